# Optimizing an MI355X kernel written in HIP

```python
import math
import jax, jax.numpy as jnp
from jax import lax
import numpy as np

D_MODEL = 1024
BATCH = 4
SEQ = 8192
DEPTH = 2
DEC_BATCH = 1
DEC_SEQ = 16384
PAST_LEN = 128

GRID_W = 64
HEAD_DIM = 128
A_GROUPS = ((128, 1), (512, 4), (2048, 16))
A_N_GROUPS = 3
A_HEADS_PER_GROUP = 4
A_HEADS = A_N_GROUPS * A_HEADS_PER_GROUP
A_QKV_WIDTH = A_HEADS * HEAD_DIM
A_WIDTH = A_HEADS_PER_GROUP * HEAD_DIM
ALIBI_MAX_BIAS = 8.0
B_HEADS = 8
B_KV_HEADS = 2
B_WIDTH = B_HEADS * HEAD_DIM
B_KV_WIDTH = B_KV_HEADS * HEAD_DIM
Q_BLOCK = 128
ROPE_THETA = 10000.0
GATE_WIDTH = 2 * D_MODEL
IN_WIDTHS = (A_QKV_WIDTH, A_QKV_WIDTH, A_QKV_WIDTH, A_WIDTH,
             B_WIDTH, B_KV_WIDTH, B_KV_WIDTH, B_WIDTH, D_MODEL, D_MODEL)
IN_WIDTH = 3 * A_QKV_WIDTH + A_WIDTH + 2 * B_WIDTH + 2 * B_KV_WIDTH + GATE_WIDTH
RMS_EPS = 1e-6
LN_EPS = 1e-5
MASK_VALUE = -1e30
ALPHA = (2 * DEPTH) ** 0.25
BETA = (8 * DEPTH) ** -0.25

kernel_name = "hybrid_dilated_gqa_encoder"


def layer_norm(x, g, b):
    xf = x.astype(jnp.float32)
    mu = jnp.mean(xf, axis=-1, keepdims=True)
    var = jnp.mean(jnp.square(xf - mu), axis=-1, keepdims=True)
    y = (xf - mu) * lax.rsqrt(var + LN_EPS) * g.astype(jnp.float32) + b.astype(jnp.float32)
    return y.astype(x.dtype)


def rms_norm(x, g):
    xf = x.astype(jnp.float32)
    y = xf * lax.rsqrt(jnp.mean(jnp.square(xf), axis=-1, keepdims=True) + RMS_EPS) * g.astype(jnp.float32)
    return y.astype(x.dtype)


def alibi_slopes():
    return jnp.asarray(2.0 ** (-ALIBI_MAX_BIAS * np.arange(1, A_HEADS + 1) / A_HEADS), dtype=jnp.float32)


def banded_attention(q, k, v, slopes, dil, n_side):
    N, L, H, Dh = q.shape
    blk = n_side
    nb = -(-L // blk)
    Lp = nb * blk
    qb = jnp.pad(q, ((0, 0), (0, Lp - L), (0, 0), (0, 0))).reshape(N, nb, blk, H, Dh)
    pad_kv = ((0, 0), (blk, Lp - L + blk), (0, 0), (0, 0))

    def neighbourhood(t):
        tb = jnp.pad(t, pad_kv).reshape(N, nb + 2, blk, H, Dh)
        return jnp.concatenate([tb[:, :-2], tb[:, 1:-1], tb[:, 2:]], axis=2)

    kb = neighbourhood(k)
    vb = neighbourhood(v)
    rel = jnp.arange(3 * blk)[None, :] - blk - jnp.arange(blk)[:, None]
    key_pos = jnp.arange(nb)[:, None] * blk - blk + jnp.arange(3 * blk)[None, :]
    valid = (jnp.abs(rel) <= n_side)[None] & ((key_pos >= 0) & (key_pos < L))[:, None, :]
    alibi = -slopes[:, None, None] * (dil * jnp.abs(rel)).astype(jnp.float32)[None]
    scale = 1.0 / math.sqrt(Dh)
    s = jnp.einsum('nbqhd,nbkhd->nbhqk', qb, kb).astype(jnp.float32) * scale + alibi[None, None]
    s = jnp.where(valid[None, :, None], s, MASK_VALUE)
    m = jnp.max(s, axis=-1, keepdims=True)
    p = jnp.exp(s - m)
    l = jnp.sum(p, axis=-1, keepdims=True)
    o = jnp.einsum('nbhqk,nbkhd->nbqhd', (p / l).astype(v.dtype), vb)
    lse = (m + jnp.log(l))[..., 0]
    o = o.reshape(N, Lp, H, Dh)[:, :L]
    lse = lse.transpose(0, 1, 3, 2).reshape(N, Lp, H)[:, :L]
    return o, lse


def dilated_group(q, k, v, slopes, dil, n_side):
    B, S, H, Dh = q.shape
    L = S // dil

    def to_classes(t):
        return t.reshape(B, L, dil, H, Dh).transpose(0, 2, 1, 3, 4).reshape(B * dil, L, H, Dh)

    o, lse = banded_attention(to_classes(q), to_classes(k), to_classes(v), slopes, dil, n_side)
    o = o.reshape(B, dil, L, H, Dh).transpose(0, 2, 1, 3, 4).reshape(B, S, H, Dh)
    lse = lse.reshape(B, dil, L, H).transpose(0, 2, 1, 3).reshape(B, S, H)
    return o, lse


def dilated_mixer(q, k, v, slopes):
    B, S, _ = q.shape
    shp = (B, S, A_N_GROUPS, A_HEADS_PER_GROUP, HEAD_DIM)
    q, k, v = q.reshape(shp), k.reshape(shp), v.reshape(shp)
    slopes = slopes.reshape(A_N_GROUPS, A_HEADS_PER_GROUP)
    outs, lses = [], []
    for g, (window, dil) in enumerate(A_GROUPS):
        n_side = window // (2 * dil)
        o, lse = dilated_group(q[:, :, g], k[:, :, g], v[:, :, g], slopes[g], dil, n_side)
        outs.append(o)
        lses.append(lse)
    o = jnp.stack(outs)
    w = jax.nn.softmax(jnp.stack(lses), axis=0)
    out = jnp.einsum('gbsh,gbshd->bshd', w.astype(o.dtype), o)
    return out.reshape(B, S, A_WIDTH)


def axial_rope_tables(S):
    rows = S // GRID_W
    row_pos = jnp.repeat(jnp.arange(rows), GRID_W).astype(jnp.float32)
    col_pos = jnp.tile(jnp.arange(GRID_W), rows).astype(jnp.float32)
    axis_dim = HEAD_DIM // 2
    inv_freq = ROPE_THETA ** (-jnp.arange(0, axis_dim, 2, dtype=jnp.float32) / axis_dim)
    ang_r = row_pos[:, None] * inv_freq[None]
    ang_c = col_pos[:, None] * inv_freq[None]
    ang = jnp.concatenate([ang_r, ang_r, ang_c, ang_c], axis=-1)
    return jnp.cos(ang), jnp.sin(ang)


def apply_axial_rope(x, cos, sin):
    xf = x.astype(jnp.float32)
    xs = xf.reshape(*x.shape[:-1], 2, 2, HEAD_DIM // 4)
    rot = jnp.stack([-xs[..., 1, :], xs[..., 0, :]], axis=-2).reshape(x.shape)
    return (xf * cos[None, :, None, :] + rot * sin[None, :, None, :]).astype(x.dtype)


def gqa_mixer(q, k, v, q_gain, k_gain):
    B, S, _ = q.shape
    G = B_HEADS // B_KV_HEADS
    q = rms_norm(q.reshape(B, S, B_HEADS, HEAD_DIM), q_gain)
    k = rms_norm(k.reshape(B, S, B_KV_HEADS, HEAD_DIM), k_gain)
    v = v.reshape(B, S, B_KV_HEADS, HEAD_DIM)
    cos, sin = axial_rope_tables(S)
    q = apply_axial_rope(q, cos, sin)
    k = apply_axial_rope(k, cos, sin)
    scale = 1.0 / math.sqrt(HEAD_DIM)
    qb = q.reshape(B, S // Q_BLOCK, Q_BLOCK, B_KV_HEADS, G, HEAD_DIM).transpose(1, 0, 2, 3, 4, 5)

    def attend_block(qi):
        s = jnp.einsum('bqkgd,bskd->bkgqs', qi, k).astype(jnp.float32) * scale
        p = jax.nn.softmax(s, axis=-1).astype(v.dtype)
        return jnp.einsum('bkgqs,bskd->bqkgd', p, v)

    o = lax.map(attend_block, qb)
    return o.transpose(1, 0, 2, 3, 4, 5).reshape(B, S, B_WIDTH)


def encoder_layer(x, w_in, b_in, q_gain, k_gain, w_proj_a, w_proj_b, w_out, ln_g, ln_b, slopes):
    h = jnp.einsum('bsd,de->bse', x, w_in) + b_in
    splits = [int(i) for i in np.cumsum(IN_WIDTHS)[:-1]]
    aq, ak, av, ag, bq, bk, bv, bg, gate_a, gate_b = jnp.split(h, splits, axis=-1)
    ya = dilated_mixer(aq, ak, av, slopes) * jax.nn.silu(ag)
    yb = gqa_mixer(bq, bk, bv, q_gain, k_gain) * jax.nn.silu(bg)
    merged = (jax.nn.sigmoid(gate_a) * jnp.einsum('bse,ed->bsd', ya, w_proj_a)
              + jax.nn.sigmoid(gate_b) * jnp.einsum('bse,ed->bsd', yb, w_proj_b))
    sub = jnp.einsum('bsd,de->bse', merged, w_out)
    return layer_norm(ALPHA * x + sub, ln_g, ln_b)


def run_trunk(x, w_in, b_in, q_gain, k_gain, w_proj_a, w_proj_b, w_out, ln_g, ln_b):
    slopes = alibi_slopes()
    for l in range(DEPTH):
        x = encoder_layer(x, w_in[l], b_in[l], q_gain[l], k_gain[l], w_proj_a[l], w_proj_b[l],
                          w_out[l], ln_g[l], ln_b[l], slopes)
    return x


def setup_inputs(seed: int = 0) -> dict:
    key = jax.random.key(seed)
    ks = jax.random.split(key, 12)
    f32 = jnp.float32
    x_prompt = jax.random.normal(ks[0], (BATCH, SEQ, D_MODEL), f32)
    x_sample = jax.random.normal(ks[1], (DEC_BATCH, DEC_SEQ, D_MODEL), f32)
    w_in = jax.random.normal(ks[2], (DEPTH, D_MODEL, IN_WIDTH), f32) * D_MODEL ** -0.5
    b_in = jax.random.normal(ks[3], (DEPTH, IN_WIDTH), f32) * 0.02
    q_gain = 1.0 + 0.05 * jax.random.normal(ks[4], (DEPTH, HEAD_DIM), f32)
    k_gain = 1.0 + 0.05 * jax.random.normal(ks[5], (DEPTH, HEAD_DIM), f32)
    w_proj_a = jax.random.normal(ks[6], (DEPTH, A_WIDTH, D_MODEL), f32) * (A_WIDTH ** -0.5 * BETA)
    w_proj_b = jax.random.normal(ks[7], (DEPTH, B_WIDTH, D_MODEL), f32) * (B_WIDTH ** -0.5 * BETA)
    w_out = jax.random.normal(ks[8], (DEPTH, D_MODEL, D_MODEL), f32) * (D_MODEL ** -0.5 * BETA)
    ln_g = 1.0 + 0.05 * jax.random.normal(ks[9], (DEPTH, D_MODEL), f32)
    ln_b = 0.02 * jax.random.normal(ks[10], (DEPTH, D_MODEL), f32)
    return {"x_prompt": x_prompt, "x_sample": x_sample, "w_in": w_in, "b_in": b_in,
            "q_gain": q_gain, "k_gain": k_gain, "w_proj_a": w_proj_a, "w_proj_b": w_proj_b,
            "w_out": w_out, "ln_g": ln_g, "ln_b": ln_b}


def reference(x_prompt, x_sample, w_in, b_in, q_gain, k_gain, w_proj_a, w_proj_b, w_out, ln_g, ln_b):
    y_prompt = run_trunk(x_prompt, w_in, b_in, q_gain, k_gain, w_proj_a, w_proj_b, w_out, ln_g, ln_b)
    y_sample = run_trunk(x_sample, w_in, b_in, q_gain, k_gain, w_proj_a, w_proj_b, w_out, ln_g, ln_b)
    return (y_prompt, y_sample)
```

```cpp
#include <hip/hip_runtime.h>
#include <hip/hip_cooperative_groups.h>
#include <cstdio>
#include <cstdint>
namespace cg = cooperative_groups;

#define LAS __attribute__((address_space(3)))
typedef unsigned short bf16_t;
typedef short bf16x8 __attribute__((ext_vector_type(8)));
typedef short s16x4 __attribute__((ext_vector_type(4)));
typedef float f32x4 __attribute__((ext_vector_type(4)));
typedef float f32x16 __attribute__((ext_vector_type(16)));
typedef unsigned u32x4 __attribute__((ext_vector_type(4)));
typedef unsigned u32x2 __attribute__((ext_vector_type(2)));
typedef int v4i_t __attribute__((ext_vector_type(4)));
typedef int v8i_t __attribute__((ext_vector_type(8)));

constexpr int DM = 1024, INW = 9728, CT = 16384, NCH = 3, DEPTH = 2;
constexpr int C_AQ = 0, C_AK = 1536, C_AV = 3072, C_AG = 4608, C_BQ = 5120, C_BK = 6144, C_BV = 6400, C_BG = 6656, C_GA = 7680, C_GB = 8704;
constexpr int YW = 1536;
constexpr float ALPHA = 1.41421356237309515f;
constexpr float RMS_EPS = 1e-6f, LN_EPS = 1e-5f;
constexpr size_t WS_WIN = 0;
constexpr size_t WS_WAB = WS_WIN + (size_t)2 * INW * DM * 2;
constexpr size_t WS_WO  = WS_WAB + (size_t)2 * DM * YW * 2;
constexpr size_t WS_XB  = WS_WO + (size_t)2 * DM * DM * 2;
constexpr size_t WS_H   = WS_XB + (size_t)CT * DM * 2;
constexpr size_t WS_Y   = WS_H + (size_t)CT * INW * 2;
constexpr size_t WS_MRG = WS_Y + (size_t)CT * YW * 2;
constexpr size_t WS_LSE = WS_MRG + (size_t)CT * DM * 2;
constexpr size_t WS_ROPE = WS_LSE + (size_t)CT * 12 * 4;
constexpr size_t WS_BAR = WS_ROPE + 256 * 32 * 2 * 4;
constexpr size_t WS_LNC = (WS_BAR + 3456 * 4 + 255) / 256 * 256;
constexpr size_t WS_ZERO_END = WS_LNC + (size_t)6 * 64 * 64 * 4;
constexpr size_t WS_LNX = WS_ZERO_END;
constexpr size_t WS_Q8  = (WS_LNX + (size_t)CT * 4 * 8 + 255) / 256 * 256;
constexpr size_t WS_K8  = WS_Q8 + (size_t)CT * 1024;
constexpr size_t WS_V8T = WS_K8 + (size_t)2 * CT * 128;
constexpr size_t WS_END = WS_V8T + (size_t)2 * CT * 128;
constexpr int LDS_BYTES = 132 * 1024;
#ifndef USE_LN_FUSED
#define USE_LN_FUSED 1
#endif
#ifndef USE_FP8_P1
#define USE_FP8_P1 1
#endif
#ifndef USE_FP8_B
#define USE_FP8_B 1
#endif
#ifndef DBG_UNIFORM
#define DBG_UNIFORM 0
#endif
#ifndef DBG_NAIVE_A
#define DBG_NAIVE_A 0
#endif
#ifndef DBG_NAIVE_B
#define DBG_NAIVE_B 0
#endif
#ifndef DBG_REP_A
#define DBG_REP_A 1
#endif
#ifndef DBG_REP_P4
#define DBG_REP_P4 1
#endif
#ifndef DBG_REP_C
#define DBG_REP_C 1
#endif
#ifndef DBG_REP_P1
#define DBG_REP_P1 1
#endif
#ifndef DBG_REP_B
#define DBG_REP_B 1
#endif
#ifndef DBG_NO_B
#define DBG_NO_B 0
#endif

struct Params {
  const float *x_prompt, *x_sample, *w_in, *b_in, *q_gain, *k_gain, *w_pa, *w_pb, *w_out, *ln_g, *ln_b;
  float* out; char* ws;
};

__device__ __forceinline__ int fresh_tid() { int t = threadIdx.x; asm volatile("" : "+v"(t)); return t; }
__device__ __forceinline__ unsigned cvtpk(float lo, float hi) { unsigned r; asm volatile("v_cvt_pk_bf16_f32 %0, %1, %2" : "=v"(r) : "v"(lo), "v"(hi)); return r; }
__device__ __forceinline__ float bflo(unsigned w) { return __uint_as_float(w << 16); }
__device__ __forceinline__ float bfhi(unsigned w) { return __uint_as_float(w & 0xffff0000u); }
__device__ __forceinline__ float bf2f(bf16_t b) { return __uint_as_float(((unsigned)b) << 16); }
__device__ __forceinline__ unsigned pk4_fp8(float a, float b, float c, float d) { const int t = __builtin_amdgcn_cvt_pk_fp8_f32(a, b, 0, false); return (unsigned)__builtin_amdgcn_cvt_pk_fp8_f32(c, d, t, true); }
typedef float f32x2_t __attribute__((ext_vector_type(2)));
__device__ __forceinline__ void fp8x4_to_f32(unsigned w, float* o) { const f32x2_t lo = __builtin_amdgcn_cvt_pk_f32_fp8((int)w, false), hi = __builtin_amdgcn_cvt_pk_f32_fp8((int)w, true); o[0] = lo[0]; o[1] = lo[1]; o[2] = hi[0]; o[3] = hi[1]; }
__device__ __forceinline__ float sigmoidf_(float x) { return __builtin_amdgcn_rcpf(1.f + __builtin_amdgcn_exp2f(-1.4426950408889634f * x)); }

namespace pg8 {
constexpr int BM = 256, BK = 64, HALF = 128, HTB = HALF * BK * 2, STAGE_BYTES = 8 * HTB, NXCD = 8, WGM = 8;
__device__ __forceinline__ int lds_byte(int r, int c) { const int st = (r >> 4) * 2 + (c >> 5), rr = r & 15, cc = c & 31, ob = rr * 64 + cc * 2; return st * 1024 + (ob ^ (((ob >> 9) & 1) << 5)); }
__device__ __forceinline__ void stage_rc(int b, int& R, int& C) { const int st = b / 1024, sb = b % 1024, swz = sb ^ (((sb >> 9) & 1) << 5); R = (st >> 1) * 16 + swz / 64; C = (st & 1) * 32 + (swz % 64) / 2; }
__device__ __forceinline__ int perm32(int rho) { const int n = rho >> 4, i = rho & 15; return 8 * (i >> 2) + 4 * n + (i & 3); }
struct Unit { int pm, pn, kind; };
__device__ __forceinline__ bool tile_of(int L, int nM, int nN, int& pm, int& pn) {
  const int nwg = nM * nN; if (L >= nwg) return false;
  int wgid = L; { const int q = nwg / NXCD, r = nwg % NXCD, xcd = wgid % NXCD, off = wgid / NXCD; wgid = (xcd < r ? xcd * (q + 1) : r * (q + 1) + (xcd - r) * q) + off; }
  const int nig = WGM * nN, gid = wgid / nig, fm = gid * WGM, gsz = (nM - fm) < WGM ? (nM - fm) : WGM;
  pm = fm + ((wgid % nig) % gsz); pn = (wgid % nig) / gsz; return true;
}
struct SchedStd {
  int nM, nN, G, c, lda, ldb, nt; const char *A, *B;
  __device__ __forceinline__ bool next(int i, Unit& u) const { u.kind = 0; return tile_of(i * G + c, nM, nN, u.pm, u.pn); }
  __device__ __forceinline__ void op(const Unit& u, const char*& a, const char*& b, int& n) const { a = A + (size_t)u.pm * BM * lda * 2; b = B + (size_t)u.pn * BM * ldb * 2; n = nt; }
};
struct SchedMerge {
  int nM, nN, G, c, lda, ldb; const char *A, *B;
  __device__ __forceinline__ bool next(int i, Unit& u) const { u.kind = i & 1; return tile_of((i >> 1) * G + c, nM, nN, u.pm, u.pn); }
  __device__ __forceinline__ void op(const Unit& u, const char*& a, const char*& b, int& n) const {
    a = A + (size_t)u.pm * BM * lda * 2 + (u.kind ? 1024 : 0); b = B + (size_t)u.pn * BM * ldb * 2 + (u.kind ? 1024 : 0); n = u.kind ? 16 : 8; }
};

struct EpiIn {
  static __device__ __forceinline__ bool keep_acc(const Unit&) { return false; }
  static constexpr bool AFTER_DRAIN = false;
  static constexpr bool PERM = true;
  bf16_t* H; const float* bias; float ascale;
  __device__ __forceinline__ void operator()(const f32x4 (&acc)[2][2][4][2], const Unit& u, int wr, int wc, int fr, int fq) const {
    const int row0 = u.pm * BM + wr * 64 + fr, col0 = u.pn * BM + wc * 32 + 8 * fq;
    const int act = (u.pn >= 30) ? 2 : (((u.pn >= 18 && u.pn < 20) || (u.pn >= 26)) ? 1 : 0);
    const bool f8 = (u.pn >= 20 && u.pn < 30) || (u.pn >= 34);
    const int fs = (u.pn < 24) ? C_BQ : (u.pn == 24) ? C_BK : (u.pn == 25) ? C_BV : (u.pn < 30) ? C_BG : C_GB;
    f32x4 bv[2][2];
#pragma unroll
    for (int bj = 0; bj < 2; ++bj)
#pragma unroll
      for (int n = 0; n < 2; ++n) bv[bj][n] = *(const f32x4*)(bias + col0 + bj * HALF + 4 * n);
#pragma unroll
    for (int ai = 0; ai < 2; ++ai)
#pragma unroll
      for (int m = 0; m < 4; ++m) { bf16_t* rowp = H + (size_t)(row0 + ai * HALF + m * 16) * INW + col0;
#pragma unroll
        for (int bj = 0; bj < 2; ++bj) { f32x4 v0 = acc[ai][bj][m][0] * ascale + bv[bj][0], v1 = acc[ai][bj][m][1] * ascale + bv[bj][1];
          if (act) {
#pragma unroll
            for (int j = 0; j < 4; ++j) { const float s0 = sigmoidf_(v0[j]), s1 = sigmoidf_(v1[j]); v0[j] = (act == 1) ? v0[j] * s0 : s0; v1[j] = (act == 1) ? v1[j] * s1 : s1; } }
          if (f8) { u32x2 w8; w8.x = pk4_fp8(v0[0], v0[1], v0[2], v0[3]); w8.y = pk4_fp8(v1[0], v1[1], v1[2], v1[3]);
            *(u32x2*)((unsigned char*)H + (size_t)(row0 + ai * HALF + m * 16) * (INW * 2) + fs * 2 + (col0 - fs) + bj * HALF) = w8; }
          else { u32x4 w; w.x = cvtpk(v0[0], v0[1]); w.y = cvtpk(v0[2], v0[3]); w.z = cvtpk(v1[0], v1[1]); w.w = cvtpk(v1[2], v1[3]);
            *(u32x4*)(rowp + bj * HALF) = w; } } }
  }
};
struct EpiMerge {
  static constexpr bool AFTER_DRAIN = false;
  static constexpr bool PERM = true;
  const bf16_t* H; bf16_t* T; bf16_t* MRG;
  static __device__ __forceinline__ bool keep_acc(const Unit& u) { return u.kind == 0; }
  __device__ __forceinline__ void operator()(f32x4 (&acc)[2][2][4][2], const Unit& u, int wr, int wc, int fr, int fq) const {
    const int row0 = u.pm * BM + wr * 64 + fr, col0 = u.pn * BM + wc * 32 + 8 * fq;
#pragma unroll
    for (int ai = 0; ai < 2; ++ai)
#pragma unroll
      for (int m = 0; m < 4; ++m) { const size_t row = (size_t)(row0 + ai * HALF + m * 16);
#pragma unroll
        for (int bj = 0; bj < 2; ++bj) {
          float gb[8];
          { const u32x2 g8 = *(const u32x2*)((const unsigned char*)H + row * (INW * 2) + C_GB * 2 + col0 + bj * HALF); fp8x4_to_f32(g8.x, gb); fp8x4_to_f32(g8.y, gb + 4); }
#pragma unroll
          for (int j = 0; j < 8; ++j) gb[j] = fmaxf(gb[j], 9.765625e-4f);
          if (u.kind == 0) {
            const u32x4 g = *(const u32x4*)(H + row * INW + C_GA + col0 + bj * HALF);
            const float ga[8] = {bflo(g.x), bfhi(g.x), bflo(g.y), bfhi(g.y), bflo(g.z), bfhi(g.z), bflo(g.w), bfhi(g.w)};
#pragma unroll
            for (int j = 0; j < 4; ++j) { acc[ai][bj][m][0][j] *= ga[j] * __builtin_amdgcn_rcpf(gb[j]); acc[ai][bj][m][1][j] *= ga[4 + j] * __builtin_amdgcn_rcpf(gb[4 + j]); }
          } else {
            const f32x4 a0 = acc[ai][bj][m][0], a1 = acc[ai][bj][m][1];
            u32x4 w; w.x = cvtpk(a0[0] * gb[0], a0[1] * gb[1]); w.y = cvtpk(a0[2] * gb[2], a0[3] * gb[3]); w.z = cvtpk(a1[0] * gb[4], a1[1] * gb[5]); w.w = cvtpk(a1[2] * gb[6], a1[3] * gb[7]);
            *(u32x4*)(MRG + row * DM + col0 + bj * HALF) = w; } } }
  }
};
struct EpiOut {
  static __device__ __forceinline__ bool keep_acc(const Unit&) { return false; }
  static constexpr bool AFTER_DRAIN = false;
  static constexpr bool PERM = true;
  const float* X; float* Z;
  __device__ __forceinline__ void operator()(const f32x4 (&acc)[2][2][4][2], const Unit& u, int wr, int wc, int fr, int fq) const {
    const int row0 = u.pm * BM + wr * 64 + fr, col0 = u.pn * BM + wc * 32 + 8 * fq;
#pragma unroll
    for (int ai = 0; ai < 2; ++ai)
#pragma unroll
      for (int m = 0; m < 4; ++m) { const size_t off = (size_t)(row0 + ai * HALF + m * 16) * DM + col0;
#pragma unroll
        for (int bj = 0; bj < 2; ++bj)
#pragma unroll
          for (int n = 0; n < 2; ++n) { const f32x4 xv = *(const f32x4*)(X + off + bj * HALF + n * 4); *(f32x4*)(Z + off + bj * HALF + n * 4) = xv * ALPHA + acc[ai][bj][m][n]; } }
  }
};


struct EpiLN {
  static __device__ __forceinline__ bool keep_acc(const Unit&) { return false; }
  static constexpr bool PERM = true, AFTER_DRAIN = true;
  const float* X; float* Yo; unsigned char* XB8; const float* g; const float* b; unsigned long long* slots; unsigned* cnt; int write_xb;
  __device__ __forceinline__ void fused(f32x4 (&acc)[2][2][4][2], const Unit& u, int wr, int wc, int fr, int fq, LAS unsigned char* lds, int wid, int lane) const {
    typedef float f32x2v __attribute__((ext_vector_type(2)));
    LAS f32x2v* P = (LAS f32x2v*)lds;
    LAS f32x2v* S = (LAS f32x2v*)(lds + 8192);
    const int col0 = u.pn * BM + wc * 32 + 8 * fq;
#pragma unroll
    for (int ai = 0; ai < 2; ++ai)
#pragma unroll
      for (int m = 0; m < 4; ++m) { const int rl = ai * HALF + wr * 64 + m * 16 + fr; const size_t off = (size_t)(u.pm * BM + rl) * DM + col0;
        float s1 = 0.f, s2 = 0.f;
#pragma unroll
        for (int bj = 0; bj < 2; ++bj)
#pragma unroll
          for (int n = 0; n < 2; ++n) { const f32x4 xv = *(const f32x4*)(X + off + bj * HALF + n * 4); const f32x4 z = xv * ALPHA + acc[ai][bj][m][n]; acc[ai][bj][m][n] = z;
            s1 += (z[0] + z[1]) + (z[2] + z[3]); s2 += (z[0] * z[0] + z[1] * z[1]) + (z[2] * z[2] + z[3] * z[3]); }
        s1 += __shfl_xor(s1, 16); s1 += __shfl_xor(s1, 32); s2 += __shfl_xor(s2, 16); s2 += __shfl_xor(s2, 32);
        if (fq == 0) P[rl * 4 + wc] = (f32x2v){s1, s2};
        asm volatile("" ::: "memory"); }
    asm volatile("s_waitcnt lgkmcnt(0)" ::: "memory"); __builtin_amdgcn_s_barrier(); asm volatile("" ::: "memory");
    const int t = wid * 64 + lane;
    if (t < 256) { const f32x2v a = P[t * 4 + 0], b2 = P[t * 4 + 1], c = P[t * 4 + 2], d = P[t * 4 + 3];
      const float m1 = (a.x + b2.x) + (c.x + d.x), m2 = (a.y + b2.y) + (c.y + d.y);
      __hip_atomic_store(slots + ((size_t)(u.pm * BM + t) * 4 + u.pn), ((unsigned long long)__float_as_uint(m2) << 32) | __float_as_uint(m1), __ATOMIC_RELAXED, __HIP_MEMORY_SCOPE_AGENT); }
    asm volatile("s_waitcnt vmcnt(0)" ::: "memory"); __builtin_amdgcn_s_barrier(); asm volatile("" ::: "memory");
    if (t == 0) { __hip_atomic_fetch_add(cnt + 64 * u.pm, 1u, __ATOMIC_RELAXED, __HIP_MEMORY_SCOPE_AGENT);
      unsigned sp = 0; while (__hip_atomic_load(cnt + 64 * u.pm, __ATOMIC_RELAXED, __HIP_MEMORY_SCOPE_AGENT) < 4u) { __builtin_amdgcn_s_sleep(2); if (++sp > (1u << 22)) break; }
      __builtin_amdgcn_fence(__ATOMIC_ACQUIRE, "agent"); asm volatile("s_waitcnt vmcnt(0)" ::: "memory"); }
    __builtin_amdgcn_s_barrier(); asm volatile("" ::: "memory");
    if (t < 256) { const unsigned long long* sl = slots + (size_t)(u.pm * BM + t) * 4; float m1 = 0.f, m2 = 0.f;
#pragma unroll
      for (int q = 0; q < 4; ++q) { const unsigned long long w = __hip_atomic_load(sl + q, __ATOMIC_RELAXED, __HIP_MEMORY_SCOPE_AGENT); m1 += __uint_as_float((unsigned)w); m2 += __uint_as_float((unsigned)(w >> 32)); }
      const float mean = m1 * (1.f / DM), var = fmaxf(m2 * (1.f / DM) - mean * mean, 0.f);
      S[t] = (f32x2v){mean, rsqrtf(var + LN_EPS)}; }
    asm volatile("s_waitcnt lgkmcnt(0)" ::: "memory"); __builtin_amdgcn_s_barrier(); asm volatile("" ::: "memory");
#pragma unroll
    for (int bj = 0; bj < 2; ++bj)
#pragma unroll
      for (int n = 0; n < 2; ++n) { const f32x4 gv = *(const f32x4*)(g + col0 + bj * HALF + n * 4), bv = *(const f32x4*)(b + col0 + bj * HALF + n * 4);
#pragma unroll
        for (int ai = 0; ai < 2; ++ai)
#pragma unroll
          for (int m = 0; m < 4; ++m) { const int rl = ai * HALF + wr * 64 + m * 16 + fr; const f32x2v st = S[rl]; const size_t row = (size_t)(u.pm * BM + rl);
            const f32x4 y = (acc[ai][bj][m][n] - st.x) * st.y * gv + bv;
            *(f32x4*)(Yo + row * DM + col0 + bj * HALF + n * 4) = y;
            if (write_xb) *(unsigned*)(XB8 + row * DM + col0 + bj * HALF + n * 4) = pk4_fp8(y[0], y[1], y[2], y[3]); } }
  }
};

template <class Epi, class Sched, bool FP8 = false>
__device__ __forceinline__ void gemm_phase(LAS unsigned char* lds, const Sched& S, const Epi& E) {
  const int tid = fresh_tid(), wid = __builtin_amdgcn_readfirstlane(tid >> 6), lane = tid & 63, wr = wid >> 2, wc = wid & 3, fr = lane & 15, fq = lane >> 4;
  const int lda = S.lda, ldb = S.ldb;
  unsigned voffA[2], voffB[2];
#pragma unroll
  for (int i = 0; i < 2; ++i) { int R, C; stage_rc(tid * 16 + i * 8192, R, C); const int Rb = Epi::PERM ? ((R & ~31) + perm32(R & 31)) : R;
    voffA[i] = (unsigned)(R * lda + C) * 2u; voffB[i] = (unsigned)(Rb * ldb + C) * 2u; }
  const size_t kstep = (size_t)(BK * 2);
  const size_t hstepA = (size_t)HALF * lda * 2, hstepB = (size_t)HALF * ldb * 2;
  const unsigned ldsw = (unsigned)wid * 1024u;
  const int aoff = lds_byte(wr * 64 + fr, fq * 8), boff = lds_byte(wc * 32 + fr, fq * 8);
#define PG8_SA(b, h) (((b) * 2 + (h)) * HTB)
#define PG8_SB(b, h) ((4 + (b) * 2 + (h)) * HTB)
#define PG8_STAGE(bufoff, gbase, voff) do { _Pragma("unroll") for (int _i = 0; _i < 2; ++_i) \
    __builtin_amdgcn_global_load_lds((const unsigned*)((const char*)(gbase) + (voff)[_i]), (LAS unsigned*)(lds + (bufoff) + ldsw + _i * 8192), 16, 0, 0); } while (0)
#define PG8_LDA(dst, b, h) do { if constexpr (FP8) { _Pragma("unroll") for (int m = 0; m < 4; ++m) dst##8[m] = __builtin_shufflevector(*(const LAS v4i_t*)(lds + PG8_SA(b, h) + aoff + m * 2048), *(const LAS v4i_t*)(lds + PG8_SA(b, h) + aoff + m * 2048 + 1024), 0, 1, 2, 3, 4, 5, 6, 7); } \
    else { _Pragma("unroll") for (int m = 0; m < 4; ++m) _Pragma("unroll") for (int k = 0; k < 2; ++k) dst[m][k] = *(const LAS bf16x8*)(lds + PG8_SA(b, h) + aoff + m * 2048 + k * 1024); } } while (0)
#define PG8_LDB(dst, b, h) do { if constexpr (FP8) { _Pragma("unroll") for (int n = 0; n < 2; ++n) dst##8[n] = __builtin_shufflevector(*(const LAS v4i_t*)(lds + PG8_SB(b, h) + boff + n * 2048), *(const LAS v4i_t*)(lds + PG8_SB(b, h) + boff + n * 2048 + 1024), 0, 1, 2, 3, 4, 5, 6, 7); } \
    else { _Pragma("unroll") for (int n = 0; n < 2; ++n) _Pragma("unroll") for (int k = 0; k < 2; ++k) dst[n][k] = *(const LAS bf16x8*)(lds + PG8_SB(b, h) + boff + n * 2048 + k * 1024); } } while (0)
#define PG8_CAT(x, y) __builtin_shufflevector(__builtin_bit_cast(v4i_t, x), __builtin_bit_cast(v4i_t, y), 0, 1, 2, 3, 4, 5, 6, 7)
#define PG8_MMA(ai, bj, At, Bt) do { __builtin_amdgcn_s_setprio(1); \
    if constexpr (FP8) { _Pragma("unroll") for (int m = 0; m < 4; ++m) _Pragma("unroll") for (int n = 0; n < 2; ++n) \
      asm volatile("v_mfma_f32_16x16x128_f8f6f4 %0, %1, %2, %0" : "+v"(acc[ai][bj][m][n]) : "v"(Bt##8[n]), "v"(At##8[m])); } \
    else { _Pragma("unroll") for (int m = 0; m < 4; ++m) _Pragma("unroll") for (int n = 0; n < 2; ++n) _Pragma("unroll") for (int k = 0; k < 2; ++k) \
      acc[ai][bj][m][n] = __builtin_amdgcn_mfma_f32_16x16x32_bf16(Bt[n][k], At[m][k], acc[ai][bj][m][n], 0, 0, 0); } \
    __builtin_amdgcn_s_setprio(0); } while (0)
#define PG8_WAIT_V(n) asm volatile("s_waitcnt vmcnt(" #n ")" ::: "memory")
#define PG8_WAIT_L(n) asm volatile("s_waitcnt lgkmcnt(" #n ")" ::: "memory")
#define PG8_BAR __builtin_amdgcn_s_barrier()
#define PG8_SCHED __builtin_amdgcn_sched_barrier(0)
  Unit cur, nxt; int ui = 0;
  if (!S.next(0, cur)) return;
  f32x4 acc[2][2][4][2];
#pragma unroll
  for (int a = 0; a < 2; ++a)
#pragma unroll
    for (int b = 0; b < 2; ++b)
#pragma unroll
      for (int m = 0; m < 4; ++m)
#pragma unroll
        for (int n = 0; n < 2; ++n) acc[a][b][m][n] = (f32x4){0.f, 0.f, 0.f, 0.f};
  bf16x8 At[4][2], B0[2][2], B1[2][2]; v8i_t At8[4], B08[2], B18[2]; (void)At; (void)B0; (void)B1; (void)At8; (void)B08; (void)B18;
  const char *cA, *cB; int nt; S.op(cur, cA, cB, nt);
  PG8_STAGE(PG8_SB(0, 0), cB, voffB); PG8_STAGE(PG8_SA(0, 0), cA, voffA); PG8_STAGE(PG8_SB(0, 1), cB + hstepB, voffB); PG8_STAGE(PG8_SA(0, 1), cA + hstepA, voffA);
  if (wr == 1) PG8_BAR;
  PG8_WAIT_V(4); PG8_BAR;
  PG8_STAGE(PG8_SB(1, 0), cB + kstep, voffB); PG8_STAGE(PG8_SA(1, 0), cA + kstep, voffA); PG8_STAGE(PG8_SB(1, 1), cB + hstepB + kstep, voffB);
  PG8_WAIT_V(6); PG8_BAR;
  for (;;) {
    const bool has_next = S.next(ui + 1, nxt);
    const char *nA = cA, *nB = cB; int nnt = nt;
    if (has_next) S.op(nxt, nA, nB, nnt);
    for (int t = 0; t < nt; t += 2) {
      const bool last = (t == nt - 2);
      const char* a1 = cA + (size_t)(t + 1) * kstep;
      const char* a2 = last ? nA : cA + (size_t)(t + 2) * kstep; const char* b2 = last ? nB : cB + (size_t)(t + 2) * kstep;
      const char* a3 = a2 + kstep; const char* b3 = b2 + kstep;
      PG8_LDB(B0, 0, 0); PG8_SCHED; PG8_LDA(At, 0, 0); PG8_STAGE(PG8_SA(1, 1), a1 + hstepA, voffA);
      PG8_WAIT_L(8); PG8_BAR; PG8_WAIT_L(0); PG8_MMA(0, 0, At, B0); PG8_BAR; PG8_SCHED;
      PG8_LDB(B1, 0, 1); PG8_STAGE(PG8_SB(0, 0), b2, voffB);
      PG8_BAR; PG8_WAIT_L(0); PG8_MMA(0, 1, At, B1); PG8_BAR;
      PG8_LDA(At, 0, 1); PG8_STAGE(PG8_SA(0, 0), a2, voffA);
      PG8_BAR; PG8_WAIT_L(0); PG8_MMA(1, 0, At, B0); PG8_BAR; PG8_SCHED;
      PG8_STAGE(PG8_SB(0, 1), b2 + hstepB, voffB);
      PG8_WAIT_V(6); PG8_BAR; PG8_MMA(1, 1, At, B1); PG8_BAR;
      PG8_LDB(B0, 1, 0); PG8_SCHED; PG8_LDA(At, 1, 0); PG8_STAGE(PG8_SA(0, 1), a2 + hstepA, voffA);
      PG8_WAIT_L(8); PG8_BAR; PG8_WAIT_L(0); PG8_MMA(0, 0, At, B0); PG8_BAR; PG8_SCHED;
      PG8_LDB(B1, 1, 1); PG8_STAGE(PG8_SB(1, 0), b3, voffB);
      PG8_BAR; PG8_WAIT_L(0); PG8_MMA(0, 1, At, B1); PG8_BAR;
      PG8_LDA(At, 1, 1); PG8_STAGE(PG8_SA(1, 0), a3, voffA);
      PG8_BAR; PG8_WAIT_L(0); PG8_MMA(1, 0, At, B0); PG8_BAR; PG8_SCHED;
      PG8_STAGE(PG8_SB(1, 1), b3 + hstepB, voffB);
      PG8_WAIT_V(6); PG8_BAR; PG8_MMA(1, 1, At, B1); PG8_BAR;
    }
    if constexpr (FP8) asm volatile("s_nop 15\n\ts_nop 15\n\ts_nop 15" ::: "memory");
    if constexpr (!Epi::AFTER_DRAIN) { Unit ue = cur; int fr_ = fr, fq_ = fq;
      asm volatile("" : "+s"(ue.pm), "+s"(ue.pn), "+s"(ue.kind), "+v"(fr_), "+v"(fq_));
      E(acc, ue, wr, wc, fr_, fq_); }
    if (!has_next) break;
    if (!Epi::keep_acc(cur)) {
#pragma unroll
    for (int a = 0; a < 2; ++a)
#pragma unroll
      for (int b = 0; b < 2; ++b)
#pragma unroll
        for (int m = 0; m < 4; ++m)
#pragma unroll
          for (int n = 0; n < 2; ++n) acc[a][b][m][n] = (f32x4){0.f, 0.f, 0.f, 0.f};
    }
    cur = nxt; cA = nA; cB = nB; nt = nnt; ++ui;
  }
  PG8_WAIT_V(0);
  if (wr == 0) PG8_BAR;
  PG8_BAR;
  if constexpr (Epi::AFTER_DRAIN) { Unit ue = cur; int fr_ = fr, fq_ = fq;
    asm volatile("" : "+s"(ue.pm), "+s"(ue.pn), "+v"(fr_), "+v"(fq_));
    E.fused(acc, ue, wr, wc, fr_, fq_, lds, wid, lane); }
#undef PG8_SA
#undef PG8_SB
#undef PG8_STAGE
#undef PG8_LDA
#undef PG8_LDB
#undef PG8_MMA
#undef PG8_CAT
#undef PG8_WAIT_V
#undef PG8_WAIT_L
#undef PG8_BAR
#undef PG8_SCHED
}
}


__device__ __forceinline__ void store_tile_rows(const f32x16* o, const float* rli, char* wl, int r32, int hi, int lane, bf16_t* Orow0, long ostride, const unsigned char* Grow0, long gstride) {
#pragma unroll
  for (int r = 0; r < 16; ++r) { const int row = (r & 3) + 8 * (r >> 2) + 4 * hi;
#pragma unroll
    for (int d0 = 0; d0 < 4; ++d0) *(bf16_t*)(wl + row * 256 + (d0 * 32 + r32) * 2) = (bf16_t)(cvtpk(o[d0][r] * rli[r], 0.f) & 0xffffu);
    asm volatile("" ::: "memory"); }
  asm volatile("s_waitcnt lgkmcnt(0)" ::: "memory");
#pragma unroll 1
  for (int it = 0; it < 8; ++it) { const int chunk = it * 64 + lane, row = chunk >> 4, cc = chunk & 15;
    u32x4 v = *(const u32x4*)(wl + chunk * 16);
    if (Grow0) { const u32x2 g8 = *(const u32x2*)(Grow0 + (long)row * gstride + cc * 8); float gf[8]; fp8x4_to_f32(g8.x, gf); fp8x4_to_f32(g8.y, gf + 4);
      v.x = cvtpk(bflo(v.x) * gf[0], bfhi(v.x) * gf[1]); v.y = cvtpk(bflo(v.y) * gf[2], bfhi(v.y) * gf[3]);
      v.z = cvtpk(bflo(v.z) * gf[4], bfhi(v.z) * gf[5]); v.w = cvtpk(bflo(v.w) * gf[6], bfhi(v.w) * gf[7]); }
    *(u32x4*)(Orow0 + (long)row * ostride + cc * 8) = v; }
  asm volatile("s_waitcnt lgkmcnt(0)" ::: "memory");
}
constexpr int EPI_LDS_OFF = 66 * 1024;

namespace at {
constexpr int D = 128, NW = 8, QBLK = 32, KVBLK = 64;
constexpr float SCALE = 0.088388347648318440f;
constexpr float THR = 8.f;
constexpr size_t SHM_V = KVBLK * D * 2, SHM_K = KVBLK * D * 2, SHM_ATTN = 2 * SHM_V + 2 * SHM_K + NW * 64 * 4;
#define KSWZ(row, colB) ((row) * 256 + ((colB) ^ (((row) & 7) << 4)))
#define SBAR() __builtin_amdgcn_sched_barrier(0)
__device__ __forceinline__ int crow(int r, int hi) { return (r & 3) + 8 * (r >> 2) + 4 * hi; }

template <bool BAND>
__device__ __forceinline__ void partialSM(f32x16& p0, f32x16& p1, float& m_reg, float& mn, float& alpha, int kb, int uq, int L, float sl, int hi) {
  constexpr float C = SCALE * 1.4426950408889634f;
#if DBG_UNIFORM
  if constexpr (!BAND) { p0 = p0 * 0.f; p1 = p1 * 0.f; }
#endif
  if constexpr (BAND) {
#pragma unroll
    for (int r = 0; r < 16; ++r) {
      const int k0i = kb + crow(r, hi), k1i = k0i + 32;
      const float a0 = fabsf((float)(k0i - uq)), a1 = fabsf((float)(k1i - uq));
      const bool ok0 = (a0 <= 64.f) && ((unsigned)k0i < (unsigned)L), ok1 = (a1 <= 64.f) && ((unsigned)k1i < (unsigned)L);
      p0[r] = ok0 ? fmaf(-a0, sl, p0[r]) : -1e30f; p1[r] = ok1 ? fmaf(-a1, sl, p1[r]) : -1e30f;
    }
  }
  float pmax = p0[0];
#pragma unroll
  for (int r = 1; r < 16; ++r) pmax = fmaxf(pmax, p0[r]);
#pragma unroll
  for (int r = 0; r < 16; ++r) pmax = fmaxf(pmax, p1[r]);
  { auto rr = __builtin_amdgcn_permlane32_swap(__float_as_uint(pmax), __float_as_uint(pmax), false, false);
    pmax = fmaxf(__uint_as_float(rr[0]), __uint_as_float(rr[1])); }
  if (__builtin_expect(__all(pmax - m_reg <= THR / SCALE), 1)) { mn = m_reg; alpha = 1.f; }
  else { mn = fmaxf(m_reg, pmax); alpha = __builtin_amdgcn_exp2f((m_reg - mn) * C); m_reg = mn; }
  const float mnC = -mn * C;
#pragma unroll
  for (int r = 0; r < 16; ++r) p0[r] = fmaf(p0[r], C, mnC);
#pragma unroll
  for (int r = 0; r < 16; ++r) p1[r] = fmaf(p1[r], C, mnC);
#pragma unroll
  for (int r = 0; r < 16; ++r) p0[r] = __builtin_amdgcn_exp2f(p0[r]);
}
__device__ __forceinline__ void finishSM(f32x16& p0, f32x16& p1, float alpha, float& l_reg, bf16x8& pa0, bf16x8& pa1, bf16x8& pa2, bf16x8& pa3) {
#pragma unroll
  for (int r = 0; r < 16; ++r) p1[r] = __builtin_amdgcn_exp2f(p1[r]);
  float ps = 0;
#pragma unroll
  for (int r = 0; r < 16; ++r) ps += p0[r];
#pragma unroll
  for (int r = 0; r < 16; ++r) ps += p1[r];
  { auto rr = __builtin_amdgcn_permlane32_swap(__float_as_uint(ps), __float_as_uint(ps), false, false);
    ps = __uint_as_float(rr[0]) + __uint_as_float(rr[1]); }
  l_reg = l_reg * alpha + ps;
#define PK4(P, BASE, OUT) do { unsigned a0 = cvtpk(P[BASE + 0], P[BASE + 1]), a1 = cvtpk(P[BASE + 2], P[BASE + 3]);   \
    unsigned b0 = cvtpk(P[BASE + 4], P[BASE + 5]), b1 = cvtpk(P[BASE + 6], P[BASE + 7]);                              \
    auto r0 = __builtin_amdgcn_permlane32_swap(a0, b0, false, false); auto r1 = __builtin_amdgcn_permlane32_swap(a1, b1, false, false); \
    u32x4 w = {r0[0], r1[0], r0[1], r1[1]}; OUT = *reinterpret_cast<bf16x8*>(&w); } while (0)
  PK4(p0, 0, pa0); PK4(p0, 8, pa1); PK4(p1, 0, pa2); PK4(p1, 8, pa3);
#undef PK4
}
__device__ __forceinline__ void qkt(f32x16& p0, f32x16& p1, const char* Ks, const bf16x8* qr, int r32, int hi) {
  p0 = f32x16{}; p1 = f32x16{};
#pragma unroll
  for (int d0 = 0; d0 < 8; ++d0) { const int cb = (d0 * 16 + hi * 8) * 2;
    bf16x8 b0 = *reinterpret_cast<const bf16x8*>(Ks + KSWZ(r32, cb));
    bf16x8 b1 = *reinterpret_cast<const bf16x8*>(Ks + KSWZ(32 + r32, cb));
    p0 = __builtin_amdgcn_mfma_f32_32x32x16_bf16(b0, qr[d0], p0, 0, 0, 0);
    p1 = __builtin_amdgcn_mfma_f32_32x32x16_bf16(b1, qr[d0], p1, 0, 0, 0); }
}
__device__ __forceinline__ int v_st(int k, int c) { const int kk = (k & ~0xC) | ((k & 4) << 1) | ((k & 8) >> 1); return ((kk >> 3) * 4 + (c >> 5)) * 512 + ((kk & 7) * 32 + (c & 31)) * 2; }
__device__ __forceinline__ int v_rd_base(int lane) { return ((lane & 3) << 3) | (((lane >> 2) & 3) << 6) | (((lane >> 4) & 1) << 5) | (((lane >> 5) & 1) << 8); }
constexpr int v_rd_off(int d0, int ks, int half) { return d0 * 512 + ks * 4096 + half * 2048; }
template <int OFF> __device__ __forceinline__ s16x4 tr_read(int vb) {
  s16x4 r; asm volatile("ds_read_b64_tr_b16 %0, %1 offset:%2" : "=&v"(r) : "v"(vb), "i"(OFF) : "memory"); return r;
}
template <int D0> __device__ __forceinline__ void pv_one(f32x16& od, int vb, bf16x8 pa0, bf16x8 pa1, bf16x8 pa2, bf16x8 pa3) {
  const s16x4 l0 = tr_read<v_rd_off(D0, 0, 0)>(vb), h0 = tr_read<v_rd_off(D0, 0, 1)>(vb), l1 = tr_read<v_rd_off(D0, 1, 0)>(vb), h1 = tr_read<v_rd_off(D0, 1, 1)>(vb);
  const s16x4 l2 = tr_read<v_rd_off(D0, 2, 0)>(vb), h2 = tr_read<v_rd_off(D0, 2, 1)>(vb), l3 = tr_read<v_rd_off(D0, 3, 0)>(vb), h3 = tr_read<v_rd_off(D0, 3, 1)>(vb);
  asm volatile("s_waitcnt lgkmcnt(0)" ::: "memory"); SBAR();
#define PK(L, H) (bf16x8){L[0], L[1], L[2], L[3], H[0], H[1], H[2], H[3]}
  od = __builtin_amdgcn_mfma_f32_32x32x16_bf16(pa0, PK(l0, h0), od, 0, 0, 0);
  od = __builtin_amdgcn_mfma_f32_32x32x16_bf16(pa1, PK(l1, h1), od, 0, 0, 0);
  od = __builtin_amdgcn_mfma_f32_32x32x16_bf16(pa2, PK(l2, h2), od, 0, 0, 0);
  od = __builtin_amdgcn_mfma_f32_32x32x16_bf16(pa3, PK(l3, h3), od, 0, 0, 0);
#undef PK
}
__device__ __forceinline__ void pv_d0(f32x16* o, int vb, bf16x8 pa0, bf16x8 pa1, bf16x8 pa2, bf16x8 pa3) {
  pv_one<0>(o[0], vb, pa0, pa1, pa2, pa3); pv_one<1>(o[1], vb, pa0, pa1, pa2, pa3); pv_one<2>(o[2], vb, pa0, pa1, pa2, pa3); pv_one<3>(o[3], vb, pa0, pa1, pa2, pa3);
}

template <bool BAND>
__device__ __forceinline__ void attn_body(const bf16_t* Qb, const bf16_t* Kh, const bf16_t* Vh, long rs, int NT,
                                          int ubase, int u0, int L, float sl,
                                          bf16_t* Ob, const bf16_t* Gb, float* Lp, long lse_stride, char* lds, bool do_store = true) {
  const int tid = fresh_tid(), wid = tid >> 6, lane = tid & 63, r32 = lane & 31, hi = lane >> 5;
  if (__builtin_amdgcn_readfirstlane(wid) >= 4) __builtin_amdgcn_s_setprio(1);
  char* V_lds = lds; char* K_lds = lds + 2 * SHM_V;
  float* wsl = (float*)(lds + 2 * SHM_V + 2 * SHM_K) + wid * 64; float* li_l = wsl; float* al_l = wsl + 32;
  float m_reg = BAND ? -1e5f : -1e30f, l_reg = 0; f32x16 o[4] = {}; bf16x8 qr[8];
  const int uq = u0 + wid * QBLK + r32;
  const bf16_t* Qw = Qb + (long)(wid * QBLK + r32) * rs + hi * 8;
#pragma unroll
  for (int d0 = 0; d0 < 8; ++d0) qr[d0] = *reinterpret_cast<const bf16x8*>(Qw + d0 * 16);
  const int sr = tid >> 4, sc = (tid & 15) * 8, vst0 = v_st(sr, sc), vst1 = v_st(32 + sr, sc);
  const int vb0 = (int)(uintptr_t)V_lds + v_rd_base(lane);
  struct { bf16x8 vs0, vs1, ks0, ks1; } sr_[2];
#define KROW(k) (BAND ? (long)min(max(ubase + (k), 0), L - 1) * rs : (long)(k) * rs)
#define SLOAD(i, k0) do { const long ra_ = KROW((k0) + sr) + sc, rb_ = KROW((k0) + 32 + sr) + sc; \
    sr_[i].vs0 = *reinterpret_cast<const bf16x8*>(Vh + ra_); sr_[i].vs1 = *reinterpret_cast<const bf16x8*>(Vh + rb_); \
    sr_[i].ks0 = *reinterpret_cast<const bf16x8*>(Kh + ra_); sr_[i].ks1 = *reinterpret_cast<const bf16x8*>(Kh + rb_); } while (0)
#define SWRITE(b, i) do { *(bf16x8*)(V_lds + (b) * SHM_V + vst0) = sr_[i].vs0;          \
    *(bf16x8*)(V_lds + (b) * SHM_V + vst1) = sr_[i].vs1; const int kc = sc * 2;               \
    *(bf16x8*)(K_lds + (b) * SHM_K + KSWZ(sr, kc)) = sr_[i].ks0;                       \
    *(bf16x8*)(K_lds + (b) * SHM_K + KSWZ(32 + sr, kc)) = sr_[i].ks1; } while (0)
#define SWAIT() asm volatile("s_waitcnt vmcnt(4)" ::: "memory")
#define RESC(a) do { if (__any((a) < 1.f)) { if (hi == 0) al_l[r32] = (a); asm volatile("s_waitcnt lgkmcnt(0)" ::: "memory"); \
    _Pragma("unroll") for (int d = 0; d < 4; ++d) _Pragma("unroll") for (int r = 0; r < 16; ++r) o[d][r] *= al_l[crow(r, hi)]; } } while (0)
  f32x16 pA0, pA1, pB0, pB1; float mnA, mnB, alA, alB; bf16x8 pa0, pa1, pa2, pa3;
  constexpr int SE = 0, SO = 1;
  SLOAD(SE, 0); SLOAD(SO, KVBLK); SWAIT(); SWRITE(0, SE); __syncthreads();
  qkt(pA0, pA1, K_lds, qr, r32, hi); partialSM<BAND>(pA0, pA1, m_reg, mnA, alA, ubase, uq, L, sl, hi);
  if (2 < NT) SLOAD(SE, 2 * KVBLK);
  SWAIT(); SWRITE(1, SO); __syncthreads();
  for (int j = 1; j + 1 < NT; j += 2) {
    SBAR(); qkt(pB0, pB1, K_lds + SHM_K, qr, r32, hi);
    finishSM(pA0, pA1, alA, l_reg, pa0, pa1, pa2, pa3); SBAR();
    SLOAD(SO, (j + 2) * KVBLK); SBAR();
    pv_d0(o, vb0, pa0, pa1, pa2, pa3); partialSM<BAND>(pB0, pB1, m_reg, mnB, alB, ubase + j * KVBLK, uq, L, sl, hi);
    __syncthreads(); SWAIT(); SWRITE(0, SE);
    RESC(alB); __syncthreads();
    SBAR(); qkt(pA0, pA1, K_lds, qr, r32, hi);
    finishSM(pB0, pB1, alB, l_reg, pa0, pa1, pa2, pa3); SBAR();
    if (j + 3 < NT) SLOAD(SE, (j + 3) * KVBLK); SBAR();
    pv_d0(o, vb0 + (int)SHM_V, pa0, pa1, pa2, pa3); partialSM<BAND>(pA0, pA1, m_reg, mnA, alA, ubase + (j + 1) * KVBLK, uq, L, sl, hi);
    __syncthreads(); SWAIT(); SWRITE(1, SO);
    RESC(alA); __syncthreads();
  }
  SBAR(); qkt(pB0, pB1, K_lds + SHM_K, qr, r32, hi);
  finishSM(pA0, pA1, alA, l_reg, pa0, pa1, pa2, pa3); SBAR();
  pv_d0(o, vb0, pa0, pa1, pa2, pa3); partialSM<BAND>(pB0, pB1, m_reg, mnB, alB, ubase + (NT - 1) * KVBLK, uq, L, sl, hi);
  __syncthreads(); RESC(alB);
  finishSM(pB0, pB1, alB, l_reg, pa0, pa1, pa2, pa3); SBAR();
  pv_d0(o, vb0 + (int)SHM_V, pa0, pa1, pa2, pa3);
  __builtin_amdgcn_s_setprio(0);
  if (hi == 0) li_l[r32] = l_reg; asm volatile("s_waitcnt lgkmcnt(0)" ::: "memory");
  float rli[16];
#pragma unroll
  for (int r = 0; r < 16; ++r) rli[r] = __builtin_amdgcn_rcpf(li_l[crow(r, hi)]);
  if (!do_store) return;
  if constexpr (BAND) {
    if (hi == 0) Lp[(long)(wid * QBLK + r32) * lse_stride] = m_reg * SCALE + __logf(l_reg);
    store_tile_rows(o, rli, lds + EPI_LDS_OFF + wid * 8192, r32, hi, lane, Ob + (long)(wid * QBLK) * rs, rs, nullptr, 0);
  } else {
    bf16_t* Ow = Ob + (long)(wid * QBLK) * YW; const bf16_t* Gw = Gb + (long)(wid * QBLK) * INW;
#pragma unroll
    for (int r = 0; r < 16; ++r) { const long orow = crow(r, hi);
#pragma unroll
      for (int d0 = 0; d0 < 4; ++d0) { const float g = bf2f(Gw[orow * INW + d0 * 32 + r32]);
        Ow[orow * YW + d0 * 32 + r32] = (bf16_t)(cvtpk(o[d0][r] * rli[r] * g, 0.f) & 0xffffu); } }
  }
#undef KROW
#undef SLOAD
#undef SWRITE
#undef SWAIT
#undef RESC
}
}


namespace a8 {
typedef int v8i __attribute__((ext_vector_type(8)));
typedef int v4i __attribute__((ext_vector_type(4)));
constexpr float PSHIFT = 7.f, CAP = 8.5f;
constexpr int TILE_B = 8192;
#define A8_MFMA(a, b, c) __builtin_amdgcn_mfma_scale_f32_32x32x64_f8f6f4((a), (b), (c), 0, 0, 0, 0, 0, 0)
__device__ __forceinline__ v8i cat8(v4i a, v4i b) { return (v8i){a[0], a[1], a[2], a[3], b[0], b[1], b[2], b[3]}; }
__device__ __forceinline__ void partialSM(f32x16& p0, f32x16& p1, float& pm, f32x16& negM, float& alpha) {
  float dmax = p0[0];
#pragma unroll
  for (int r = 1; r < 16; ++r) dmax = fmaxf(dmax, p0[r]);
#pragma unroll
  for (int r = 0; r < 16; ++r) dmax = fmaxf(dmax, p1[r]);
  { auto rr = __builtin_amdgcn_permlane32_swap(__float_as_uint(dmax), __float_as_uint(dmax), false, false);
    dmax = fmaxf(__uint_as_float(rr[0]), __uint_as_float(rr[1])); }
  if (__builtin_expect(__all(dmax <= CAP), 1)) { alpha = 1.f; }
  else { const float delta = fmaxf(dmax - PSHIFT, 0.f); alpha = __builtin_amdgcn_exp2f(-delta); pm += delta;
#pragma unroll
    for (int r = 0; r < 16; ++r) { p0[r] -= delta; p1[r] -= delta; }
    const float nm = -pm;
#pragma unroll
    for (int r = 0; r < 16; ++r) negM[r] = nm; }
#pragma unroll
  for (int r = 0; r < 16; ++r) p0[r] = __builtin_amdgcn_exp2f(p0[r]);
}
__device__ __forceinline__ void finishSM(f32x16& p0, f32x16& p1, v8i& pa) {
#pragma unroll
  for (int r = 0; r < 16; ++r) p1[r] = __builtin_amdgcn_exp2f(p1[r]);
#pragma unroll
  for (int v = 0; v < 4; ++v) { int w = __builtin_amdgcn_cvt_pk_fp8_f32(p0[4 * v], p0[4 * v + 1], 0, false); pa[v] = __builtin_amdgcn_cvt_pk_fp8_f32(p0[4 * v + 2], p0[4 * v + 3], w, true); }
#pragma unroll
  for (int v = 0; v < 4; ++v) { int w = __builtin_amdgcn_cvt_pk_fp8_f32(p1[4 * v], p1[4 * v + 1], 0, false); pa[4 + v] = __builtin_amdgcn_cvt_pk_fp8_f32(p1[4 * v + 2], p1[4 * v + 3], w, true); }
}
__device__ __forceinline__ void qkt(f32x16& p0, f32x16& p1, const f32x16& negM, const char* Ks, v8i q0, v8i q1, int kb, int ko00, int ko01, int ko10, int ko11) {
  const v4i a00 = *(const v4i*)(Ks + kb + ko00), a01 = *(const v4i*)(Ks + kb + ko01), a10 = *(const v4i*)(Ks + kb + ko10), a11 = *(const v4i*)(Ks + kb + ko11);
  const v4i b00 = *(const v4i*)(Ks + 4096 + kb + ko00), b01 = *(const v4i*)(Ks + 4096 + kb + ko01), b10 = *(const v4i*)(Ks + 4096 + kb + ko10), b11 = *(const v4i*)(Ks + 4096 + kb + ko11);
  p0 = A8_MFMA(cat8(a00, a01), q0, negM); p1 = A8_MFMA(cat8(b00, b01), q0, negM);
  p0 = A8_MFMA(cat8(a10, a11), q1, p0); p1 = A8_MFMA(cat8(b10, b11), q1, p1);
}
__device__ __forceinline__ void pv(f32x16* o, const char* Vs, v8i pa, const char* onesp, int vb, int vo0, int vo1) {
  const v8i ones = cat8(*(const v4i*)(onesp), *(const v4i*)(onesp + 16));
  const v4i x0 = *(const v4i*)(Vs + vb + vo0), y0 = *(const v4i*)(Vs + vb + vo1), x1 = *(const v4i*)(Vs + 2048 + vb + vo0), y1 = *(const v4i*)(Vs + 2048 + vb + vo1);
  const v4i x2 = *(const v4i*)(Vs + 4096 + vb + vo0), y2 = *(const v4i*)(Vs + 4096 + vb + vo1), x3 = *(const v4i*)(Vs + 6144 + vb + vo0), y3 = *(const v4i*)(Vs + 6144 + vb + vo1);
  o[4] = A8_MFMA(pa, ones, o[4]);
  o[0] = A8_MFMA(pa, cat8(x0, y0), o[0]); o[1] = A8_MFMA(pa, cat8(x1, y1), o[1]); o[2] = A8_MFMA(pa, cat8(x2, y2), o[2]); o[3] = A8_MFMA(pa, cat8(x3, y3), o[3]);
}
__device__ __forceinline__ void attn_body(const unsigned char* Q8, const unsigned char* K8, const unsigned char* V8T, int NT, bf16_t* Ob, const unsigned char* Gb, char* lds) {
  using at::crow;
  const int tid = fresh_tid(), wid = tid >> 6, lane = tid & 63, r32 = lane & 31, hi = lane >> 5;
  if (__builtin_amdgcn_readfirstlane(wid) >= 4) __builtin_amdgcn_s_setprio(1);
  char* V_lds = lds; char* K_lds = lds + 2 * TILE_B;
  float* al_l = (float*)(lds + 4 * TILE_B) + wid * 32;
  float pm = -PSHIFT; f32x16 o[5] = {}; f32x16 negM;
#pragma unroll
  for (int r = 0; r < 16; ++r) negM[r] = PSHIFT;
  { int t_; asm volatile("v_mov_b32 %0, 0x38383838" : "=v"(t_)); *(int*)(lds + 4 * TILE_B + 1024 + tid * 4) = t_; }
  const char* ones = lds + 4 * TILE_B + 1024 + lane * 32;
  v8i q0, q1;
  { const unsigned char* Qw = Q8 + (long)(wid * 32 + r32) * 1024 + hi * 32;
    q0 = cat8(*(const v4i*)(Qw), *(const v4i*)(Qw + 16)); q1 = cat8(*(const v4i*)(Qw + 64), *(const v4i*)(Qw + 80)); }
  const int kb = r32 * 128, ksw = (r32 >> 1) & 7;
  const int ko00 = ((2 * hi) ^ ksw) << 4, ko01 = ((2 * hi + 1) ^ ksw) << 4, ko10 = ((4 + 2 * hi) ^ ksw) << 4, ko11 = ((5 + 2 * hi) ^ ksw) << 4;
  const int vb = r32 * 64, vsw = (r32 >> 2) & 3, vo0 = ((2 * hi) ^ vsw) << 4, vo1 = ((2 * hi + 1) ^ vsw) << 4;
  const int krow = tid >> 3, kst = krow * 128 + (((tid & 7) ^ ((krow >> 1) & 7)) << 4);
  const int vd = tid >> 2, vst = vd * 64 + (((tid & 3) ^ ((vd >> 2) & 3)) << 4);
  const unsigned char* Kg = K8 + tid * 16; const unsigned char* Vg = V8T + tid * 16;
  struct { v4i k, v; } sr_[2];
#define SLOAD(i, t) do { sr_[i].k = *(const v4i*)(Kg + (long)(t) * TILE_B); sr_[i].v = *(const v4i*)(Vg + (long)(t) * TILE_B); } while (0)
#define SWRITE(b, i) do { *(v4i*)(K_lds + (b) * TILE_B + kst) = sr_[i].k; *(v4i*)(V_lds + (b) * TILE_B + vst) = sr_[i].v; } while (0)
#define SWAIT() asm volatile("s_waitcnt vmcnt(2)" ::: "memory")
#define RESC(a) do { if (__any((a) < 1.f)) { if (hi == 0) al_l[r32] = (a); asm volatile("s_waitcnt lgkmcnt(0)" ::: "memory"); \
    _Pragma("unroll") for (int d = 0; d < 5; ++d) _Pragma("unroll") for (int r = 0; r < 16; ++r) o[d][r] *= al_l[crow(r, hi)]; } } while (0)
  f32x16 pA0, pA1, pB0, pB1; float alA, alB; v8i pa;
  constexpr int SE = 0, SO = 1;
  SLOAD(SE, 0); SLOAD(SO, 1); SWAIT(); SWRITE(0, SE); __syncthreads();
  qkt(pA0, pA1, negM, K_lds, q0, q1, kb, ko00, ko01, ko10, ko11); partialSM(pA0, pA1, pm, negM, alA);
  if (2 < NT) SLOAD(SE, 2);
  SWAIT(); SWRITE(1, SO); __syncthreads();
  for (int j = 1; j + 1 < NT; j += 2) {
    SBAR(); qkt(pB0, pB1, negM, K_lds + TILE_B, q0, q1, kb, ko00, ko01, ko10, ko11);
    finishSM(pA0, pA1, pa); SBAR();
    SLOAD(SO, j + 2); SBAR();
    pv(o, V_lds, pa, ones, vb, vo0, vo1); partialSM(pB0, pB1, pm, negM, alB);
    __syncthreads(); SWAIT(); SWRITE(0, SE);
    RESC(alB); __syncthreads();
    SBAR(); qkt(pA0, pA1, negM, K_lds, q0, q1, kb, ko00, ko01, ko10, ko11);
    finishSM(pB0, pB1, pa); SBAR();
    if (j + 3 < NT) SLOAD(SE, j + 3); SBAR();
    pv(o, V_lds + TILE_B, pa, ones, vb, vo0, vo1); partialSM(pA0, pA1, pm, negM, alA);
    __syncthreads(); SWAIT(); SWRITE(1, SO);
    RESC(alA); __syncthreads();
  }
  SBAR(); qkt(pB0, pB1, negM, K_lds + TILE_B, q0, q1, kb, ko00, ko01, ko10, ko11);
  finishSM(pA0, pA1, pa); SBAR();
  pv(o, V_lds, pa, ones, vb, vo0, vo1); partialSM(pB0, pB1, pm, negM, alB);
  __syncthreads(); RESC(alB);
  finishSM(pB0, pB1, pa); SBAR();
  pv(o, V_lds + TILE_B, pa, ones, vb, vo0, vo1);
  __builtin_amdgcn_s_setprio(0);
  float rli[16];
#pragma unroll
  for (int r = 0; r < 16; ++r) rli[r] = __builtin_amdgcn_rcpf(o[4][r]);
  store_tile_rows(o, rli, lds + EPI_LDS_OFF + wid * 8192, r32, hi, lane, Ob + (long)(wid * 32) * YW, YW, Gb + (long)(wid * 32) * (INW * 2), INW * 2);
#undef SLOAD
#undef SWRITE
#undef SWAIT
#undef RESC
}
}

#if DBG_NAIVE_A || DBG_NAIVE_B
__device__ __forceinline__ void naive_row(const bf16_t* qrow, const bf16_t* Kb, const bf16_t* Vb, long rs, int first, int count, int uc, float sl, int lane, float& m, float& l, float& o0, float& o1) {
  const unsigned qw = *(const unsigned*)(qrow + 2 * lane); const float q0 = bflo(qw), q1 = bfhi(qw);
  m = -1e30f; l = 0.f; o0 = 0.f; o1 = 0.f;
  for (int i = first; i < first + count; ++i) {
    const unsigned kw = *(const unsigned*)(Kb + (long)i * rs + 2 * lane), vw = *(const unsigned*)(Vb + (long)i * rs + 2 * lane);
    float s = q0 * bflo(kw) + q1 * bfhi(kw);
#pragma unroll
    for (int off = 1; off < 64; off <<= 1) s += __shfl_xor(s, off);
    s = s * 0.088388347648318440f - sl * fabsf((float)(i - uc));
    const float mn = fmaxf(m, s), a = __expf(m - mn), p = __expf(s - mn);
    l = l * a + p; o0 = o0 * a + p * bflo(vw); o1 = o1 * a + p * bfhi(vw); m = mn;
  }
}
#endif

#define XB_TMO      128
#define XB_XCNT(j)  (256  + 64 * (j))
#define XB_XSUB(j)  (1280 + 64 * (j))
#define XB_XGEN(j)  (2304 + 64 * (j))
#define XB_TOP      3328
#define XB_TOPGEN   3392
#define XCD_BAR_WORDS 3456
#define XB_SPIN_CAP (1u << 20)
__device__ __forceinline__ unsigned xb_ld(unsigned* p)              { return __hip_atomic_load(p, __ATOMIC_RELAXED, __HIP_MEMORY_SCOPE_AGENT); }
__device__ __forceinline__ unsigned xb_add(unsigned* p, unsigned v) { return __hip_atomic_fetch_add(p, v, __ATOMIC_RELAXED, __HIP_MEMORY_SCOPE_AGENT); }
__device__ __forceinline__ unsigned xb_xcc_id() { return (unsigned)__builtin_amdgcn_s_getreg((3 << 11) | 20) & 0xFu; }
#define XB_SPIN(cond, bar) do { unsigned _sp = 0; while (cond) { __builtin_amdgcn_s_sleep(1); \
    if ((++_sp & 255u) == 0u) { if (xb_ld(&(bar)[XB_TMO])) break; if (_sp > XB_SPIN_CAP) { atomicAdd(&(bar)[XB_TMO], 1u); break; } } } } while (0)
struct XcdBarrier { unsigned* bar; unsigned x; volatile LAS unsigned* st; };
__device__ __forceinline__ XcdBarrier xcd_barrier_post(unsigned* bar, volatile LAS unsigned* st) {
  XcdBarrier b; b.bar = bar; b.x = xb_xcc_id(); b.st = st;
  if (threadIdx.x == 0) (void)xb_add(&bar[XB_XCNT(b.x)], 1u);
  return b;
}
__device__ __forceinline__ void xcd_barrier_complete(unsigned* bar, unsigned x, unsigned& nloc, unsigned& nx) {
  const unsigned G = gridDim.x * gridDim.y * gridDim.z;
  unsigned sum, cnt, mine, sp = 0u;
  for (;;) {
    sum = 0u; cnt = 0u; mine = 0u;
#pragma unroll
    for (unsigned j = 0; j < 16; ++j) { const unsigned c = xb_ld(&bar[XB_XCNT(j)]); sum += c; cnt += (c > 0u) ? 1u : 0u; mine = (j == x) ? c : mine; }
    if (sum == G) break;
    __builtin_amdgcn_s_sleep(1);
    if ((++sp & 255u) == 0u) { if (xb_ld(&bar[XB_TMO])) break; if (sp > XB_SPIN_CAP) { atomicAdd(&bar[XB_TMO], 1u); break; } }
  }
  nloc = mine > 0u ? mine : 1u; nx = cnt > 0u ? cnt : 1u;
}
__device__ __forceinline__ void xcd_barrier(const XcdBarrier& b) {
  asm volatile("s_waitcnt vmcnt(0)" ::: "memory");
  __syncthreads();
  if (threadIdx.x == 0) {
    unsigned* bar = b.bar;
    __builtin_amdgcn_s_waitcnt(0);
    unsigned nloc = b.st[0], nx = b.st[1];
    if (nloc == 0u) { xcd_barrier_complete(bar, b.x, nloc, nx); b.st[0] = nloc; b.st[1] = nx; }
    const unsigned old = xb_add(&bar[XB_XSUB(b.x)], 1u);
    const unsigned gen = old / nloc;
    if (old + 1u == (gen + 1u) * nloc) {
      __builtin_amdgcn_fence(__ATOMIC_RELEASE, "agent");
      asm volatile("s_waitcnt vmcnt(0)" ::: "memory");
      const unsigned og = xb_add(&bar[XB_TOP], 1u);
      const unsigned tg = og / nx;
      if (og + 1u == (tg + 1u) * nx) xb_add(&bar[XB_TOPGEN], 1u);
      else XB_SPIN(xb_ld(&bar[XB_TOPGEN]) == tg, bar);
      __builtin_amdgcn_fence(__ATOMIC_ACQUIRE, "agent");
      xb_add(&bar[XB_XGEN(b.x)], 1u);
      asm volatile("s_waitcnt vmcnt(0)" ::: "memory");
    } else {
      XB_SPIN(xb_ld(&bar[XB_XGEN(b.x)]) == gen, bar);
      __builtin_amdgcn_fence(__ATOMIC_ACQUIRE, "agent");
      asm volatile("s_waitcnt vmcnt(0)" ::: "memory");
    }
  }
  __syncthreads();
}

__device__ __forceinline__ float wave_sum(float v) {
#pragma unroll
  for (int o = 1; o < 64; o <<= 1) v += __shfl_xor(v, o);
  return v;
}
__device__ __forceinline__ void transpose_item(const float* W, int N, bf16_t* WT, int ldt, int koff, LAS float* scr, int item, int lane) {
  const int nblk = N / 32, kb = item / nblk, nb = item % nblk, k0 = 64 * kb, n0 = 32 * nb;
#pragma unroll
  for (int i = 0; i < 8; ++i) { const int kk = 8 * i + (lane >> 3), n4 = (lane & 7) * 4;
    const f32x4 w = *(const f32x4*)(W + (size_t)(k0 + kk) * N + n0 + n4);
    scr[kk * 33 + n4] = w[0]; scr[kk * 33 + n4 + 1] = w[1]; scr[kk * 33 + n4 + 2] = w[2]; scr[kk * 33 + n4 + 3] = w[3]; }
  asm volatile("s_waitcnt lgkmcnt(0)" ::: "memory");
  const int c = lane & 7;
#pragma unroll
  for (int j = 0; j < 4; ++j) { const int n = (lane >> 3) + 8 * j; const LAS float* s = scr + (8 * c) * 33 + n;
    u32x4 o; o.x = cvtpk(s[0 * 33], s[1 * 33]); o.y = cvtpk(s[2 * 33], s[3 * 33]); o.z = cvtpk(s[4 * 33], s[5 * 33]); o.w = cvtpk(s[6 * 33], s[7 * 33]);
    *(u32x4*)(WT + (size_t)(n0 + n) * ldt + koff + k0 + 8 * c) = o; }
  asm volatile("s_waitcnt lgkmcnt(0)" ::: "memory");
}

__device__ __forceinline__ void transpose_item8(const float* W, int N, unsigned char* WT, int ldt, float wscale, LAS float* scr, int item, int lane) {
  const int nblk = N / 32, kb = item / nblk, nb = item % nblk, k0 = 64 * kb, n0 = 32 * nb;
#pragma unroll
  for (int i = 0; i < 8; ++i) { const int kk = 8 * i + (lane >> 3), n4 = (lane & 7) * 4;
    const f32x4 w = *(const f32x4*)(W + (size_t)(k0 + kk) * N + n0 + n4) * wscale;
    scr[kk * 33 + n4] = w[0]; scr[kk * 33 + n4 + 1] = w[1]; scr[kk * 33 + n4 + 2] = w[2]; scr[kk * 33 + n4 + 3] = w[3]; }
  asm volatile("s_waitcnt lgkmcnt(0)" ::: "memory");
  const int c = lane & 7;
#pragma unroll
  for (int j = 0; j < 4; ++j) { const int n = (lane >> 3) + 8 * j; const LAS float* s = scr + (8 * c) * 33 + n;
    u32x2 o; o.x = pk4_fp8(s[0 * 33], s[1 * 33], s[2 * 33], s[3 * 33]); o.y = pk4_fp8(s[4 * 33], s[5 * 33], s[6 * 33], s[7 * 33]);
    *(u32x2*)(WT + (size_t)(n0 + n) * ldt + k0 + 8 * c) = o; }
  asm volatile("s_waitcnt lgkmcnt(0)" ::: "memory");
}
__device__ __forceinline__ void sincos_d(double a, double& s, double& c) {
  const double q = rint(a * 0.63661977236758134308);
  double r = fma(-q, 1.57079632679489655800e+00, a); r = fma(-q, 6.12323399573676603587e-17, r);
  const int qi = ((int)q) & 3; const double r2 = r * r;
  const double sp = r + r * r2 * (-1.0 / 6 + r2 * (1.0 / 120 + r2 * (-1.0 / 5040 + r2 * (1.0 / 362880 + r2 * (-1.0 / 39916800 + r2 * (1.0 / 6227020800.0 + r2 * (-1.0 / 1307674368000.0)))))));
  const double cp = 1.0 + r2 * (-0.5 + r2 * (1.0 / 24 + r2 * (-1.0 / 720 + r2 * (1.0 / 40320 + r2 * (-1.0 / 3628800 + r2 * (1.0 / 479001600 + r2 * (-1.0 / 87178291200.0 + r2 * (1.0 / 20922789888000.0))))))));
  s = (qi == 0) ? sp : (qi == 1) ? cp : (qi == 2) ? -sp : -cp;
  c = (qi == 0) ? cp : (qi == 1) ? -sp : (qi == 2) ? -cp : sp;
}
__device__ __forceinline__ void convert_x(const float* x, bf16_t* xb, int gtid, int gthreads) {
  for (int i = gtid; i < CT * DM / 8; i += gthreads) {
    const f32x4 a = *(const f32x4*)(x + (size_t)i * 8), b = *(const f32x4*)(x + (size_t)i * 8 + 4);
#if USE_FP8_P1
    u32x2 w; w.x = pk4_fp8(a[0], a[1], a[2], a[3]); w.y = pk4_fp8(b[0], b[1], b[2], b[3]);
    *(u32x2*)((unsigned char*)xb + (size_t)i * 8) = w; }
#else
    u32x4 w; w.x = cvtpk(a[0], a[1]); w.y = cvtpk(a[2], a[3]); w.z = cvtpk(b[0], b[1]); w.w = cvtpk(b[2], b[3]);
    *(u32x4*)(xb + (size_t)i * 8) = w; }
#endif
}

__global__ void __launch_bounds__(512, 2) fwd_megakernel(Params p) {
  extern __shared__ __attribute__((aligned(16))) unsigned char smem[];
  cg::grid_group grid = cg::this_grid();
  const int G = gridDim.x, cb = blockIdx.x, NGW = G * 8, gthreads = G * 512;
  volatile LAS unsigned* xst = (volatile LAS unsigned*)((LAS unsigned char*)smem + 131 * 1024);
  if (threadIdx.x == 0) { xst[0] = 0u; xst[1] = 0u; }
  __syncthreads();
  const XcdBarrier xb = xcd_barrier_post((unsigned*)(p.ws + WS_BAR), xst);
#define GSYNC() xcd_barrier(xb)
#define THIN_IDS() const int tid = fresh_tid(), wid = tid >> 6, lane = tid & 63, gw = cb * 8 + wid, gtid = cb * 512 + tid; (void)gw; (void)gtid; (void)lane
  bf16_t* WIN = (bf16_t*)(p.ws + WS_WIN); bf16_t* WAB = (bf16_t*)(p.ws + WS_WAB); bf16_t* WO = (bf16_t*)(p.ws + WS_WO);
  bf16_t* XB = (bf16_t*)(p.ws + WS_XB); bf16_t* T = XB; bf16_t* H = (bf16_t*)(p.ws + WS_H); bf16_t* Y = (bf16_t*)(p.ws + WS_Y);
  unsigned char* Q8 = (unsigned char*)(p.ws + WS_Q8); unsigned char* K8 = (unsigned char*)(p.ws + WS_K8); unsigned char* V8T = (unsigned char*)(p.ws + WS_V8T);
  bf16_t* MRG = (bf16_t*)(p.ws + WS_MRG); float* LSE = (float*)(p.ws + WS_LSE); float* ROPE = (float*)(p.ws + WS_ROPE);

  {
    THIN_IDS();
    LAS float* scr = (LAS float*)((LAS unsigned char*)smem + wid * 8704);
    constexpr int I_IN = (DM / 64) * (INW / 32), I_A = (512 / 64) * (DM / 32), I_B = (DM / 64) * (DM / 32), I_O = I_B, I_L = I_IN + I_A + I_B + I_O;
    for (int it = gw; it < 2 * I_L; it += NGW) {
      const int l = it / I_L; int r = it % I_L;
#if USE_FP8_P1
      if (r < I_IN) { transpose_item8(p.w_in + (size_t)l * DM * INW, INW, (unsigned char*)WIN + (size_t)l * INW * DM, DM, 32.f, scr, r, lane); continue; } r -= I_IN;
#else
      if (r < I_IN) { transpose_item(p.w_in + (size_t)l * DM * INW, INW, WIN + (size_t)l * INW * DM, DM, 0, scr, r, lane); continue; } r -= I_IN;
#endif
      if (r < I_A) { transpose_item(p.w_pa + (size_t)l * 512 * DM, DM, WAB + (size_t)l * DM * YW, YW, 0, scr, r, lane); continue; } r -= I_A;
      if (r < I_B) { transpose_item(p.w_pb + (size_t)l * DM * DM, DM, WAB + (size_t)l * DM * YW, YW, 512, scr, r, lane); continue; } r -= I_B;
      transpose_item(p.w_out + (size_t)l * DM * DM, DM, WO + (size_t)l * DM * DM, DM, 0, scr, r, lane);
    }
    for (int e = gtid; e < 256 * 32; e += gthreads) { const int pos = e >> 5, i = e & 31;
      const float inv = exp2f(-(float)i * (13.287712379549449f / 32.f));
      const float ang = (float)pos * inv; double s, c; sincos_d((double)ang, s, c);
      ROPE[e * 2] = (float)c; ROPE[e * 2 + 1] = (float)s; }
    convert_x(p.x_prompt, XB, gtid, gthreads);
  }
  grid.sync();

#pragma unroll 1
  for (int ch = 0; ch < NCH; ++ch) {
    const int S = (ch < 2) ? 8192 : 16384;
    const float* xin = (ch < 2) ? p.x_prompt + (size_t)ch * CT * DM : p.x_sample;
    float* outc = p.out + (size_t)ch * CT * DM;
#pragma unroll 1
    for (int l = 0; l < DEPTH; ++l) {
#if USE_FP8_P1
      { pg8::SchedStd s; s.nM = CT / 256; s.nN = INW / 256; s.G = G; s.c = cb; s.lda = DM / 2; s.ldb = DM / 2; s.nt = DM / 128; s.A = (const char*)XB; s.B = (const char*)WIN + (size_t)l * INW * DM;
        pg8::EpiIn e; e.H = H; e.bias = p.b_in + (size_t)l * INW; e.ascale = 1.f / 32.f;
        for (int rep = 0; rep < DBG_REP_P1; ++rep) pg8::gemm_phase<pg8::EpiIn, pg8::SchedStd, true>(( LAS unsigned char*)smem, s, e); }
#else
      { pg8::SchedStd s; s.nM = CT / 256; s.nN = INW / 256; s.G = G; s.c = cb; s.lda = DM; s.ldb = DM; s.nt = DM / 64; s.A = (const char*)XB; s.B = (const char*)(WIN + (size_t)l * INW * DM);
        pg8::EpiIn e; e.H = H; e.bias = p.b_in + (size_t)l * INW; e.ascale = 1.f;
        for (int rep = 0; rep < DBG_REP_P1; ++rep) pg8::gemm_phase(( LAS unsigned char*)smem, s, e); }
#endif
      GSYNC();
      {
        { THIN_IDS();
        const float* qg = p.q_gain + l * 128; const float* kg = p.k_gain + l * 128;
        const int l16 = lane & 15;
        for (int idx0 = gw * 4 + (lane >> 4); idx0 < CT * 10; idx0 += NGW * 16) {
          const unsigned char* ptr[4]; u32x2 w[4]; bool ok[4]; int tokk[4], hhk[4];
#pragma unroll
          for (int k = 0; k < 4; ++k) { const int idx = idx0 + k * NGW * 4; ok[k] = idx < CT * 10; const int idc = ok[k] ? idx : idx0;
            tokk[k] = idc / 10; hhk[k] = idc % 10;
            const int boff = (hhk[k] < 8 ? C_BQ * 2 + hhk[k] * 128 : C_BK * 2 + (hhk[k] - 8) * 128) + l16 * 8;
            ptr[k] = (const unsigned char*)H + (size_t)tokk[k] * (INW * 2) + boff; w[k] = *(const u32x2*)ptr[k]; }
#pragma unroll
          for (int k = 0; k < 4; ++k) {
            float v[8]; fp8x4_to_f32(w[k].x, v); fp8x4_to_f32(w[k].y, v + 4);
            float ss = 0.f;
#pragma unroll
            for (int j = 0; j < 8; ++j) ss += v[j] * v[j];
            ss += __shfl_xor(ss, 1); ss += __shfl_xor(ss, 2); ss += __shfl_xor(ss, 4); ss += __shfl_xor(ss, 8);
            const float rms = rsqrtf(ss * (1.f / 128.f) + RMS_EPS);
            const float* gp = (hhk[k] < 8 ? qg : kg) + l16 * 8;
            const int tpos = tokk[k] & (S - 1);
            const int pos = (l16 < 8) ? (tpos >> 6) : (tpos & 63);
            const f32x4* rt = (const f32x4*)(ROPE + ((size_t)pos * 32 + (l16 & 3) * 8) * 2);
            const f32x4 g0 = *(const f32x4*)gp, g1 = *(const f32x4*)(gp + 4);
            const float gg[8] = {g0[0], g0[1], g0[2], g0[3], g1[0], g1[1], g1[2], g1[3]};
            float o[8];
#pragma unroll
            for (int j = 0; j < 8; ++j) v[j] = v[j] * rms * gg[j];
#pragma unroll
            for (int j2 = 0; j2 < 4; ++j2) { const f32x4 cs = rt[j2];
              const float pr0 = __shfl_xor(v[2 * j2], 4), pr1 = __shfl_xor(v[2 * j2 + 1], 4);
              o[2 * j2] = v[2 * j2] * cs[0] + ((l16 & 4) ? pr0 : -pr0) * cs[1];
              o[2 * j2 + 1] = v[2 * j2 + 1] * cs[2] + ((l16 & 4) ? pr1 : -pr1) * cs[3]; }
            u32x4 wo; wo.x = cvtpk(o[0], o[1]); wo.y = cvtpk(o[2], o[3]); wo.z = cvtpk(o[4], o[5]); wo.w = cvtpk(o[6], o[7]);
            if (ok[k]) {
#if USE_FP8_B
#pragma unroll
              for (int j = 0; j < 8; ++j) o[j] *= 0.35709583f;
              u32x2 w8; int t0 = __builtin_amdgcn_cvt_pk_fp8_f32(o[0], o[1], 0, false); w8.x = (unsigned)__builtin_amdgcn_cvt_pk_fp8_f32(o[2], o[3], t0, true);
              int t1 = __builtin_amdgcn_cvt_pk_fp8_f32(o[4], o[5], 0, false); w8.y = (unsigned)__builtin_amdgcn_cvt_pk_fp8_f32(o[6], o[7], t1, true);
              unsigned char* d8 = (hhk[k] < 8) ? Q8 + (size_t)tokk[k] * 1024 + hhk[k] * 128 + l16 * 8 : K8 + ((size_t)(hhk[k] - 8) * CT + tokk[k]) * 128 + l16 * 8;
              *(u32x2*)d8 = w8;
#else
              (void)wo;
#endif
            }
          }
        } }
#if USE_FP8_B
        { THIN_IDS();
          const int kk = lane & 31, khi = (kk >> 2) & 1, slot = khi * 32 + (kk & 3) + 4 * (kk >> 3) + 16 * (lane >> 5);
          for (int it = gw; it < 2 * (CT / 64); it += NGW) {
            const int kvh = it / (CT / 64), tl = it % (CT / 64);
            const unsigned char* vrow = (const unsigned char*)H + (size_t)(tl * 64 + lane) * (INW * 2) + C_BV * 2 + kvh * 128;
            unsigned char* dst = V8T + ((size_t)(kvh * (CT / 64) + tl) * 128) * 64 + slot;
#pragma unroll 4
            for (int d8 = 0; d8 < 16; ++d8) { const u32x2 w = *(const u32x2*)(vrow + d8 * 8);
#pragma unroll
              for (int j = 0; j < 8; ++j) dst[(d8 * 8 + j) * 64] = (unsigned char)(((j < 4 ? w.x : w.y) >> (8 * (j & 3))) & 0xff); }
          } }
#endif
#if DBG_NAIVE_A
        { THIN_IDS();
          for (int idx = gw; idx < CT * 12; idx += NGW) {
            const int tok = idx / 12, gh = idx % 12, g = gh >> 2;
            const int dil = (g == 0) ? 1 : (g == 1) ? 4 : 16, L = S / dil;
            const int seq = tok / S, tp = tok % S, r = tp % dil, u = tp / dil;
            const float slope = exp2f(-8.f * (float)(gh + 1) / 12.f);
            const size_t tok0 = (size_t)seq * S + r; const long rs = (long)dil * INW;
            bf16_t* qrow = H + (size_t)tok * INW + C_AQ + gh * 128;
            const int first = max(u - 64, 0), last = min(u + 64, L - 1);
            float m, l, o0, o1;
            naive_row(qrow, H + tok0 * INW + C_AK + gh * 128, H + tok0 * INW + C_AV + gh * 128, rs, first, last - first + 1, u, slope * (float)dil, lane, m, l, o0, o1);
            *(unsigned*)(qrow + 2 * lane) = cvtpk(o0 / l, o1 / l);
            if (lane == 0) LSE[(size_t)tok * 12 + gh] = m + __logf(l);
          } }
        for (int it = 64 * 12; it < 64 * 12; it += G) {
#else
        for (int rep = 0; rep < DBG_REP_A; ++rep)
        for (int it = cb; it < 64 * 12; it += G) {
#endif
          const int bi = it / 12, gh = it % 12, g = gh >> 2, hs = gh & 3;
          const int dil = (g == 0) ? 1 : (g == 1) ? 4 : 16, L = S / dil, bpc = L / 256;
          const int bps = S / 256, seq = bi / bps, w = bi % bps, r = w / bpc, u0 = (w % bpc) * 256;
          const float slope = exp2f(-8.f * (float)(gh + 1) / 12.f);
          const float sl = slope * (float)dil / at::SCALE;
          const size_t tok0 = (size_t)seq * S + r;
          bf16_t* Qh = H + tok0 * INW + C_AQ + gh * 128;
          const bf16_t* Kh = H + tok0 * INW + C_AK + gh * 128; const bf16_t* Vh = H + tok0 * INW + C_AV + gh * 128;
          const long rs = (long)dil * INW;
          __syncthreads();
          at::attn_body<true>(Qh + (long)u0 * rs, Kh, Vh, rs, 6, u0 - 64, u0, L, sl, Qh + (long)u0 * rs, nullptr,
                              LSE + (tok0 + (size_t)u0 * dil) * 12 + gh, (long)dil * 12, (char*)smem, rep == DBG_REP_A - 1);
        }
      }
      GSYNC();
      {
        const int bps = S / 256;
#if DBG_NAIVE_B
        { THIN_IDS();
          for (int idx = gw; idx < CT * 8; idx += NGW) {
            const int tok = idx >> 3, h = idx & 7, seq = tok / S; const size_t tok0 = (size_t)seq * S;
            float m, l, o0, o1;
            naive_row(H + (size_t)tok * INW + C_BQ + h * 128, H + tok0 * INW + C_BK + (h >> 2) * 128, H + tok0 * INW + C_BV + (h >> 2) * 128, (long)INW, 0, S, 0, 0.f, lane, m, l, o0, o1);
            const unsigned gw_ = *(const unsigned*)(H + (size_t)tok * INW + C_BG + h * 128 + 2 * lane);
            *(unsigned*)(Y + (size_t)tok * YW + 512 + h * 128 + 2 * lane) = cvtpk(o0 / l * bflo(gw_), o1 / l * bfhi(gw_));
          } }
        for (int it = 64 * 8; it < 64 * 8; it += G) {
#else
        for (int rep = 0; rep < DBG_REP_B; ++rep)
        for (int it = cb; it < 64 * 8; it += G) {
#endif
          int qb, h, seq;
          if (G == 256) {
            const int x = cb & 7, idx = (x >> 1) * 64 + (cb >> 3) * 2 + (it >> 8), qblk = idx & 63;
            h = (x & 1) * 4 + (idx >> 6); seq = qblk / bps; qb = qblk % bps;
          } else { qb = it % bps; const int sh = it / bps; h = sh & 7; seq = sh >> 3; }
          const size_t tok0 = (size_t)seq * S, row0 = tok0 + (size_t)qb * 256;
#if DBG_NO_B
          { const int t_ = fresh_tid(); for (int e = t_; e < 256 * 16; e += 512) { u32x4 z = {0u, 0u, 0u, 0u}; *(u32x4*)(Y + (row0 + (e >> 4)) * YW + 512 + h * 128 + (e & 15) * 8) = z; } }
#else
          __syncthreads();
#if USE_FP8_B
          a8::attn_body(Q8 + row0 * 1024 + h * 128, K8 + ((size_t)(h >> 2) * CT + tok0) * 128, V8T + ((size_t)(h >> 2) * (CT / 64) + tok0 / 64) * 8192, S / 64,
                        Y + row0 * YW + 512 + h * 128, (const unsigned char*)H + row0 * (INW * 2) + C_BG * 2 + h * 128, (char*)smem);
#else
          at::attn_body<false>(H + row0 * INW + C_BQ + h * 128, H + tok0 * INW + C_BK + (h >> 2) * 128, H + tok0 * INW + C_BV + (h >> 2) * 128, (long)INW, S / 64,
                               0, 0, 0, 0.f, Y + row0 * YW + 512 + h * 128, H + row0 * INW + C_BG + h * 128, nullptr, 0, (char*)smem);
#endif
#endif
        }
        THIN_IDS();
        const int l16 = lane & 15;
        for (int rep = 0; rep < DBG_REP_C; ++rep)
        for (int idx0 = gw * 4 + (lane >> 4); idx0 < CT * 4; idx0 += NGW * 16) {
          float l0[4], l1[4], l2[4]; u32x4 a[4], b[4], c[4], gt[4]; int tokk[4], hsk[4]; bool ok[4];
#pragma unroll
          for (int k = 0; k < 4; ++k) { const int idx = idx0 + k * NGW * 4; ok[k] = idx < CT * 4; const int idc = ok[k] ? idx : idx0; tokk[k] = idc >> 2; hsk[k] = idc & 3;
            const float* lp = LSE + (size_t)tokk[k] * 12 + hsk[k]; l0[k] = lp[0]; l1[k] = lp[4]; l2[k] = lp[8];
            const bf16_t* hp = H + (size_t)tokk[k] * INW + hsk[k] * 128 + l16 * 8;
            a[k] = *(const u32x4*)(hp); b[k] = *(const u32x4*)(hp + 512); c[k] = *(const u32x4*)(hp + 1024); gt[k] = *(const u32x4*)(hp + C_AG); }
#pragma unroll
          for (int k = 0; k < 4; ++k) {
            const float mx = fmaxf(l0[k], fmaxf(l1[k], l2[k]));
            float e0 = __expf(l0[k] - mx), e1 = __expf(l1[k] - mx), e2 = __expf(l2[k] - mx);
            const float inv = 1.f / (e0 + e1 + e2); e0 *= inv; e1 *= inv; e2 *= inv;
            float o[8];
#define CMB(j, W, HL) o[j] = (e0 * HL(a[k].W) + e1 * HL(b[k].W) + e2 * HL(c[k].W)) * HL(gt[k].W)
            CMB(0, x, bflo); CMB(1, x, bfhi); CMB(2, y, bflo); CMB(3, y, bfhi); CMB(4, z, bflo); CMB(5, z, bfhi); CMB(6, w, bflo); CMB(7, w, bfhi);
#undef CMB
            u32x4 wo; wo.x = cvtpk(o[0], o[1]); wo.y = cvtpk(o[2], o[3]); wo.z = cvtpk(o[4], o[5]); wo.w = cvtpk(o[6], o[7]);
            if (ok[k]) *(u32x4*)(Y + (size_t)tokk[k] * YW + hsk[k] * 128 + l16 * 8) = wo;
          }
        }
      }
      GSYNC();
      { pg8::SchedMerge s; s.nM = CT / 256; s.nN = DM / 256; s.G = G; s.c = cb; s.lda = YW; s.ldb = YW; s.A = (const char*)Y; s.B = (const char*)(WAB + (size_t)l * DM * YW);
        pg8::EpiMerge e; e.H = H; e.T = T; e.MRG = MRG;
        for (int rep = 0; rep < DBG_REP_P4; ++rep) pg8::gemm_phase((LAS unsigned char*)smem, s, e); }
      GSYNC();
#if USE_LN_FUSED
      if (G == 256) {
      { pg8::SchedStd s; s.nM = CT / 256; s.nN = DM / 256; s.G = G; s.c = cb; s.lda = DM; s.ldb = DM; s.nt = DM / 64; s.A = (const char*)MRG; s.B = (const char*)(WO + (size_t)l * DM * DM);
        pg8::EpiLN e; e.X = (l == 0) ? xin : (const float*)outc; e.Yo = outc; e.XB8 = (unsigned char*)XB; e.g = p.ln_g + l * DM; e.b = p.ln_b + l * DM;
        e.slots = (unsigned long long*)(p.ws + WS_LNX); e.cnt = (unsigned*)(p.ws + WS_LNC) + (size_t)(ch * DEPTH + l) * 64 * 64; e.write_xb = (l == 0);
        pg8::gemm_phase((LAS unsigned char*)smem, s, e); }
      if (l == DEPTH - 1 && ch + 1 < NCH) { THIN_IDS(); convert_x((ch + 1 < 2) ? p.x_prompt + (size_t)(ch + 1) * CT * DM : p.x_sample, XB, gtid, gthreads); }
      GSYNC();
      } else
#endif
      {
      { pg8::SchedStd s; s.nM = CT / 256; s.nN = DM / 256; s.G = G; s.c = cb; s.lda = DM; s.ldb = DM; s.nt = DM / 64; s.A = (const char*)MRG; s.B = (const char*)(WO + (size_t)l * DM * DM);
        pg8::EpiOut e; e.X = (l == 0) ? xin : (const float*)outc; e.Z = outc;
        pg8::gemm_phase((LAS unsigned char*)smem, s, e); }
      GSYNC();
      {
        THIN_IDS();
        const float* gmm = p.ln_g + l * DM; const float* bta = p.ln_b + l * DM;
        f32x4 gv[4], bv[4];
#pragma unroll
        for (int j = 0; j < 4; ++j) { gv[j] = *(const f32x4*)(gmm + (j * 64 + lane) * 4); bv[j] = *(const f32x4*)(bta + (j * 64 + lane) * 4); }
        for (int row0 = gw; row0 < CT; row0 += NGW * 4) {
          f32x4 v[4][4];
#pragma unroll
          for (int k = 0; k < 4; ++k) { const int row = min(row0 + k * NGW, CT - 1); const float* zr = outc + (size_t)row * DM;
#pragma unroll
            for (int j = 0; j < 4; ++j) v[k][j] = *(const f32x4*)(zr + (j * 64 + lane) * 4); }
#pragma unroll
          for (int k = 0; k < 4; ++k) { const int row = row0 + k * NGW; float* zr = outc + (size_t)min(row, CT - 1) * DM;
            float s = 0.f;
#pragma unroll
            for (int j = 0; j < 4; ++j) s += (v[k][j][0] + v[k][j][1]) + (v[k][j][2] + v[k][j][3]);
            const float mean = wave_sum(s) * (1.f / DM); float s2 = 0.f;
#pragma unroll
            for (int j = 0; j < 4; ++j) { v[k][j] = v[k][j] - mean; s2 += (v[k][j][0] * v[k][j][0] + v[k][j][1] * v[k][j][1]) + (v[k][j][2] * v[k][j][2] + v[k][j][3] * v[k][j][3]); }
            const float rstd = rsqrtf(wave_sum(s2) * (1.f / DM) + LN_EPS);
            if (row < CT) {
#pragma unroll
              for (int j = 0; j < 4; ++j) { const f32x4 y = v[k][j] * rstd * gv[j] + bv[j]; *(f32x4*)(zr + (j * 64 + lane) * 4) = y;
#if USE_FP8_P1
                if (l == 0) *(unsigned*)((unsigned char*)XB + (size_t)row * DM + (j * 64 + lane) * 4) = pk4_fp8(y[0], y[1], y[2], y[3]); } }
#else
                if (l == 0) { u32x2 w; w.x = cvtpk(y[0], y[1]); w.y = cvtpk(y[2], y[3]); *(u32x2*)(XB + (size_t)row * DM + (j * 64 + lane) * 4) = w; } } }
#endif
          }
        }
        if (l == DEPTH - 1 && ch + 1 < NCH) convert_x((ch + 1 < 2) ? p.x_prompt + (size_t)(ch + 1) * CT * DM : p.x_sample, XB, gtid, gthreads);
      }
      GSYNC();
      }
    }
  }
}

extern "C" void kernel_launch(void* const* d_in, const int* in_sizes, int n_in, void* d_out, int out_size, void* d_ws, size_t ws_size, hipStream_t stream) {
  static int grid_blocks = 0;
  if (grid_blocks == 0) {
    if (n_in != 11 || out_size != NCH * CT * DM || ws_size < WS_END) { fprintf(stderr, "kernel_launch: unexpected shapes n_in %d out %d ws %zu (need %zu)\n", n_in, out_size, ws_size, (size_t)WS_END); grid_blocks = -1; return; }
    int dev = 0, cus = 0, per_cu = 0;
    hipGetDevice(&dev);
    hipDeviceGetAttribute(&cus, hipDeviceAttributeMultiprocessorCount, dev);
    if (hipFuncSetAttribute((const void*)fwd_megakernel, hipFuncAttributeMaxDynamicSharedMemorySize, LDS_BYTES) != hipSuccess) { fprintf(stderr, "kernel_launch: hipFuncSetAttribute failed\n"); grid_blocks = -1; return; }
    hipOccupancyMaxActiveBlocksPerMultiprocessor(&per_cu, (const void*)fwd_megakernel, 512, LDS_BYTES);
    if (per_cu < 1) { fprintf(stderr, "kernel_launch: occupancy query says %d blocks per CU\n", per_cu); per_cu = 1; }
    (void)hipGetLastError();
    grid_blocks = cus;
  }
  if (grid_blocks < 0) return;
  Params p{};
  p.x_prompt = (const float*)d_in[0]; p.x_sample = (const float*)d_in[1]; p.w_in = (const float*)d_in[2]; p.b_in = (const float*)d_in[3];
  p.q_gain = (const float*)d_in[4]; p.k_gain = (const float*)d_in[5]; p.w_pa = (const float*)d_in[6]; p.w_pb = (const float*)d_in[7];
  p.w_out = (const float*)d_in[8]; p.ln_g = (const float*)d_in[9]; p.ln_b = (const float*)d_in[10];
  p.out = (float*)d_out; p.ws = (char*)d_ws;
  if (hipMemsetAsync((char*)d_ws + WS_BAR, 0, WS_ZERO_END - WS_BAR, stream) != hipSuccess) { fprintf(stderr, "kernel_launch: memset of the barrier words failed\n"); return; }
  void* args[] = {&p};
  hipError_t e = hipLaunchCooperativeKernel((const void*)fwd_megakernel, dim3(grid_blocks), dim3(512), args, LDS_BYTES, stream);
  if (e != hipSuccess) fprintf(stderr, "cooperative launch failed: %s (grid %d)\n", hipGetErrorString(e), grid_blocks);
}
```

```cpp
#include <hip/hip_runtime.h>
#include <hip/hip_cooperative_groups.h>
#include <cstdio>
#include <cstdint>
namespace cg = cooperative_groups;

#define LAS __attribute__((address_space(3)))
typedef unsigned short bf16_t;
typedef short bf16x8 __attribute__((ext_vector_type(8)));
typedef short s16x4 __attribute__((ext_vector_type(4)));
typedef float f32x4 __attribute__((ext_vector_type(4)));
typedef float f32x16 __attribute__((ext_vector_type(16)));
typedef unsigned u32x4 __attribute__((ext_vector_type(4)));
typedef unsigned u32x2 __attribute__((ext_vector_type(2)));
typedef int v4i_t __attribute__((ext_vector_type(4)));
typedef int v8i_t __attribute__((ext_vector_type(8)));

constexpr int DM = 1024, INW = 9728, CT = 16384, NCH = 3, DEPTH = 2;
constexpr int C_AQ = 0, C_AK = 1536, C_AV = 3072, C_AG = 4608, C_BQ = 5120, C_BK = 6144, C_BV = 6400, C_BG = 6656, C_GA = 7680, C_GB = 8704;
constexpr int YW = 1536;
constexpr float ALPHA = 1.41421356237309515f;
constexpr float RMS_EPS = 1e-6f, LN_EPS = 1e-5f;
constexpr size_t WS_WIN = 0;
constexpr size_t WS_WAB = WS_WIN + (size_t)2 * INW * DM * 2;
constexpr size_t WS_WO  = WS_WAB + (size_t)2 * DM * YW * 2;
constexpr size_t WS_XB  = WS_WO + (size_t)2 * DM * DM * 2;
constexpr size_t WS_H   = WS_XB + (size_t)CT * DM * 2;
constexpr size_t WS_Y   = WS_H + (size_t)CT * INW * 2;
constexpr size_t WS_MRG = WS_Y + (size_t)CT * YW * 2;
constexpr size_t WS_LSE = WS_MRG + (size_t)CT * DM * 2;
constexpr size_t WS_ROPE = WS_LSE + (size_t)CT * 12 * 4;
constexpr size_t WS_BAR = WS_ROPE + 256 * 32 * 2 * 4;
constexpr size_t WS_LNC = (WS_BAR + 3456 * 4 + 255) / 256 * 256;
constexpr size_t WS_ZERO_END = WS_LNC + (size_t)6 * 64 * 64 * 4;
constexpr size_t WS_LNX = WS_ZERO_END;
constexpr size_t WS_Q8  = (WS_LNX + (size_t)CT * 4 * 8 + 255) / 256 * 256;
constexpr size_t WS_K8  = WS_Q8 + (size_t)CT * 1024;
constexpr size_t WS_V8T = WS_K8 + (size_t)2 * CT * 128;
constexpr size_t WS_END = WS_V8T + (size_t)2 * CT * 128;
constexpr int LDS_BYTES = 132 * 1024;
#ifndef USE_LN_FUSED
#define USE_LN_FUSED 1
#endif
#ifndef USE_FP8_P1
#define USE_FP8_P1 1
#endif
#ifndef USE_FP8_B
#define USE_FP8_B 1
#endif
#ifndef DBG_UNIFORM
#define DBG_UNIFORM 0
#endif
#ifndef DBG_NAIVE_A
#define DBG_NAIVE_A 0
#endif
#ifndef DBG_NAIVE_B
#define DBG_NAIVE_B 0
#endif
#ifndef DBG_REP_A
#define DBG_REP_A 1
#endif
#ifndef DBG_REP_P4
#define DBG_REP_P4 1
#endif
#ifndef DBG_REP_C
#define DBG_REP_C 1
#endif
#ifndef DBG_REP_P1
#define DBG_REP_P1 1
#endif
#ifndef DBG_REP_B
#define DBG_REP_B 1
#endif
#ifndef DBG_NO_B
#define DBG_NO_B 0
#endif

struct Params {
  const float *x_prompt, *x_sample, *w_in, *b_in, *q_gain, *k_gain, *w_pa, *w_pb, *w_out, *ln_g, *ln_b;
  float* out; char* ws;
};

__device__ __forceinline__ int fresh_tid() { int t = threadIdx.x; asm volatile("" : "+v"(t)); return t; }
__device__ __forceinline__ unsigned cvtpk(float lo, float hi) { unsigned r; asm volatile("v_cvt_pk_bf16_f32 %0, %1, %2" : "=v"(r) : "v"(lo), "v"(hi)); return r; }
__device__ __forceinline__ float bflo(unsigned w) { return __uint_as_float(w << 16); }
__device__ __forceinline__ float bfhi(unsigned w) { return __uint_as_float(w & 0xffff0000u); }
__device__ __forceinline__ float bf2f(bf16_t b) { return __uint_as_float(((unsigned)b) << 16); }
__device__ __forceinline__ unsigned pk4_fp8(float a, float b, float c, float d) { const int t = __builtin_amdgcn_cvt_pk_fp8_f32(a, b, 0, false); return (unsigned)__builtin_amdgcn_cvt_pk_fp8_f32(c, d, t, true); }
typedef float f32x2_t __attribute__((ext_vector_type(2)));
__device__ __forceinline__ void fp8x4_to_f32(unsigned w, float* o) { const f32x2_t lo = __builtin_amdgcn_cvt_pk_f32_fp8((int)w, false), hi = __builtin_amdgcn_cvt_pk_f32_fp8((int)w, true); o[0] = lo[0]; o[1] = lo[1]; o[2] = hi[0]; o[3] = hi[1]; }
__device__ __forceinline__ float sigmoidf_(float x) { return __builtin_amdgcn_rcpf(1.f + __builtin_amdgcn_exp2f(-1.4426950408889634f * x)); }

namespace pg8 {
constexpr int BM = 256, BK = 64, HALF = 128, HTB = HALF * BK * 2, STAGE_BYTES = 8 * HTB, NXCD = 8, WGM = 8;
__device__ __forceinline__ int lds_byte(int r, int c) { const int st = (r >> 4) * 2 + (c >> 5), rr = r & 15, cc = c & 31, ob = rr * 64 + cc * 2; return st * 1024 + (ob ^ (((ob >> 9) & 1) << 5)); }
__device__ __forceinline__ void stage_rc(int b, int& R, int& C) { const int st = b / 1024, sb = b % 1024, swz = sb ^ (((sb >> 9) & 1) << 5); R = (st >> 1) * 16 + swz / 64; C = (st & 1) * 32 + (swz % 64) / 2; }
__device__ __forceinline__ int perm32(int rho) { const int n = rho >> 4, i = rho & 15; return 8 * (i >> 2) + 4 * n + (i & 3); }
struct Unit { int pm, pn, kind; };
__device__ __forceinline__ bool tile_of(int L, int nM, int nN, int& pm, int& pn) {
  const int nwg = nM * nN; if (L >= nwg) return false;
  int wgid = L; { const int q = nwg / NXCD, r = nwg % NXCD, xcd = wgid % NXCD, off = wgid / NXCD; wgid = (xcd < r ? xcd * (q + 1) : r * (q + 1) + (xcd - r) * q) + off; }
  const int nig = WGM * nN, gid = wgid / nig, fm = gid * WGM, gsz = (nM - fm) < WGM ? (nM - fm) : WGM;
  pm = fm + ((wgid % nig) % gsz); pn = (wgid % nig) / gsz; return true;
}
struct SchedStd {
  int nM, nN, G, c, lda, ldb, nt; const char *A, *B;
  __device__ __forceinline__ bool next(int i, Unit& u) const { u.kind = 0; return tile_of(i * G + c, nM, nN, u.pm, u.pn); }
  __device__ __forceinline__ void op(const Unit& u, const char*& a, const char*& b, int& n) const { a = A + (size_t)u.pm * BM * lda * 2; b = B + (size_t)u.pn * BM * ldb * 2; n = nt; }
};
struct SchedMerge {
  int nM, nN, G, c, lda, ldb; const char *A, *B;
  __device__ __forceinline__ bool next(int i, Unit& u) const { u.kind = i & 1; return tile_of((i >> 1) * G + c, nM, nN, u.pm, u.pn); }
  __device__ __forceinline__ void op(const Unit& u, const char*& a, const char*& b, int& n) const {
    a = A + (size_t)u.pm * BM * lda * 2 + (u.kind ? 1024 : 0); b = B + (size_t)u.pn * BM * ldb * 2 + (u.kind ? 1024 : 0); n = u.kind ? 16 : 8; }
};

struct EpiIn {
  static __device__ __forceinline__ bool keep_acc(const Unit&) { return false; }
  static constexpr bool AFTER_DRAIN = false;
  static constexpr bool PERM = true;
  bf16_t* H; const float* bias; float ascale;
  __device__ __forceinline__ void operator()(const f32x4 (&acc)[2][2][4][2], const Unit& u, int wr, int wc, int fr, int fq) const {
    const int row0 = u.pm * BM + wr * 64 + fr, col0 = u.pn * BM + wc * 32 + 8 * fq;
    const int act = (u.pn >= 30) ? 2 : (((u.pn >= 18 && u.pn < 20) || (u.pn >= 26)) ? 1 : 0);
    const bool f8 = (u.pn >= 20 && u.pn < 30) || (u.pn >= 34);
    const int fs = (u.pn < 24) ? C_BQ : (u.pn == 24) ? C_BK : (u.pn == 25) ? C_BV : (u.pn < 30) ? C_BG : C_GB;
    f32x4 bv[2][2];
#pragma unroll
    for (int bj = 0; bj < 2; ++bj)
#pragma unroll
      for (int n = 0; n < 2; ++n) bv[bj][n] = *(const f32x4*)(bias + col0 + bj * HALF + 4 * n);
#pragma unroll
    for (int ai = 0; ai < 2; ++ai)
#pragma unroll
      for (int m = 0; m < 4; ++m) { bf16_t* rowp = H + (size_t)(row0 + ai * HALF + m * 16) * INW + col0;
#pragma unroll
        for (int bj = 0; bj < 2; ++bj) { f32x4 v0 = acc[ai][bj][m][0] * ascale + bv[bj][0], v1 = acc[ai][bj][m][1] * ascale + bv[bj][1];
          if (act) {
#pragma unroll
            for (int j = 0; j < 4; ++j) { const float s0 = sigmoidf_(v0[j]), s1 = sigmoidf_(v1[j]); v0[j] = (act == 1) ? v0[j] * s0 : s0; v1[j] = (act == 1) ? v1[j] * s1 : s1; } }
          if (f8) { u32x2 w8; w8.x = pk4_fp8(v0[0], v0[1], v0[2], v0[3]); w8.y = pk4_fp8(v1[0], v1[1], v1[2], v1[3]);
            *(u32x2*)((unsigned char*)H + (size_t)(row0 + ai * HALF + m * 16) * (INW * 2) + fs * 2 + (col0 - fs) + bj * HALF) = w8; }
          else { u32x4 w; w.x = cvtpk(v0[0], v0[1]); w.y = cvtpk(v0[2], v0[3]); w.z = cvtpk(v1[0], v1[1]); w.w = cvtpk(v1[2], v1[3]);
            *(u32x4*)(rowp + bj * HALF) = w; } } }
  }
};
struct EpiMerge {
  static constexpr bool AFTER_DRAIN = false;
  static constexpr bool PERM = true;
  const bf16_t* H; bf16_t* T; bf16_t* MRG;
  static __device__ __forceinline__ bool keep_acc(const Unit& u) { return u.kind == 0; }
  __device__ __forceinline__ void operator()(f32x4 (&acc)[2][2][4][2], const Unit& u, int wr, int wc, int fr, int fq) const {
    const int row0 = u.pm * BM + wr * 64 + fr, col0 = u.pn * BM + wc * 32 + 8 * fq;
#pragma unroll
    for (int ai = 0; ai < 2; ++ai)
#pragma unroll
      for (int m = 0; m < 4; ++m) { const size_t row = (size_t)(row0 + ai * HALF + m * 16);
#pragma unroll
        for (int bj = 0; bj < 2; ++bj) {
          float gb[8];
          { const u32x2 g8 = *(const u32x2*)((const unsigned char*)H + row * (INW * 2) + C_GB * 2 + col0 + bj * HALF); fp8x4_to_f32(g8.x, gb); fp8x4_to_f32(g8.y, gb + 4); }
#pragma unroll
          for (int j = 0; j < 8; ++j) gb[j] = fmaxf(gb[j], 9.765625e-4f);
          if (u.kind == 0) {
            const u32x4 g = *(const u32x4*)(H + row * INW + C_GA + col0 + bj * HALF);
            const float ga[8] = {bflo(g.x), bfhi(g.x), bflo(g.y), bfhi(g.y), bflo(g.z), bfhi(g.z), bflo(g.w), bfhi(g.w)};
#pragma unroll
            for (int j = 0; j < 4; ++j) { acc[ai][bj][m][0][j] *= ga[j] * __builtin_amdgcn_rcpf(gb[j]); acc[ai][bj][m][1][j] *= ga[4 + j] * __builtin_amdgcn_rcpf(gb[4 + j]); }
          } else {
            const f32x4 a0 = acc[ai][bj][m][0], a1 = acc[ai][bj][m][1];
            u32x4 w; w.x = cvtpk(a0[0] * gb[0], a0[1] * gb[1]); w.y = cvtpk(a0[2] * gb[2], a0[3] * gb[3]); w.z = cvtpk(a1[0] * gb[4], a1[1] * gb[5]); w.w = cvtpk(a1[2] * gb[6], a1[3] * gb[7]);
            *(u32x4*)(MRG + row * DM + col0 + bj * HALF) = w; } } }
  }
};
struct EpiOut {
  static __device__ __forceinline__ bool keep_acc(const Unit&) { return false; }
  static constexpr bool AFTER_DRAIN = false;
  static constexpr bool PERM = true;
  const float* X; float* Z;
  __device__ __forceinline__ void operator()(const f32x4 (&acc)[2][2][4][2], const Unit& u, int wr, int wc, int fr, int fq) const {
    const int row0 = u.pm * BM + wr * 64 + fr, col0 = u.pn * BM + wc * 32 + 8 * fq;
#pragma unroll
    for (int ai = 0; ai < 2; ++ai)
#pragma unroll
      for (int m = 0; m < 4; ++m) { const size_t off = (size_t)(row0 + ai * HALF + m * 16) * DM + col0;
#pragma unroll
        for (int bj = 0; bj < 2; ++bj)
#pragma unroll
          for (int n = 0; n < 2; ++n) { const f32x4 xv = *(const f32x4*)(X + off + bj * HALF + n * 4); *(f32x4*)(Z + off + bj * HALF + n * 4) = xv * ALPHA + acc[ai][bj][m][n]; } }
  }
};


struct EpiLN {
  static __device__ __forceinline__ bool keep_acc(const Unit&) { return false; }
  static constexpr bool PERM = true, AFTER_DRAIN = true;
  const float* X; float* Yo; unsigned char* XB8; const float* g; const float* b; unsigned long long* slots; unsigned* cnt; int write_xb;
  __device__ __forceinline__ void fused(f32x4 (&acc)[2][2][4][2], const Unit& u, int wr, int wc, int fr, int fq, LAS unsigned char* lds, int wid, int lane) const {
    typedef float f32x2v __attribute__((ext_vector_type(2)));
    LAS f32x2v* P = (LAS f32x2v*)lds;
    LAS f32x2v* S = (LAS f32x2v*)(lds + 8192);
    const int col0 = u.pn * BM + wc * 32 + 8 * fq;
#pragma unroll
    for (int ai = 0; ai < 2; ++ai)
#pragma unroll
      for (int m = 0; m < 4; ++m) { const int rl = ai * HALF + wr * 64 + m * 16 + fr; const size_t off = (size_t)(u.pm * BM + rl) * DM + col0;
        float s1 = 0.f, s2 = 0.f;
#pragma unroll
        for (int bj = 0; bj < 2; ++bj)
#pragma unroll
          for (int n = 0; n < 2; ++n) { const f32x4 xv = *(const f32x4*)(X + off + bj * HALF + n * 4); const f32x4 z = xv * ALPHA + acc[ai][bj][m][n]; acc[ai][bj][m][n] = z;
            s1 += (z[0] + z[1]) + (z[2] + z[3]); s2 += (z[0] * z[0] + z[1] * z[1]) + (z[2] * z[2] + z[3] * z[3]); }
        s1 += __shfl_xor(s1, 16); s1 += __shfl_xor(s1, 32); s2 += __shfl_xor(s2, 16); s2 += __shfl_xor(s2, 32);
        if (fq == 0) P[rl * 4 + wc] = (f32x2v){s1, s2};
        asm volatile("" ::: "memory"); }
    asm volatile("s_waitcnt lgkmcnt(0)" ::: "memory"); __builtin_amdgcn_s_barrier(); asm volatile("" ::: "memory");
    const int t = wid * 64 + lane;
    if (t < 256) { const f32x2v a = P[t * 4 + 0], b2 = P[t * 4 + 1], c = P[t * 4 + 2], d = P[t * 4 + 3];
      const float m1 = (a.x + b2.x) + (c.x + d.x), m2 = (a.y + b2.y) + (c.y + d.y);
      __hip_atomic_store(slots + ((size_t)(u.pm * BM + t) * 4 + u.pn), ((unsigned long long)__float_as_uint(m2) << 32) | __float_as_uint(m1), __ATOMIC_RELAXED, __HIP_MEMORY_SCOPE_AGENT); }
    asm volatile("s_waitcnt vmcnt(0)" ::: "memory"); __builtin_amdgcn_s_barrier(); asm volatile("" ::: "memory");
    if (t == 0) { __hip_atomic_fetch_add(cnt + 64 * u.pm, 1u, __ATOMIC_RELAXED, __HIP_MEMORY_SCOPE_AGENT);
      unsigned sp = 0; while (__hip_atomic_load(cnt + 64 * u.pm, __ATOMIC_RELAXED, __HIP_MEMORY_SCOPE_AGENT) < 4u) { __builtin_amdgcn_s_sleep(2); if (++sp > (1u << 22)) break; }
      __builtin_amdgcn_fence(__ATOMIC_ACQUIRE, "agent"); asm volatile("s_waitcnt vmcnt(0)" ::: "memory"); }
    __builtin_amdgcn_s_barrier(); asm volatile("" ::: "memory");
    if (t < 256) { const unsigned long long* sl = slots + (size_t)(u.pm * BM + t) * 4; float m1 = 0.f, m2 = 0.f;
#pragma unroll
      for (int q = 0; q < 4; ++q) { const unsigned long long w = __hip_atomic_load(sl + q, __ATOMIC_RELAXED, __HIP_MEMORY_SCOPE_AGENT); m1 += __uint_as_float((unsigned)w); m2 += __uint_as_float((unsigned)(w >> 32)); }
      const float mean = m1 * (1.f / DM), var = fmaxf(m2 * (1.f / DM) - mean * mean, 0.f);
      S[t] = (f32x2v){mean, rsqrtf(var + LN_EPS)}; }
    asm volatile("s_waitcnt lgkmcnt(0)" ::: "memory"); __builtin_amdgcn_s_barrier(); asm volatile("" ::: "memory");
#pragma unroll
    for (int bj = 0; bj < 2; ++bj)
#pragma unroll
      for (int n = 0; n < 2; ++n) { const f32x4 gv = *(const f32x4*)(g + col0 + bj * HALF + n * 4), bv = *(const f32x4*)(b + col0 + bj * HALF + n * 4);
#pragma unroll
        for (int ai = 0; ai < 2; ++ai)
#pragma unroll
          for (int m = 0; m < 4; ++m) { const int rl = ai * HALF + wr * 64 + m * 16 + fr; const f32x2v st = S[rl]; const size_t row = (size_t)(u.pm * BM + rl);
            const f32x4 y = (acc[ai][bj][m][n] - st.x) * st.y * gv + bv;
            *(f32x4*)(Yo + row * DM + col0 + bj * HALF + n * 4) = y;
            if (write_xb) *(unsigned*)(XB8 + row * DM + col0 + bj * HALF + n * 4) = pk4_fp8(y[0], y[1], y[2], y[3]); } }
  }
};

template <class Epi, class Sched, bool FP8 = false>
__device__ __forceinline__ void gemm_phase(LAS unsigned char* lds, const Sched& S, const Epi& E) {
  const int tid = fresh_tid(), wid = __builtin_amdgcn_readfirstlane(tid >> 6), lane = tid & 63, wr = wid >> 2, wc = wid & 3, fr = lane & 15, fq = lane >> 4;
  const int lda = S.lda, ldb = S.ldb;
  unsigned voffA[2], voffB[2];
#pragma unroll
  for (int i = 0; i < 2; ++i) { int R, C; stage_rc(tid * 16 + i * 8192, R, C); const int Rb = Epi::PERM ? ((R & ~31) + perm32(R & 31)) : R;
    voffA[i] = (unsigned)(R * lda + C) * 2u; voffB[i] = (unsigned)(Rb * ldb + C) * 2u; }
  const size_t kstep = (size_t)(BK * 2);
  const size_t hstepA = (size_t)HALF * lda * 2, hstepB = (size_t)HALF * ldb * 2;
  const unsigned ldsw = (unsigned)wid * 1024u;
  const int aoff = lds_byte(wr * 64 + fr, fq * 8), boff = lds_byte(wc * 32 + fr, fq * 8);
#define PG8_SA(b, h) (((b) * 2 + (h)) * HTB)
#define PG8_SB(b, h) ((4 + (b) * 2 + (h)) * HTB)
#define PG8_STAGE(bufoff, gbase, voff) do { _Pragma("unroll") for (int _i = 0; _i < 2; ++_i) \
    __builtin_amdgcn_global_load_lds((const unsigned*)((const char*)(gbase) + (voff)[_i]), (LAS unsigned*)(lds + (bufoff) + ldsw + _i * 8192), 16, 0, 0); } while (0)
#define PG8_LDA(dst, b, h) do { if constexpr (FP8) { _Pragma("unroll") for (int m = 0; m < 4; ++m) dst##8[m] = __builtin_shufflevector(*(const LAS v4i_t*)(lds + PG8_SA(b, h) + aoff + m * 2048), *(const LAS v4i_t*)(lds + PG8_SA(b, h) + aoff + m * 2048 + 1024), 0, 1, 2, 3, 4, 5, 6, 7); } \
    else { _Pragma("unroll") for (int m = 0; m < 4; ++m) _Pragma("unroll") for (int k = 0; k < 2; ++k) dst[m][k] = *(const LAS bf16x8*)(lds + PG8_SA(b, h) + aoff + m * 2048 + k * 1024); } } while (0)
#define PG8_LDB(dst, b, h) do { if constexpr (FP8) { _Pragma("unroll") for (int n = 0; n < 2; ++n) dst##8[n] = __builtin_shufflevector(*(const LAS v4i_t*)(lds + PG8_SB(b, h) + boff + n * 2048), *(const LAS v4i_t*)(lds + PG8_SB(b, h) + boff + n * 2048 + 1024), 0, 1, 2, 3, 4, 5, 6, 7); } \
    else { _Pragma("unroll") for (int n = 0; n < 2; ++n) _Pragma("unroll") for (int k = 0; k < 2; ++k) dst[n][k] = *(const LAS bf16x8*)(lds + PG8_SB(b, h) + boff + n * 2048 + k * 1024); } } while (0)
#define PG8_CAT(x, y) __builtin_shufflevector(__builtin_bit_cast(v4i_t, x), __builtin_bit_cast(v4i_t, y), 0, 1, 2, 3, 4, 5, 6, 7)
#define PG8_MMA(ai, bj, At, Bt) do { __builtin_amdgcn_s_setprio(1); \
    if constexpr (FP8) { _Pragma("unroll") for (int m = 0; m < 4; ++m) _Pragma("unroll") for (int n = 0; n < 2; ++n) \
      asm volatile("v_mfma_f32_16x16x128_f8f6f4 %0, %1, %2, %0" : "+v"(acc[ai][bj][m][n]) : "v"(Bt##8[n]), "v"(At##8[m])); } \
    else { _Pragma("unroll") for (int m = 0; m < 4; ++m) _Pragma("unroll") for (int n = 0; n < 2; ++n) _Pragma("unroll") for (int k = 0; k < 2; ++k) \
      acc[ai][bj][m][n] = __builtin_amdgcn_mfma_f32_16x16x32_bf16(Bt[n][k], At[m][k], acc[ai][bj][m][n], 0, 0, 0); } \
    __builtin_amdgcn_s_setprio(0); } while (0)
#define PG8_WAIT_V(n) asm volatile("s_waitcnt vmcnt(" #n ")" ::: "memory")
#define PG8_WAIT_L(n) asm volatile("s_waitcnt lgkmcnt(" #n ")" ::: "memory")
#define PG8_BAR __builtin_amdgcn_s_barrier()
#define PG8_SCHED __builtin_amdgcn_sched_barrier(0)
  Unit cur, nxt; int ui = 0;
  if (!S.next(0, cur)) return;
  f32x4 acc[2][2][4][2];
#pragma unroll
  for (int a = 0; a < 2; ++a)
#pragma unroll
    for (int b = 0; b < 2; ++b)
#pragma unroll
      for (int m = 0; m < 4; ++m)
#pragma unroll
        for (int n = 0; n < 2; ++n) acc[a][b][m][n] = (f32x4){0.f, 0.f, 0.f, 0.f};
  bf16x8 At[4][2], B0[2][2], B1[2][2]; v8i_t At8[4], B08[2], B18[2]; (void)At; (void)B0; (void)B1; (void)At8; (void)B08; (void)B18;
  const char *cA, *cB; int nt; S.op(cur, cA, cB, nt);
  PG8_STAGE(PG8_SB(0, 0), cB, voffB); PG8_STAGE(PG8_SA(0, 0), cA, voffA); PG8_STAGE(PG8_SB(0, 1), cB + hstepB, voffB); PG8_STAGE(PG8_SA(0, 1), cA + hstepA, voffA);
  if (wr == 1) PG8_BAR;
  PG8_WAIT_V(4); PG8_BAR;
  PG8_STAGE(PG8_SB(1, 0), cB + kstep, voffB); PG8_STAGE(PG8_SA(1, 0), cA + kstep, voffA); PG8_STAGE(PG8_SB(1, 1), cB + hstepB + kstep, voffB);
  PG8_WAIT_V(6); PG8_BAR;
  for (;;) {
    const bool has_next = S.next(ui + 1, nxt);
    const char *nA = cA, *nB = cB; int nnt = nt;
    if (has_next) S.op(nxt, nA, nB, nnt);
    for (int t = 0; t < nt; t += 2) {
      const bool last = (t == nt - 2);
      const char* a1 = cA + (size_t)(t + 1) * kstep;
      const char* a2 = last ? nA : cA + (size_t)(t + 2) * kstep; const char* b2 = last ? nB : cB + (size_t)(t + 2) * kstep;
      const char* a3 = a2 + kstep; const char* b3 = b2 + kstep;
      PG8_LDB(B0, 0, 0); PG8_SCHED; PG8_LDA(At, 0, 0); PG8_STAGE(PG8_SA(1, 1), a1 + hstepA, voffA);
      PG8_WAIT_L(8); PG8_BAR; PG8_WAIT_L(0); PG8_MMA(0, 0, At, B0); PG8_BAR; PG8_SCHED;
      PG8_LDB(B1, 0, 1); PG8_STAGE(PG8_SB(0, 0), b2, voffB);
      PG8_BAR; PG8_WAIT_L(0); PG8_MMA(0, 1, At, B1); PG8_BAR;
      PG8_LDA(At, 0, 1); PG8_STAGE(PG8_SA(0, 0), a2, voffA);
      PG8_BAR; PG8_WAIT_L(0); PG8_MMA(1, 0, At, B0); PG8_BAR; PG8_SCHED;
      PG8_STAGE(PG8_SB(0, 1), b2 + hstepB, voffB);
      PG8_WAIT_V(6); PG8_BAR; PG8_MMA(1, 1, At, B1); PG8_BAR;
      PG8_LDB(B0, 1, 0); PG8_SCHED; PG8_LDA(At, 1, 0); PG8_STAGE(PG8_SA(0, 1), a2 + hstepA, voffA);
      PG8_WAIT_L(8); PG8_BAR; PG8_WAIT_L(0); PG8_MMA(0, 0, At, B0); PG8_BAR; PG8_SCHED;
      PG8_LDB(B1, 1, 1); PG8_STAGE(PG8_SB(1, 0), b3, voffB);
      PG8_BAR; PG8_WAIT_L(0); PG8_MMA(0, 1, At, B1); PG8_BAR;
      PG8_LDA(At, 1, 1); PG8_STAGE(PG8_SA(1, 0), a3, voffA);
      PG8_BAR; PG8_WAIT_L(0); PG8_MMA(1, 0, At, B0); PG8_BAR; PG8_SCHED;
      PG8_STAGE(PG8_SB(1, 1), b3 + hstepB, voffB);
      PG8_WAIT_V(6); PG8_BAR; PG8_MMA(1, 1, At, B1); PG8_BAR;
    }
    if constexpr (FP8) asm volatile("s_nop 15\n\ts_nop 15\n\ts_nop 15" ::: "memory");
    if constexpr (!Epi::AFTER_DRAIN) { Unit ue = cur; int fr_ = fr, fq_ = fq;
      asm volatile("" : "+s"(ue.pm), "+s"(ue.pn), "+s"(ue.kind), "+v"(fr_), "+v"(fq_));
      E(acc, ue, wr, wc, fr_, fq_); }
    if (!has_next) break;
    if (!Epi::keep_acc(cur)) {
#pragma unroll
    for (int a = 0; a < 2; ++a)
#pragma unroll
      for (int b = 0; b < 2; ++b)
#pragma unroll
        for (int m = 0; m < 4; ++m)
#pragma unroll
          for (int n = 0; n < 2; ++n) acc[a][b][m][n] = (f32x4){0.f, 0.f, 0.f, 0.f};
    }
    cur = nxt; cA = nA; cB = nB; nt = nnt; ++ui;
  }
  PG8_WAIT_V(0);
  if (wr == 0) PG8_BAR;
  PG8_BAR;
  if constexpr (Epi::AFTER_DRAIN) { Unit ue = cur; int fr_ = fr, fq_ = fq;
    asm volatile("" : "+s"(ue.pm), "+s"(ue.pn), "+v"(fr_), "+v"(fq_));
    E.fused(acc, ue, wr, wc, fr_, fq_, lds, wid, lane); }
#undef PG8_SA
#undef PG8_SB
#undef PG8_STAGE
#undef PG8_LDA
#undef PG8_LDB
#undef PG8_MMA
#undef PG8_CAT
#undef PG8_WAIT_V
#undef PG8_WAIT_L
#undef PG8_BAR
#undef PG8_SCHED
}
}


__device__ __forceinline__ void store_tile_rows(const f32x16* o, const float* rli, char* wl, int r32, int hi, int lane, bf16_t* Orow0, long ostride, const unsigned char* Grow0, long gstride) {
#pragma unroll
  for (int r = 0; r < 16; ++r) { const int row = (r & 3) + 8 * (r >> 2) + 4 * hi;
#pragma unroll
    for (int d0 = 0; d0 < 4; ++d0) *(bf16_t*)(wl + row * 256 + (d0 * 32 + r32) * 2) = (bf16_t)(cvtpk(o[d0][r] * rli[r], 0.f) & 0xffffu);
    asm volatile("" ::: "memory"); }
  asm volatile("s_waitcnt lgkmcnt(0)" ::: "memory");
#pragma unroll 1
  for (int it = 0; it < 8; ++it) { const int chunk = it * 64 + lane, row = chunk >> 4, cc = chunk & 15;
    u32x4 v = *(const u32x4*)(wl + chunk * 16);
    if (Grow0) { const u32x2 g8 = *(const u32x2*)(Grow0 + (long)row * gstride + cc * 8); float gf[8]; fp8x4_to_f32(g8.x, gf); fp8x4_to_f32(g8.y, gf + 4);
      v.x = cvtpk(bflo(v.x) * gf[0], bfhi(v.x) * gf[1]); v.y = cvtpk(bflo(v.y) * gf[2], bfhi(v.y) * gf[3]);
      v.z = cvtpk(bflo(v.z) * gf[4], bfhi(v.z) * gf[5]); v.w = cvtpk(bflo(v.w) * gf[6], bfhi(v.w) * gf[7]); }
    *(u32x4*)(Orow0 + (long)row * ostride + cc * 8) = v; }
  asm volatile("s_waitcnt lgkmcnt(0)" ::: "memory");
}
constexpr int EPI_LDS_OFF = 66 * 1024;

namespace at {
constexpr int D = 128, NW = 8, QBLK = 32, KVBLK = 64;
constexpr float SCALE = 0.088388347648318440f;
constexpr float THR = 8.f;
constexpr size_t SHM_V = KVBLK * D * 2, SHM_K = KVBLK * D * 2, SHM_ATTN = 2 * SHM_V + 2 * SHM_K + NW * 64 * 4;
#define KSWZ(row, colB) ((row) * 256 + ((colB) ^ (((row) & 7) << 4)))
#define SBAR() __builtin_amdgcn_sched_barrier(0)
__device__ __forceinline__ int crow(int r, int hi) { return (r & 3) + 8 * (r >> 2) + 4 * hi; }

template <bool BAND>
__device__ __forceinline__ void partialSM(f32x16& p0, f32x16& p1, float& m_reg, float& mn, float& alpha, int kb, int uq, int L, float sl, int hi) {
  constexpr float C = SCALE * 1.4426950408889634f;
#if DBG_UNIFORM
  if constexpr (!BAND) { p0 = p0 * 0.f; p1 = p1 * 0.f; }
#endif
  if constexpr (BAND) {
#pragma unroll
    for (int r = 0; r < 16; ++r) {
      const int k0i = kb + crow(r, hi), k1i = k0i + 32;
      const float a0 = fabsf((float)(k0i - uq)), a1 = fabsf((float)(k1i - uq));
      const bool ok0 = (a0 <= 64.f) && ((unsigned)k0i < (unsigned)L), ok1 = (a1 <= 64.f) && ((unsigned)k1i < (unsigned)L);
      p0[r] = ok0 ? fmaf(-a0, sl, p0[r]) : -1e30f; p1[r] = ok1 ? fmaf(-a1, sl, p1[r]) : -1e30f;
    }
  }
  float pmax = p0[0];
#pragma unroll
  for (int r = 1; r < 16; ++r) pmax = fmaxf(pmax, p0[r]);
#pragma unroll
  for (int r = 0; r < 16; ++r) pmax = fmaxf(pmax, p1[r]);
  { auto rr = __builtin_amdgcn_permlane32_swap(__float_as_uint(pmax), __float_as_uint(pmax), false, false);
    pmax = fmaxf(__uint_as_float(rr[0]), __uint_as_float(rr[1])); }
  if (__builtin_expect(__all(pmax - m_reg <= THR / SCALE), 1)) { mn = m_reg; alpha = 1.f; }
  else { mn = fmaxf(m_reg, pmax); alpha = __builtin_amdgcn_exp2f((m_reg - mn) * C); m_reg = mn; }
  const float mnC = -mn * C;
#pragma unroll
  for (int r = 0; r < 16; ++r) p0[r] = fmaf(p0[r], C, mnC);
#pragma unroll
  for (int r = 0; r < 16; ++r) p1[r] = fmaf(p1[r], C, mnC);
#pragma unroll
  for (int r = 0; r < 16; ++r) p0[r] = __builtin_amdgcn_exp2f(p0[r]);
}
__device__ __forceinline__ void finishSM(f32x16& p0, f32x16& p1, float alpha, float& l_reg, bf16x8& pa0, bf16x8& pa1, bf16x8& pa2, bf16x8& pa3) {
#pragma unroll
  for (int r = 0; r < 16; ++r) p1[r] = __builtin_amdgcn_exp2f(p1[r]);
  float ps = 0;
#pragma unroll
  for (int r = 0; r < 16; ++r) ps += p0[r];
#pragma unroll
  for (int r = 0; r < 16; ++r) ps += p1[r];
  { auto rr = __builtin_amdgcn_permlane32_swap(__float_as_uint(ps), __float_as_uint(ps), false, false);
    ps = __uint_as_float(rr[0]) + __uint_as_float(rr[1]); }
  l_reg = l_reg * alpha + ps;
#define PK4(P, BASE, OUT) do { unsigned a0 = cvtpk(P[BASE + 0], P[BASE + 1]), a1 = cvtpk(P[BASE + 2], P[BASE + 3]);   \
    unsigned b0 = cvtpk(P[BASE + 4], P[BASE + 5]), b1 = cvtpk(P[BASE + 6], P[BASE + 7]);                              \
    auto r0 = __builtin_amdgcn_permlane32_swap(a0, b0, false, false); auto r1 = __builtin_amdgcn_permlane32_swap(a1, b1, false, false); \
    u32x4 w = {r0[0], r1[0], r0[1], r1[1]}; OUT = *reinterpret_cast<bf16x8*>(&w); } while (0)
  PK4(p0, 0, pa0); PK4(p0, 8, pa1); PK4(p1, 0, pa2); PK4(p1, 8, pa3);
#undef PK4
}
__device__ __forceinline__ void qkt(f32x16& p0, f32x16& p1, const char* Ks, const bf16x8* qr, int r32, int hi) {
  p0 = f32x16{}; p1 = f32x16{};
#pragma unroll
  for (int d0 = 0; d0 < 8; ++d0) { const int cb = (d0 * 16 + hi * 8) * 2;
    bf16x8 b0 = *reinterpret_cast<const bf16x8*>(Ks + KSWZ(r32, cb));
    bf16x8 b1 = *reinterpret_cast<const bf16x8*>(Ks + KSWZ(32 + r32, cb));
    p0 = __builtin_amdgcn_mfma_f32_32x32x16_bf16(b0, qr[d0], p0, 0, 0, 0);
    p1 = __builtin_amdgcn_mfma_f32_32x32x16_bf16(b1, qr[d0], p1, 0, 0, 0); }
}
__device__ __forceinline__ int v_st(int k, int c) { const int kk = (k & ~0xC) | ((k & 4) << 1) | ((k & 8) >> 1); return ((kk >> 3) * 4 + (c >> 5)) * 512 + ((kk & 7) * 32 + (c & 31)) * 2; }
__device__ __forceinline__ int v_rd_base(int lane) { return ((lane & 3) << 3) | (((lane >> 2) & 3) << 6) | (((lane >> 4) & 1) << 5) | (((lane >> 5) & 1) << 8); }
constexpr int v_rd_off(int d0, int ks, int half) { return d0 * 512 + ks * 4096 + half * 2048; }
template <int OFF> __device__ __forceinline__ s16x4 tr_read(int vb) {
  s16x4 r; asm volatile("ds_read_b64_tr_b16 %0, %1 offset:%2" : "=&v"(r) : "v"(vb), "i"(OFF) : "memory"); return r;
}
template <int D0> __device__ __forceinline__ void pv_one(f32x16& od, int vb, bf16x8 pa0, bf16x8 pa1, bf16x8 pa2, bf16x8 pa3) {
  const s16x4 l0 = tr_read<v_rd_off(D0, 0, 0)>(vb), h0 = tr_read<v_rd_off(D0, 0, 1)>(vb), l1 = tr_read<v_rd_off(D0, 1, 0)>(vb), h1 = tr_read<v_rd_off(D0, 1, 1)>(vb);
  const s16x4 l2 = tr_read<v_rd_off(D0, 2, 0)>(vb), h2 = tr_read<v_rd_off(D0, 2, 1)>(vb), l3 = tr_read<v_rd_off(D0, 3, 0)>(vb), h3 = tr_read<v_rd_off(D0, 3, 1)>(vb);
  asm volatile("s_waitcnt lgkmcnt(0)" ::: "memory"); SBAR();
#define PK(L, H) (bf16x8){L[0], L[1], L[2], L[3], H[0], H[1], H[2], H[3]}
  od = __builtin_amdgcn_mfma_f32_32x32x16_bf16(pa0, PK(l0, h0), od, 0, 0, 0);
  od = __builtin_amdgcn_mfma_f32_32x32x16_bf16(pa1, PK(l1, h1), od, 0, 0, 0);
  od = __builtin_amdgcn_mfma_f32_32x32x16_bf16(pa2, PK(l2, h2), od, 0, 0, 0);
  od = __builtin_amdgcn_mfma_f32_32x32x16_bf16(pa3, PK(l3, h3), od, 0, 0, 0);
#undef PK
}
__device__ __forceinline__ void pv_d0(f32x16* o, int vb, bf16x8 pa0, bf16x8 pa1, bf16x8 pa2, bf16x8 pa3) {
  pv_one<0>(o[0], vb, pa0, pa1, pa2, pa3); pv_one<1>(o[1], vb, pa0, pa1, pa2, pa3); pv_one<2>(o[2], vb, pa0, pa1, pa2, pa3); pv_one<3>(o[3], vb, pa0, pa1, pa2, pa3);
}

template <bool BAND>
__device__ __forceinline__ void attn_body(const bf16_t* Qb, const bf16_t* Kh, const bf16_t* Vh, long rs, int NT,
                                          int ubase, int u0, int L, float sl,
                                          bf16_t* Ob, const bf16_t* Gb, float* Lp, long lse_stride, char* lds, bool do_store = true) {
  const int tid = fresh_tid(), wid = tid >> 6, lane = tid & 63, r32 = lane & 31, hi = lane >> 5;
  if (__builtin_amdgcn_readfirstlane(wid) >= 4) __builtin_amdgcn_s_setprio(1);
  char* V_lds = lds; char* K_lds = lds + 2 * SHM_V;
  float* wsl = (float*)(lds + 2 * SHM_V + 2 * SHM_K) + wid * 64; float* li_l = wsl; float* al_l = wsl + 32;
  float m_reg = BAND ? -1e5f : -1e30f, l_reg = 0; f32x16 o[4] = {}; bf16x8 qr[8];
  const int uq = u0 + wid * QBLK + r32;
  const bf16_t* Qw = Qb + (long)(wid * QBLK + r32) * rs + hi * 8;
#pragma unroll
  for (int d0 = 0; d0 < 8; ++d0) qr[d0] = *reinterpret_cast<const bf16x8*>(Qw + d0 * 16);
  const int sr = tid >> 4, sc = (tid & 15) * 8, vst0 = v_st(sr, sc), vst1 = v_st(32 + sr, sc);
  const int vb0 = (int)(uintptr_t)V_lds + v_rd_base(lane);
  struct { bf16x8 vs0, vs1, ks0, ks1; } sr_[2];
#define KROW(k) (BAND ? (long)min(max(ubase + (k), 0), L - 1) * rs : (long)(k) * rs)
#define SLOAD(i, k0) do { const long ra_ = KROW((k0) + sr) + sc, rb_ = KROW((k0) + 32 + sr) + sc; \
    sr_[i].vs0 = *reinterpret_cast<const bf16x8*>(Vh + ra_); sr_[i].vs1 = *reinterpret_cast<const bf16x8*>(Vh + rb_); \
    sr_[i].ks0 = *reinterpret_cast<const bf16x8*>(Kh + ra_); sr_[i].ks1 = *reinterpret_cast<const bf16x8*>(Kh + rb_); } while (0)
#define SWRITE(b, i) do { *(bf16x8*)(V_lds + (b) * SHM_V + vst0) = sr_[i].vs0;          \
    *(bf16x8*)(V_lds + (b) * SHM_V + vst1) = sr_[i].vs1; const int kc = sc * 2;               \
    *(bf16x8*)(K_lds + (b) * SHM_K + KSWZ(sr, kc)) = sr_[i].ks0;                       \
    *(bf16x8*)(K_lds + (b) * SHM_K + KSWZ(32 + sr, kc)) = sr_[i].ks1; } while (0)
#define SWAIT() asm volatile("s_waitcnt vmcnt(4)" ::: "memory")
#define RESC(a) do { if (__any((a) < 1.f)) { if (hi == 0) al_l[r32] = (a); asm volatile("s_waitcnt lgkmcnt(0)" ::: "memory"); \
    _Pragma("unroll") for (int d = 0; d < 4; ++d) _Pragma("unroll") for (int r = 0; r < 16; ++r) o[d][r] *= al_l[crow(r, hi)]; } } while (0)
  f32x16 pA0, pA1, pB0, pB1; float mnA, mnB, alA, alB; bf16x8 pa0, pa1, pa2, pa3;
  constexpr int SE = 0, SO = 1;
  SLOAD(SE, 0); SLOAD(SO, KVBLK); SWAIT(); SWRITE(0, SE); __syncthreads();
  qkt(pA0, pA1, K_lds, qr, r32, hi); partialSM<BAND>(pA0, pA1, m_reg, mnA, alA, ubase, uq, L, sl, hi);
  if (2 < NT) SLOAD(SE, 2 * KVBLK);
  SWAIT(); SWRITE(1, SO); __syncthreads();
  for (int j = 1; j + 1 < NT; j += 2) {
    SBAR(); qkt(pB0, pB1, K_lds + SHM_K, qr, r32, hi);
    finishSM(pA0, pA1, alA, l_reg, pa0, pa1, pa2, pa3); SBAR();
    SLOAD(SO, (j + 2) * KVBLK); SBAR();
    pv_d0(o, vb0, pa0, pa1, pa2, pa3); partialSM<BAND>(pB0, pB1, m_reg, mnB, alB, ubase + j * KVBLK, uq, L, sl, hi);
    __syncthreads(); SWAIT(); SWRITE(0, SE);
    RESC(alB); __syncthreads();
    SBAR(); qkt(pA0, pA1, K_lds, qr, r32, hi);
    finishSM(pB0, pB1, alB, l_reg, pa0, pa1, pa2, pa3); SBAR();
    if (j + 3 < NT) SLOAD(SE, (j + 3) * KVBLK); SBAR();
    pv_d0(o, vb0 + (int)SHM_V, pa0, pa1, pa2, pa3); partialSM<BAND>(pA0, pA1, m_reg, mnA, alA, ubase + (j + 1) * KVBLK, uq, L, sl, hi);
    __syncthreads(); SWAIT(); SWRITE(1, SO);
    RESC(alA); __syncthreads();
  }
  SBAR(); qkt(pB0, pB1, K_lds + SHM_K, qr, r32, hi);
  finishSM(pA0, pA1, alA, l_reg, pa0, pa1, pa2, pa3); SBAR();
  pv_d0(o, vb0, pa0, pa1, pa2, pa3); partialSM<BAND>(pB0, pB1, m_reg, mnB, alB, ubase + (NT - 1) * KVBLK, uq, L, sl, hi);
  __syncthreads(); RESC(alB);
  finishSM(pB0, pB1, alB, l_reg, pa0, pa1, pa2, pa3); SBAR();
  pv_d0(o, vb0 + (int)SHM_V, pa0, pa1, pa2, pa3);
  __builtin_amdgcn_s_setprio(0);
  if (hi == 0) li_l[r32] = l_reg; asm volatile("s_waitcnt lgkmcnt(0)" ::: "memory");
  float rli[16];
#pragma unroll
  for (int r = 0; r < 16; ++r) rli[r] = __builtin_amdgcn_rcpf(li_l[crow(r, hi)]);
  if (!do_store) return;
  if constexpr (BAND) {
    if (hi == 0) Lp[(long)(wid * QBLK + r32) * lse_stride] = m_reg * SCALE + __logf(l_reg);
    store_tile_rows(o, rli, lds + EPI_LDS_OFF + wid * 8192, r32, hi, lane, Ob + (long)(wid * QBLK) * rs, rs, nullptr, 0);
  } else {
    bf16_t* Ow = Ob + (long)(wid * QBLK) * YW; const bf16_t* Gw = Gb + (long)(wid * QBLK) * INW;
#pragma unroll
    for (int r = 0; r < 16; ++r) { const long orow = crow(r, hi);
#pragma unroll
      for (int d0 = 0; d0 < 4; ++d0) { const float g = bf2f(Gw[orow * INW + d0 * 32 + r32]);
        Ow[orow * YW + d0 * 32 + r32] = (bf16_t)(cvtpk(o[d0][r] * rli[r] * g, 0.f) & 0xffffu); } }
  }
#undef KROW
#undef SLOAD
#undef SWRITE
#undef SWAIT
#undef RESC
}
}


namespace a8 {
typedef int v8i __attribute__((ext_vector_type(8)));
typedef int v4i __attribute__((ext_vector_type(4)));
constexpr float PSHIFT = 6.f, CAP = 8.5f;
constexpr int TILE_B = 8192;
#define A8_MFMA(a, b, c) __builtin_amdgcn_mfma_scale_f32_32x32x64_f8f6f4((a), (b), (c), 0, 0, 0, 0, 0, 0)
__device__ __forceinline__ v8i cat8(v4i a, v4i b) { return (v8i){a[0], a[1], a[2], a[3], b[0], b[1], b[2], b[3]}; }
__device__ __forceinline__ void partialSM(f32x16& p0, f32x16& p1, float& pm, f32x16& negM, float& alpha) {
  float dmax = p0[0];
#pragma unroll
  for (int r = 1; r < 16; ++r) dmax = fmaxf(dmax, p0[r]);
#pragma unroll
  for (int r = 0; r < 16; ++r) dmax = fmaxf(dmax, p1[r]);
  { auto rr = __builtin_amdgcn_permlane32_swap(__float_as_uint(dmax), __float_as_uint(dmax), false, false);
    dmax = fmaxf(__uint_as_float(rr[0]), __uint_as_float(rr[1])); }
  if (__builtin_expect(__all(dmax <= CAP), 1)) { alpha = 1.f; }
  else { const float delta = fmaxf(dmax - PSHIFT, 0.f); alpha = __builtin_amdgcn_exp2f(-delta); pm += delta;
#pragma unroll
    for (int r = 0; r < 16; ++r) { p0[r] -= delta; p1[r] -= delta; }
    const float nm = -pm;
#pragma unroll
    for (int r = 0; r < 16; ++r) negM[r] = nm; }
#pragma unroll
  for (int r = 0; r < 16; ++r) p0[r] = __builtin_amdgcn_exp2f(p0[r]);
}
__device__ __forceinline__ void finishSM(f32x16& p0, f32x16& p1, v8i& pa) {
#pragma unroll
  for (int r = 0; r < 16; ++r) p1[r] = __builtin_amdgcn_exp2f(p1[r]);
#pragma unroll
  for (int v = 0; v < 4; ++v) { int w = __builtin_amdgcn_cvt_pk_fp8_f32(p0[4 * v], p0[4 * v + 1], 0, false); pa[v] = __builtin_amdgcn_cvt_pk_fp8_f32(p0[4 * v + 2], p0[4 * v + 3], w, true); }
#pragma unroll
  for (int v = 0; v < 4; ++v) { int w = __builtin_amdgcn_cvt_pk_fp8_f32(p1[4 * v], p1[4 * v + 1], 0, false); pa[4 + v] = __builtin_amdgcn_cvt_pk_fp8_f32(p1[4 * v + 2], p1[4 * v + 3], w, true); }
}
__device__ __forceinline__ void qkt(f32x16& p0, f32x16& p1, const f32x16& negM, const char* Ks, v8i q0, v8i q1, int kb, int ko00, int ko01, int ko10, int ko11) {
  const v4i a00 = *(const v4i*)(Ks + kb + ko00), a01 = *(const v4i*)(Ks + kb + ko01), a10 = *(const v4i*)(Ks + kb + ko10), a11 = *(const v4i*)(Ks + kb + ko11);
  const v4i b00 = *(const v4i*)(Ks + 4096 + kb + ko00), b01 = *(const v4i*)(Ks + 4096 + kb + ko01), b10 = *(const v4i*)(Ks + 4096 + kb + ko10), b11 = *(const v4i*)(Ks + 4096 + kb + ko11);
  p0 = A8_MFMA(cat8(a00, a01), q0, negM); p1 = A8_MFMA(cat8(b00, b01), q0, negM);
  p0 = A8_MFMA(cat8(a10, a11), q1, p0); p1 = A8_MFMA(cat8(b10, b11), q1, p1);
}
__device__ __forceinline__ void pv(f32x16* o, const char* Vs, v8i pa, const char* onesp, int vb, int vo0, int vo1) {
  const v8i ones = cat8(*(const v4i*)(onesp), *(const v4i*)(onesp + 16));
  const v4i x0 = *(const v4i*)(Vs + vb + vo0), y0 = *(const v4i*)(Vs + vb + vo1), x1 = *(const v4i*)(Vs + 2048 + vb + vo0), y1 = *(const v4i*)(Vs + 2048 + vb + vo1);
  const v4i x2 = *(const v4i*)(Vs + 4096 + vb + vo0), y2 = *(const v4i*)(Vs + 4096 + vb + vo1), x3 = *(const v4i*)(Vs + 6144 + vb + vo0), y3 = *(const v4i*)(Vs + 6144 + vb + vo1);
  o[4] = A8_MFMA(pa, ones, o[4]);
  o[0] = A8_MFMA(pa, cat8(x0, y0), o[0]); o[1] = A8_MFMA(pa, cat8(x1, y1), o[1]); o[2] = A8_MFMA(pa, cat8(x2, y2), o[2]); o[3] = A8_MFMA(pa, cat8(x3, y3), o[3]);
}
__device__ __forceinline__ void attn_body(const unsigned char* Q8, const unsigned char* K8, const unsigned char* V8T, int NT, bf16_t* Ob, const unsigned char* Gb, char* lds) {
  using at::crow;
  const int tid = fresh_tid(), wid = tid >> 6, lane = tid & 63, r32 = lane & 31, hi = lane >> 5;
  if (__builtin_amdgcn_readfirstlane(wid) >= 4) __builtin_amdgcn_s_setprio(1);
  char* V_lds = lds; char* K_lds = lds + 2 * TILE_B;
  float* al_l = (float*)(lds + 4 * TILE_B) + wid * 32;
  float pm = -PSHIFT; f32x16 o[5] = {}; f32x16 negM;
#pragma unroll
  for (int r = 0; r < 16; ++r) negM[r] = PSHIFT;
  { int t_; asm volatile("v_mov_b32 %0, 0x38383838" : "=v"(t_)); *(int*)(lds + 4 * TILE_B + 1024 + tid * 4) = t_; }
  const char* ones = lds + 4 * TILE_B + 1024 + lane * 32;
  v8i q0, q1;
  { const unsigned char* Qw = Q8 + (long)(wid * 32 + r32) * 1024 + hi * 32;
    q0 = cat8(*(const v4i*)(Qw), *(const v4i*)(Qw + 16)); q1 = cat8(*(const v4i*)(Qw + 64), *(const v4i*)(Qw + 80)); }
  const int kb = r32 * 128, ksw = (r32 >> 1) & 7;
  const int ko00 = ((2 * hi) ^ ksw) << 4, ko01 = ((2 * hi + 1) ^ ksw) << 4, ko10 = ((4 + 2 * hi) ^ ksw) << 4, ko11 = ((5 + 2 * hi) ^ ksw) << 4;
  const int vb = r32 * 64, vsw = (r32 >> 2) & 3, vo0 = ((2 * hi) ^ vsw) << 4, vo1 = ((2 * hi + 1) ^ vsw) << 4;
  const int krow = tid >> 3, kst = krow * 128 + (((tid & 7) ^ ((krow >> 1) & 7)) << 4);
  const int vd = tid >> 2, vst = vd * 64 + (((tid & 3) ^ ((vd >> 2) & 3)) << 4);
  const unsigned char* Kg = K8 + tid * 16; const unsigned char* Vg = V8T + tid * 16;
  struct { v4i k, v; } sr_[2];
#define SLOAD(i, t) do { sr_[i].k = *(const v4i*)(Kg + (long)(t) * TILE_B); sr_[i].v = *(const v4i*)(Vg + (long)(t) * TILE_B); } while (0)
#define SWRITE(b, i) do { *(v4i*)(K_lds + (b) * TILE_B + kst) = sr_[i].k; *(v4i*)(V_lds + (b) * TILE_B + vst) = sr_[i].v; } while (0)
#define SWAIT() asm volatile("s_waitcnt vmcnt(2)" ::: "memory")
#define RESC(a) do { if (__any((a) < 1.f)) { if (hi == 0) al_l[r32] = (a); asm volatile("s_waitcnt lgkmcnt(0)" ::: "memory"); \
    _Pragma("unroll") for (int d = 0; d < 5; ++d) _Pragma("unroll") for (int r = 0; r < 16; ++r) o[d][r] *= al_l[crow(r, hi)]; } } while (0)
  f32x16 pA0, pA1, pB0, pB1; float alA, alB; v8i pa;
  constexpr int SE = 0, SO = 1;
  SLOAD(SE, 0); SLOAD(SO, 1); SWAIT(); SWRITE(0, SE); __syncthreads();
  qkt(pA0, pA1, negM, K_lds, q0, q1, kb, ko00, ko01, ko10, ko11); partialSM(pA0, pA1, pm, negM, alA);
  if (2 < NT) SLOAD(SE, 2);
  SWAIT(); SWRITE(1, SO); __syncthreads();
  for (int j = 1; j + 1 < NT; j += 2) {
    SBAR(); qkt(pB0, pB1, negM, K_lds + TILE_B, q0, q1, kb, ko00, ko01, ko10, ko11);
    finishSM(pA0, pA1, pa); SBAR();
    SLOAD(SO, j + 2); SBAR();
    pv(o, V_lds, pa, ones, vb, vo0, vo1); partialSM(pB0, pB1, pm, negM, alB);
    __syncthreads(); SWAIT(); SWRITE(0, SE);
    RESC(alB); __syncthreads();
    SBAR(); qkt(pA0, pA1, negM, K_lds, q0, q1, kb, ko00, ko01, ko10, ko11);
    finishSM(pB0, pB1, pa); SBAR();
    if (j + 3 < NT) SLOAD(SE, j + 3); SBAR();
    pv(o, V_lds + TILE_B, pa, ones, vb, vo0, vo1); partialSM(pA0, pA1, pm, negM, alA);
    __syncthreads(); SWAIT(); SWRITE(1, SO);
    RESC(alA); __syncthreads();
  }
  SBAR(); qkt(pB0, pB1, negM, K_lds + TILE_B, q0, q1, kb, ko00, ko01, ko10, ko11);
  finishSM(pA0, pA1, pa); SBAR();
  pv(o, V_lds, pa, ones, vb, vo0, vo1); partialSM(pB0, pB1, pm, negM, alB);
  __syncthreads(); RESC(alB);
  finishSM(pB0, pB1, pa); SBAR();
  pv(o, V_lds + TILE_B, pa, ones, vb, vo0, vo1);
  __builtin_amdgcn_s_setprio(0);
  float rli[16];
#pragma unroll
  for (int r = 0; r < 16; ++r) rli[r] = __builtin_amdgcn_rcpf(o[4][r]);
  store_tile_rows(o, rli, lds + EPI_LDS_OFF + wid * 8192, r32, hi, lane, Ob + (long)(wid * 32) * YW, YW, Gb + (long)(wid * 32) * (INW * 2), INW * 2);
#undef SLOAD
#undef SWRITE
#undef SWAIT
#undef RESC
}
}

#if DBG_NAIVE_A || DBG_NAIVE_B
__device__ __forceinline__ void naive_row(const bf16_t* qrow, const bf16_t* Kb, const bf16_t* Vb, long rs, int first, int count, int uc, float sl, int lane, float& m, float& l, float& o0, float& o1) {
  const unsigned qw = *(const unsigned*)(qrow + 2 * lane); const float q0 = bflo(qw), q1 = bfhi(qw);
  m = -1e30f; l = 0.f; o0 = 0.f; o1 = 0.f;
  for (int i = first; i < first + count; ++i) {
    const unsigned kw = *(const unsigned*)(Kb + (long)i * rs + 2 * lane), vw = *(const unsigned*)(Vb + (long)i * rs + 2 * lane);
    float s = q0 * bflo(kw) + q1 * bfhi(kw);
#pragma unroll
    for (int off = 1; off < 64; off <<= 1) s += __shfl_xor(s, off);
    s = s * 0.088388347648318440f - sl * fabsf((float)(i - uc));
    const float mn = fmaxf(m, s), a = __expf(m - mn), p = __expf(s - mn);
    l = l * a + p; o0 = o0 * a + p * bflo(vw); o1 = o1 * a + p * bfhi(vw); m = mn;
  }
}
#endif

#define XB_TMO      128
#define XB_XCNT(j)  (256  + 64 * (j))
#define XB_XSUB(j)  (1280 + 64 * (j))
#define XB_XGEN(j)  (2304 + 64 * (j))
#define XB_TOP      3328
#define XB_TOPGEN   3392
#define XCD_BAR_WORDS 3456
#define XB_SPIN_CAP (1u << 20)
__device__ __forceinline__ unsigned xb_ld(unsigned* p)              { return __hip_atomic_load(p, __ATOMIC_RELAXED, __HIP_MEMORY_SCOPE_AGENT); }
__device__ __forceinline__ unsigned xb_add(unsigned* p, unsigned v) { return __hip_atomic_fetch_add(p, v, __ATOMIC_RELAXED, __HIP_MEMORY_SCOPE_AGENT); }
__device__ __forceinline__ unsigned xb_xcc_id() { return (unsigned)__builtin_amdgcn_s_getreg((3 << 11) | 20) & 0xFu; }
#define XB_SPIN(cond, bar) do { unsigned _sp = 0; while (cond) { __builtin_amdgcn_s_sleep(1); \
    if ((++_sp & 255u) == 0u) { if (xb_ld(&(bar)[XB_TMO])) break; if (_sp > XB_SPIN_CAP) { atomicAdd(&(bar)[XB_TMO], 1u); break; } } } } while (0)
struct XcdBarrier { unsigned* bar; unsigned x; volatile LAS unsigned* st; };
__device__ __forceinline__ XcdBarrier xcd_barrier_post(unsigned* bar, volatile LAS unsigned* st) {
  XcdBarrier b; b.bar = bar; b.x = xb_xcc_id(); b.st = st;
  if (threadIdx.x == 0) (void)xb_add(&bar[XB_XCNT(b.x)], 1u);
  return b;
}
__device__ __forceinline__ void xcd_barrier_complete(unsigned* bar, unsigned x, unsigned& nloc, unsigned& nx) {
  const unsigned G = gridDim.x * gridDim.y * gridDim.z;
  unsigned sum, cnt, mine, sp = 0u;
  for (;;) {
    sum = 0u; cnt = 0u; mine = 0u;
#pragma unroll
    for (unsigned j = 0; j < 16; ++j) { const unsigned c = xb_ld(&bar[XB_XCNT(j)]); sum += c; cnt += (c > 0u) ? 1u : 0u; mine = (j == x) ? c : mine; }
    if (sum == G) break;
    __builtin_amdgcn_s_sleep(1);
    if ((++sp & 255u) == 0u) { if (xb_ld(&bar[XB_TMO])) break; if (sp > XB_SPIN_CAP) { atomicAdd(&bar[XB_TMO], 1u); break; } }
  }
  nloc = mine > 0u ? mine : 1u; nx = cnt > 0u ? cnt : 1u;
}
__device__ __forceinline__ void xcd_barrier(const XcdBarrier& b) {
  asm volatile("s_waitcnt vmcnt(0)" ::: "memory");
  __syncthreads();
  if (threadIdx.x == 0) {
    unsigned* bar = b.bar;
    __builtin_amdgcn_s_waitcnt(0);
    unsigned nloc = b.st[0], nx = b.st[1];
    if (nloc == 0u) { xcd_barrier_complete(bar, b.x, nloc, nx); b.st[0] = nloc; b.st[1] = nx; }
    const unsigned old = xb_add(&bar[XB_XSUB(b.x)], 1u);
    const unsigned gen = old / nloc;
    if (old + 1u == (gen + 1u) * nloc) {
      __builtin_amdgcn_fence(__ATOMIC_RELEASE, "agent");
      asm volatile("s_waitcnt vmcnt(0)" ::: "memory");
      const unsigned og = xb_add(&bar[XB_TOP], 1u);
      const unsigned tg = og / nx;
      if (og + 1u == (tg + 1u) * nx) xb_add(&bar[XB_TOPGEN], 1u);
      else XB_SPIN(xb_ld(&bar[XB_TOPGEN]) == tg, bar);
      __builtin_amdgcn_fence(__ATOMIC_ACQUIRE, "agent");
      xb_add(&bar[XB_XGEN(b.x)], 1u);
      asm volatile("s_waitcnt vmcnt(0)" ::: "memory");
    } else {
      XB_SPIN(xb_ld(&bar[XB_XGEN(b.x)]) == gen, bar);
      __builtin_amdgcn_fence(__ATOMIC_ACQUIRE, "agent");
      asm volatile("s_waitcnt vmcnt(0)" ::: "memory");
    }
  }
  __syncthreads();
}

__device__ __forceinline__ float wave_sum(float v) {
#pragma unroll
  for (int o = 1; o < 64; o <<= 1) v += __shfl_xor(v, o);
  return v;
}
__device__ __forceinline__ void transpose_item(const float* W, int N, bf16_t* WT, int ldt, int koff, LAS float* scr, int item, int lane) {
  const int nblk = N / 32, kb = item / nblk, nb = item % nblk, k0 = 64 * kb, n0 = 32 * nb;
#pragma unroll
  for (int i = 0; i < 8; ++i) { const int kk = 8 * i + (lane >> 3), n4 = (lane & 7) * 4;
    const f32x4 w = *(const f32x4*)(W + (size_t)(k0 + kk) * N + n0 + n4);
    scr[kk * 33 + n4] = w[0]; scr[kk * 33 + n4 + 1] = w[1]; scr[kk * 33 + n4 + 2] = w[2]; scr[kk * 33 + n4 + 3] = w[3]; }
  asm volatile("s_waitcnt lgkmcnt(0)" ::: "memory");
  const int c = lane & 7;
#pragma unroll
  for (int j = 0; j < 4; ++j) { const int n = (lane >> 3) + 8 * j; const LAS float* s = scr + (8 * c) * 33 + n;
    u32x4 o; o.x = cvtpk(s[0 * 33], s[1 * 33]); o.y = cvtpk(s[2 * 33], s[3 * 33]); o.z = cvtpk(s[4 * 33], s[5 * 33]); o.w = cvtpk(s[6 * 33], s[7 * 33]);
    *(u32x4*)(WT + (size_t)(n0 + n) * ldt + koff + k0 + 8 * c) = o; }
  asm volatile("s_waitcnt lgkmcnt(0)" ::: "memory");
}

__device__ __forceinline__ void transpose_item8(const float* W, int N, unsigned char* WT, int ldt, float wscale, LAS float* scr, int item, int lane) {
  const int nblk = N / 32, kb = item / nblk, nb = item % nblk, k0 = 64 * kb, n0 = 32 * nb;
#pragma unroll
  for (int i = 0; i < 8; ++i) { const int kk = 8 * i + (lane >> 3), n4 = (lane & 7) * 4;
    const f32x4 w = *(const f32x4*)(W + (size_t)(k0 + kk) * N + n0 + n4) * wscale;
    scr[kk * 33 + n4] = w[0]; scr[kk * 33 + n4 + 1] = w[1]; scr[kk * 33 + n4 + 2] = w[2]; scr[kk * 33 + n4 + 3] = w[3]; }
  asm volatile("s_waitcnt lgkmcnt(0)" ::: "memory");
  const int c = lane & 7;
#pragma unroll
  for (int j = 0; j < 4; ++j) { const int n = (lane >> 3) + 8 * j; const LAS float* s = scr + (8 * c) * 33 + n;
    u32x2 o; o.x = pk4_fp8(s[0 * 33], s[1 * 33], s[2 * 33], s[3 * 33]); o.y = pk4_fp8(s[4 * 33], s[5 * 33], s[6 * 33], s[7 * 33]);
    *(u32x2*)(WT + (size_t)(n0 + n) * ldt + k0 + 8 * c) = o; }
  asm volatile("s_waitcnt lgkmcnt(0)" ::: "memory");
}
__device__ __forceinline__ void sincos_d(double a, double& s, double& c) {
  const double q = rint(a * 0.63661977236758134308);
  double r = fma(-q, 1.57079632679489655800e+00, a); r = fma(-q, 6.12323399573676603587e-17, r);
  const int qi = ((int)q) & 3; const double r2 = r * r;
  const double sp = r + r * r2 * (-1.0 / 6 + r2 * (1.0 / 120 + r2 * (-1.0 / 5040 + r2 * (1.0 / 362880 + r2 * (-1.0 / 39916800 + r2 * (1.0 / 6227020800.0 + r2 * (-1.0 / 1307674368000.0)))))));
  const double cp = 1.0 + r2 * (-0.5 + r2 * (1.0 / 24 + r2 * (-1.0 / 720 + r2 * (1.0 / 40320 + r2 * (-1.0 / 3628800 + r2 * (1.0 / 479001600 + r2 * (-1.0 / 87178291200.0 + r2 * (1.0 / 20922789888000.0))))))));
  s = (qi == 0) ? sp : (qi == 1) ? cp : (qi == 2) ? -sp : -cp;
  c = (qi == 0) ? cp : (qi == 1) ? -sp : (qi == 2) ? -cp : sp;
}
__device__ __forceinline__ void convert_x(const float* x, bf16_t* xb, int gtid, int gthreads) {
  for (int i = gtid; i < CT * DM / 8; i += gthreads) {
    const f32x4 a = *(const f32x4*)(x + (size_t)i * 8), b = *(const f32x4*)(x + (size_t)i * 8 + 4);
#if USE_FP8_P1
    u32x2 w; w.x = pk4_fp8(a[0], a[1], a[2], a[3]); w.y = pk4_fp8(b[0], b[1], b[2], b[3]);
    *(u32x2*)((unsigned char*)xb + (size_t)i * 8) = w; }
#else
    u32x4 w; w.x = cvtpk(a[0], a[1]); w.y = cvtpk(a[2], a[3]); w.z = cvtpk(b[0], b[1]); w.w = cvtpk(b[2], b[3]);
    *(u32x4*)(xb + (size_t)i * 8) = w; }
#endif
}

__global__ void __launch_bounds__(512, 2) fwd_megakernel(Params p) {
  extern __shared__ __attribute__((aligned(16))) unsigned char smem[];
  cg::grid_group grid = cg::this_grid();
  const int G = gridDim.x, cb = blockIdx.x, NGW = G * 8, gthreads = G * 512;
  volatile LAS unsigned* xst = (volatile LAS unsigned*)((LAS unsigned char*)smem + 131 * 1024);
  if (threadIdx.x == 0) { xst[0] = 0u; xst[1] = 0u; }
  __syncthreads();
  const XcdBarrier xb = xcd_barrier_post((unsigned*)(p.ws + WS_BAR), xst);
#define GSYNC() xcd_barrier(xb)
#define THIN_IDS() const int tid = fresh_tid(), wid = tid >> 6, lane = tid & 63, gw = cb * 8 + wid, gtid = cb * 512 + tid; (void)gw; (void)gtid; (void)lane
  bf16_t* WIN = (bf16_t*)(p.ws + WS_WIN); bf16_t* WAB = (bf16_t*)(p.ws + WS_WAB); bf16_t* WO = (bf16_t*)(p.ws + WS_WO);
  bf16_t* XB = (bf16_t*)(p.ws + WS_XB); bf16_t* T = XB; bf16_t* H = (bf16_t*)(p.ws + WS_H); bf16_t* Y = (bf16_t*)(p.ws + WS_Y);
  unsigned char* Q8 = (unsigned char*)(p.ws + WS_Q8); unsigned char* K8 = (unsigned char*)(p.ws + WS_K8); unsigned char* V8T = (unsigned char*)(p.ws + WS_V8T);
  bf16_t* MRG = (bf16_t*)(p.ws + WS_MRG); float* LSE = (float*)(p.ws + WS_LSE); float* ROPE = (float*)(p.ws + WS_ROPE);

  {
    THIN_IDS();
    LAS float* scr = (LAS float*)((LAS unsigned char*)smem + wid * 8704);
    constexpr int I_IN = (DM / 64) * (INW / 32), I_A = (512 / 64) * (DM / 32), I_B = (DM / 64) * (DM / 32), I_O = I_B, I_L = I_IN + I_A + I_B + I_O;
    for (int it = gw; it < 2 * I_L; it += NGW) {
      const int l = it / I_L; int r = it % I_L;
#if USE_FP8_P1
      if (r < I_IN) { transpose_item8(p.w_in + (size_t)l * DM * INW, INW, (unsigned char*)WIN + (size_t)l * INW * DM, DM, 32.f, scr, r, lane); continue; } r -= I_IN;
#else
      if (r < I_IN) { transpose_item(p.w_in + (size_t)l * DM * INW, INW, WIN + (size_t)l * INW * DM, DM, 0, scr, r, lane); continue; } r -= I_IN;
#endif
      if (r < I_A) { transpose_item(p.w_pa + (size_t)l * 512 * DM, DM, WAB + (size_t)l * DM * YW, YW, 0, scr, r, lane); continue; } r -= I_A;
      if (r < I_B) { transpose_item(p.w_pb + (size_t)l * DM * DM, DM, WAB + (size_t)l * DM * YW, YW, 512, scr, r, lane); continue; } r -= I_B;
      transpose_item(p.w_out + (size_t)l * DM * DM, DM, WO + (size_t)l * DM * DM, DM, 0, scr, r, lane);
    }
    for (int e = cb + G * tid; e < 256 * 32 && tid < (256 * 32 + G - 1) / G; e += gthreads) { const int pos = e >> 5, i = e & 31;
      const float inv = exp2f(-(float)i * (13.287712379549449f / 32.f));
      const float ang = (float)pos * inv; double s, c; sincos_d((double)ang, s, c);
      ROPE[e * 2] = (float)c; ROPE[e * 2 + 1] = (float)s; }
    convert_x(p.x_prompt, XB, gtid, gthreads);
  }
  grid.sync();

#pragma unroll 1
  for (int ch = 0; ch < NCH; ++ch) {
    const int S = (ch < 2) ? 8192 : 16384;
    const float* xin = (ch < 2) ? p.x_prompt + (size_t)ch * CT * DM : p.x_sample;
    float* outc = p.out + (size_t)ch * CT * DM;
#pragma unroll 1
    for (int l = 0; l < DEPTH; ++l) {
#if USE_FP8_P1
      { pg8::SchedStd s; s.nM = CT / 256; s.nN = INW / 256; s.G = G; s.c = cb; s.lda = DM / 2; s.ldb = DM / 2; s.nt = DM / 128; s.A = (const char*)XB; s.B = (const char*)WIN + (size_t)l * INW * DM;
        pg8::EpiIn e; e.H = H; e.bias = p.b_in + (size_t)l * INW; e.ascale = 1.f / 32.f;
        for (int rep = 0; rep < DBG_REP_P1; ++rep) pg8::gemm_phase<pg8::EpiIn, pg8::SchedStd, true>(( LAS unsigned char*)smem, s, e); }
#else
      { pg8::SchedStd s; s.nM = CT / 256; s.nN = INW / 256; s.G = G; s.c = cb; s.lda = DM; s.ldb = DM; s.nt = DM / 64; s.A = (const char*)XB; s.B = (const char*)(WIN + (size_t)l * INW * DM);
        pg8::EpiIn e; e.H = H; e.bias = p.b_in + (size_t)l * INW; e.ascale = 1.f;
        for (int rep = 0; rep < DBG_REP_P1; ++rep) pg8::gemm_phase(( LAS unsigned char*)smem, s, e); }
#endif
      GSYNC();
      {
        { THIN_IDS();
        const float* qg = p.q_gain + l * 128; const float* kg = p.k_gain + l * 128;
        const int l16 = lane & 15;
        for (int idx0 = gw * 4 + (lane >> 4); idx0 < CT * 10; idx0 += NGW * 16) {
          const unsigned char* ptr[4]; u32x2 w[4]; bool ok[4]; int tokk[4], hhk[4];
#pragma unroll
          for (int k = 0; k < 4; ++k) { const int idx = idx0 + k * NGW * 4; ok[k] = idx < CT * 10; const int idc = ok[k] ? idx : idx0;
            tokk[k] = idc / 10; hhk[k] = idc % 10;
            const int boff = (hhk[k] < 8 ? C_BQ * 2 + hhk[k] * 128 : C_BK * 2 + (hhk[k] - 8) * 128) + l16 * 8;
            ptr[k] = (const unsigned char*)H + (size_t)tokk[k] * (INW * 2) + boff; w[k] = *(const u32x2*)ptr[k]; }
#pragma unroll
          for (int k = 0; k < 4; ++k) {
            float v[8]; fp8x4_to_f32(w[k].x, v); fp8x4_to_f32(w[k].y, v + 4);
            float ss = 0.f;
#pragma unroll
            for (int j = 0; j < 8; ++j) ss += v[j] * v[j];
            ss += __shfl_xor(ss, 1); ss += __shfl_xor(ss, 2); ss += __shfl_xor(ss, 4); ss += __shfl_xor(ss, 8);
            const float rms = rsqrtf(ss * (1.f / 128.f) + RMS_EPS);
            const float* gp = (hhk[k] < 8 ? qg : kg) + l16 * 8;
            const int tpos = tokk[k] & (S - 1);
            const int pos = (l16 < 8) ? (tpos >> 6) : (tpos & 63);
            const f32x4* rt = (const f32x4*)(ROPE + ((size_t)pos * 32 + (l16 & 3) * 8) * 2);
            const f32x4 g0 = *(const f32x4*)gp, g1 = *(const f32x4*)(gp + 4);
            const float gg[8] = {g0[0], g0[1], g0[2], g0[3], g1[0], g1[1], g1[2], g1[3]};
            float o[8];
#pragma unroll
            for (int j = 0; j < 8; ++j) v[j] = v[j] * rms * gg[j];
#pragma unroll
            for (int j2 = 0; j2 < 4; ++j2) { const f32x4 cs = rt[j2];
              const float pr0 = __shfl_xor(v[2 * j2], 4), pr1 = __shfl_xor(v[2 * j2 + 1], 4);
              o[2 * j2] = v[2 * j2] * cs[0] + ((l16 & 4) ? pr0 : -pr0) * cs[1];
              o[2 * j2 + 1] = v[2 * j2 + 1] * cs[2] + ((l16 & 4) ? pr1 : -pr1) * cs[3]; }
            u32x4 wo; wo.x = cvtpk(o[0], o[1]); wo.y = cvtpk(o[2], o[3]); wo.z = cvtpk(o[4], o[5]); wo.w = cvtpk(o[6], o[7]);
            if (ok[k]) {
#if USE_FP8_B
#pragma unroll
              for (int j = 0; j < 8; ++j) o[j] *= 0.35709583f;
              u32x2 w8; int t0 = __builtin_amdgcn_cvt_pk_fp8_f32(o[0], o[1], 0, false); w8.x = (unsigned)__builtin_amdgcn_cvt_pk_fp8_f32(o[2], o[3], t0, true);
              int t1 = __builtin_amdgcn_cvt_pk_fp8_f32(o[4], o[5], 0, false); w8.y = (unsigned)__builtin_amdgcn_cvt_pk_fp8_f32(o[6], o[7], t1, true);
              unsigned char* d8 = (hhk[k] < 8) ? Q8 + (size_t)tokk[k] * 1024 + hhk[k] * 128 + l16 * 8 : K8 + ((size_t)(hhk[k] - 8) * CT + tokk[k]) * 128 + l16 * 8;
              *(u32x2*)d8 = w8;
#else
              (void)wo;
#endif
            }
          }
        } }
#if USE_FP8_B
        { THIN_IDS();
          const int kk = lane & 31, khi = (kk >> 2) & 1, slot = khi * 32 + (kk & 3) + 4 * (kk >> 3) + 16 * (lane >> 5);
          for (int it = gw; it < 2 * (CT / 64); it += NGW) {
            const int kvh = it / (CT / 64), tl = it % (CT / 64);
            const unsigned char* vrow = (const unsigned char*)H + (size_t)(tl * 64 + lane) * (INW * 2) + C_BV * 2 + kvh * 128;
            unsigned char* dst = V8T + ((size_t)(kvh * (CT / 64) + tl) * 128) * 64 + slot;
#pragma unroll 4
            for (int d8 = 0; d8 < 16; ++d8) { const u32x2 w = *(const u32x2*)(vrow + d8 * 8);
#pragma unroll
              for (int j = 0; j < 8; ++j) dst[(d8 * 8 + j) * 64] = (unsigned char)(((j < 4 ? w.x : w.y) >> (8 * (j & 3))) & 0xff); }
          } }
#endif
#if DBG_NAIVE_A
        { THIN_IDS();
          for (int idx = gw; idx < CT * 12; idx += NGW) {
            const int tok = idx / 12, gh = idx % 12, g = gh >> 2;
            const int dil = (g == 0) ? 1 : (g == 1) ? 4 : 16, L = S / dil;
            const int seq = tok / S, tp = tok % S, r = tp % dil, u = tp / dil;
            const float slope = exp2f(-8.f * (float)(gh + 1) / 12.f);
            const size_t tok0 = (size_t)seq * S + r; const long rs = (long)dil * INW;
            bf16_t* qrow = H + (size_t)tok * INW + C_AQ + gh * 128;
            const int first = max(u - 64, 0), last = min(u + 64, L - 1);
            float m, l, o0, o1;
            naive_row(qrow, H + tok0 * INW + C_AK + gh * 128, H + tok0 * INW + C_AV + gh * 128, rs, first, last - first + 1, u, slope * (float)dil, lane, m, l, o0, o1);
            *(unsigned*)(qrow + 2 * lane) = cvtpk(o0 / l, o1 / l);
            if (lane == 0) LSE[(size_t)tok * 12 + gh] = m + __logf(l);
          } }
        for (int it = 64 * 12; it < 64 * 12; it += G) {
#else
        for (int rep = 0; rep < DBG_REP_A; ++rep)
        for (int it = cb; it < 64 * 12; it += G) {
#endif
          const int bi = it / 12, gh = it % 12, g = gh >> 2, hs = gh & 3;
          const int dil = (g == 0) ? 1 : (g == 1) ? 4 : 16, L = S / dil, bpc = L / 256;
          const int bps = S / 256, seq = bi / bps, w = bi % bps, r = w / bpc, u0 = (w % bpc) * 256;
          const float slope = exp2f(-8.f * (float)(gh + 1) / 12.f);
          const float sl = slope * (float)dil / at::SCALE;
          const size_t tok0 = (size_t)seq * S + r;
          bf16_t* Qh = H + tok0 * INW + C_AQ + gh * 128;
          const bf16_t* Kh = H + tok0 * INW + C_AK + gh * 128; const bf16_t* Vh = H + tok0 * INW + C_AV + gh * 128;
          const long rs = (long)dil * INW;
          __syncthreads();
          at::attn_body<true>(Qh + (long)u0 * rs, Kh, Vh, rs, 6, u0 - 64, u0, L, sl, Qh + (long)u0 * rs, nullptr,
                              LSE + (tok0 + (size_t)u0 * dil) * 12 + gh, (long)dil * 12, (char*)smem, rep == DBG_REP_A - 1);
        }
      }
      GSYNC();
      {
        const int bps = S / 256;
#if DBG_NAIVE_B
        { THIN_IDS();
          for (int idx = gw; idx < CT * 8; idx += NGW) {
            const int tok = idx >> 3, h = idx & 7, seq = tok / S; const size_t tok0 = (size_t)seq * S;
            float m, l, o0, o1;
            naive_row(H + (size_t)tok * INW + C_BQ + h * 128, H + tok0 * INW + C_BK + (h >> 2) * 128, H + tok0 * INW + C_BV + (h >> 2) * 128, (long)INW, 0, S, 0, 0.f, lane, m, l, o0, o1);
            const unsigned gw_ = *(const unsigned*)(H + (size_t)tok * INW + C_BG + h * 128 + 2 * lane);
            *(unsigned*)(Y + (size_t)tok * YW + 512 + h * 128 + 2 * lane) = cvtpk(o0 / l * bflo(gw_), o1 / l * bfhi(gw_));
          } }
        for (int it = 64 * 8; it < 64 * 8; it += G) {
#else
        for (int rep = 0; rep < DBG_REP_B; ++rep)
        for (int it = cb; it < 64 * 8; it += G) {
#endif
          int qb, h, seq;
          if (G == 256) {
            const int x = cb & 7, idx = (x >> 1) * 64 + (cb >> 3) * 2 + (it >> 8), qblk = idx & 63;
            h = (x & 1) * 4 + (idx >> 6); seq = qblk / bps; qb = qblk % bps;
          } else { qb = it % bps; const int sh = it / bps; h = sh & 7; seq = sh >> 3; }
          const size_t tok0 = (size_t)seq * S, row0 = tok0 + (size_t)qb * 256;
#if DBG_NO_B
          { const int t_ = fresh_tid(); for (int e = t_; e < 256 * 16; e += 512) { u32x4 z = {0u, 0u, 0u, 0u}; *(u32x4*)(Y + (row0 + (e >> 4)) * YW + 512 + h * 128 + (e & 15) * 8) = z; } }
#else
          __syncthreads();
#if USE_FP8_B
          a8::attn_body(Q8 + row0 * 1024 + h * 128, K8 + ((size_t)(h >> 2) * CT + tok0) * 128, V8T + ((size_t)(h >> 2) * (CT / 64) + tok0 / 64) * 8192, S / 64,
                        Y + row0 * YW + 512 + h * 128, (const unsigned char*)H + row0 * (INW * 2) + C_BG * 2 + h * 128, (char*)smem);
#else
          at::attn_body<false>(H + row0 * INW + C_BQ + h * 128, H + tok0 * INW + C_BK + (h >> 2) * 128, H + tok0 * INW + C_BV + (h >> 2) * 128, (long)INW, S / 64,
                               0, 0, 0, 0.f, Y + row0 * YW + 512 + h * 128, H + row0 * INW + C_BG + h * 128, nullptr, 0, (char*)smem);
#endif
#endif
        }
        THIN_IDS();
        const int l16 = lane & 15;
        for (int rep = 0; rep < DBG_REP_C; ++rep)
        for (int idx0 = gw * 4 + (lane >> 4); idx0 < CT * 4; idx0 += NGW * 16) {
          float l0[4], l1[4], l2[4]; u32x4 a[4], b[4], c[4], gt[4]; int tokk[4], hsk[4]; bool ok[4];
#pragma unroll
          for (int k = 0; k < 4; ++k) { const int idx = idx0 + k * NGW * 4; ok[k] = idx < CT * 4; const int idc = ok[k] ? idx : idx0; tokk[k] = idc >> 2; hsk[k] = idc & 3;
            const float* lp = LSE + (size_t)tokk[k] * 12 + hsk[k]; l0[k] = lp[0]; l1[k] = lp[4]; l2[k] = lp[8];
            const bf16_t* hp = H + (size_t)tokk[k] * INW + hsk[k] * 128 + l16 * 8;
            a[k] = *(const u32x4*)(hp); b[k] = *(const u32x4*)(hp + 512); c[k] = *(const u32x4*)(hp + 1024); gt[k] = *(const u32x4*)(hp + C_AG); }
#pragma unroll
          for (int k = 0; k < 4; ++k) {
            const float mx = fmaxf(l0[k], fmaxf(l1[k], l2[k]));
            float e0 = __expf(l0[k] - mx), e1 = __expf(l1[k] - mx), e2 = __expf(l2[k] - mx);
            const float inv = 1.f / (e0 + e1 + e2); e0 *= inv; e1 *= inv; e2 *= inv;
            float o[8];
#define CMB(j, W, HL) o[j] = (e0 * HL(a[k].W) + e1 * HL(b[k].W) + e2 * HL(c[k].W)) * HL(gt[k].W)
            CMB(0, x, bflo); CMB(1, x, bfhi); CMB(2, y, bflo); CMB(3, y, bfhi); CMB(4, z, bflo); CMB(5, z, bfhi); CMB(6, w, bflo); CMB(7, w, bfhi);
#undef CMB
            u32x4 wo; wo.x = cvtpk(o[0], o[1]); wo.y = cvtpk(o[2], o[3]); wo.z = cvtpk(o[4], o[5]); wo.w = cvtpk(o[6], o[7]);
            if (ok[k]) *(u32x4*)(Y + (size_t)tokk[k] * YW + hsk[k] * 128 + l16 * 8) = wo;
          }
        }
      }
      GSYNC();
      { pg8::SchedMerge s; s.nM = CT / 256; s.nN = DM / 256; s.G = G; s.c = cb; s.lda = YW; s.ldb = YW; s.A = (const char*)Y; s.B = (const char*)(WAB + (size_t)l * DM * YW);
        pg8::EpiMerge e; e.H = H; e.T = T; e.MRG = MRG;
        for (int rep = 0; rep < DBG_REP_P4; ++rep) pg8::gemm_phase((LAS unsigned char*)smem, s, e); }
      GSYNC();
#if USE_LN_FUSED
      if (G == 256) {
      { pg8::SchedStd s; s.nM = CT / 256; s.nN = DM / 256; s.G = G; s.c = cb; s.lda = DM; s.ldb = DM; s.nt = DM / 64; s.A = (const char*)MRG; s.B = (const char*)(WO + (size_t)l * DM * DM);
        pg8::EpiLN e; e.X = (l == 0) ? xin : (const float*)outc; e.Yo = outc; e.XB8 = (unsigned char*)XB; e.g = p.ln_g + l * DM; e.b = p.ln_b + l * DM;
        e.slots = (unsigned long long*)(p.ws + WS_LNX); e.cnt = (unsigned*)(p.ws + WS_LNC) + (size_t)(ch * DEPTH + l) * 64 * 64; e.write_xb = (l == 0);
        pg8::gemm_phase((LAS unsigned char*)smem, s, e); }
      if (l == DEPTH - 1 && ch + 1 < NCH) { THIN_IDS(); convert_x((ch + 1 < 2) ? p.x_prompt + (size_t)(ch + 1) * CT * DM : p.x_sample, XB, gtid, gthreads); }
      GSYNC();
      } else
#endif
      {
      { pg8::SchedStd s; s.nM = CT / 256; s.nN = DM / 256; s.G = G; s.c = cb; s.lda = DM; s.ldb = DM; s.nt = DM / 64; s.A = (const char*)MRG; s.B = (const char*)(WO + (size_t)l * DM * DM);
        pg8::EpiOut e; e.X = (l == 0) ? xin : (const float*)outc; e.Z = outc;
        pg8::gemm_phase((LAS unsigned char*)smem, s, e); }
      GSYNC();
      {
        THIN_IDS();
        const float* gmm = p.ln_g + l * DM; const float* bta = p.ln_b + l * DM;
        f32x4 gv[4], bv[4];
#pragma unroll
        for (int j = 0; j < 4; ++j) { gv[j] = *(const f32x4*)(gmm + (j * 64 + lane) * 4); bv[j] = *(const f32x4*)(bta + (j * 64 + lane) * 4); }
        for (int row0 = gw; row0 < CT; row0 += NGW * 4) {
          f32x4 v[4][4];
#pragma unroll
          for (int k = 0; k < 4; ++k) { const int row = min(row0 + k * NGW, CT - 1); const float* zr = outc + (size_t)row * DM;
#pragma unroll
            for (int j = 0; j < 4; ++j) v[k][j] = *(const f32x4*)(zr + (j * 64 + lane) * 4); }
#pragma unroll
          for (int k = 0; k < 4; ++k) { const int row = row0 + k * NGW; float* zr = outc + (size_t)min(row, CT - 1) * DM;
            float s = 0.f;
#pragma unroll
            for (int j = 0; j < 4; ++j) s += (v[k][j][0] + v[k][j][1]) + (v[k][j][2] + v[k][j][3]);
            const float mean = wave_sum(s) * (1.f / DM); float s2 = 0.f;
#pragma unroll
            for (int j = 0; j < 4; ++j) { v[k][j] = v[k][j] - mean; s2 += (v[k][j][0] * v[k][j][0] + v[k][j][1] * v[k][j][1]) + (v[k][j][2] * v[k][j][2] + v[k][j][3] * v[k][j][3]); }
            const float rstd = rsqrtf(wave_sum(s2) * (1.f / DM) + LN_EPS);
            if (row < CT) {
#pragma unroll
              for (int j = 0; j < 4; ++j) { const f32x4 y = v[k][j] * rstd * gv[j] + bv[j]; *(f32x4*)(zr + (j * 64 + lane) * 4) = y;
#if USE_FP8_P1
                if (l == 0) *(unsigned*)((unsigned char*)XB + (size_t)row * DM + (j * 64 + lane) * 4) = pk4_fp8(y[0], y[1], y[2], y[3]); } }
#else
                if (l == 0) { u32x2 w; w.x = cvtpk(y[0], y[1]); w.y = cvtpk(y[2], y[3]); *(u32x2*)(XB + (size_t)row * DM + (j * 64 + lane) * 4) = w; } } }
#endif
          }
        }
        if (l == DEPTH - 1 && ch + 1 < NCH) convert_x((ch + 1 < 2) ? p.x_prompt + (size_t)(ch + 1) * CT * DM : p.x_sample, XB, gtid, gthreads);
      }
      GSYNC();
      }
    }
  }
}

extern "C" void kernel_launch(void* const* d_in, const int* in_sizes, int n_in, void* d_out, int out_size, void* d_ws, size_t ws_size, hipStream_t stream) {
  static int grid_blocks = 0;
  if (grid_blocks == 0) {
    if (n_in != 11 || out_size != NCH * CT * DM || ws_size < WS_END) { fprintf(stderr, "kernel_launch: unexpected shapes n_in %d out %d ws %zu (need %zu)\n", n_in, out_size, ws_size, (size_t)WS_END); grid_blocks = -1; return; }
    int dev = 0, cus = 0, per_cu = 0;
    hipGetDevice(&dev);
    hipDeviceGetAttribute(&cus, hipDeviceAttributeMultiprocessorCount, dev);
    if (hipFuncSetAttribute((const void*)fwd_megakernel, hipFuncAttributeMaxDynamicSharedMemorySize, LDS_BYTES) != hipSuccess) { fprintf(stderr, "kernel_launch: hipFuncSetAttribute failed\n"); grid_blocks = -1; return; }
    hipOccupancyMaxActiveBlocksPerMultiprocessor(&per_cu, (const void*)fwd_megakernel, 512, LDS_BYTES);
    if (per_cu < 1) { fprintf(stderr, "kernel_launch: occupancy query says %d blocks per CU\n", per_cu); per_cu = 1; }
    (void)hipGetLastError();
    grid_blocks = cus;
  }
  if (grid_blocks < 0) return;
  Params p{};
  p.x_prompt = (const float*)d_in[0]; p.x_sample = (const float*)d_in[1]; p.w_in = (const float*)d_in[2]; p.b_in = (const float*)d_in[3];
  p.q_gain = (const float*)d_in[4]; p.k_gain = (const float*)d_in[5]; p.w_pa = (const float*)d_in[6]; p.w_pb = (const float*)d_in[7];
  p.w_out = (const float*)d_in[8]; p.ln_g = (const float*)d_in[9]; p.ln_b = (const float*)d_in[10];
  p.out = (float*)d_out; p.ws = (char*)d_ws;
  if (hipMemsetAsync((char*)d_ws + WS_BAR, 0, WS_ZERO_END - WS_BAR, stream) != hipSuccess) { fprintf(stderr, "kernel_launch: memset of the barrier words failed\n"); return; }
  void* args[] = {&p};
  hipError_t e = hipLaunchCooperativeKernel((const void*)fwd_megakernel, dim3(grid_blocks), dim3(512), args, LDS_BYTES, stream);
  if (e != hipSuccess) fprintf(stderr, "cooperative launch failed: %s (grid %d)\n", hipGetErrorString(e), grid_blocks);
}
```

```cpp
#include <hip/hip_runtime.h>
#include <hip/hip_cooperative_groups.h>
#include <cstdio>
#include <cstdint>
namespace cg = cooperative_groups;

#define LAS __attribute__((address_space(3)))
typedef unsigned short bf16_t;
typedef short bf16x8 __attribute__((ext_vector_type(8)));
typedef short s16x4 __attribute__((ext_vector_type(4)));
typedef float f32x4 __attribute__((ext_vector_type(4)));
typedef float f32x16 __attribute__((ext_vector_type(16)));
typedef unsigned u32x4 __attribute__((ext_vector_type(4)));
typedef unsigned u32x2 __attribute__((ext_vector_type(2)));
typedef int v4i_t __attribute__((ext_vector_type(4)));
typedef int v8i_t __attribute__((ext_vector_type(8)));

constexpr int DM = 1024, INW = 9728, CT = 16384, NCH = 3, DEPTH = 2;
constexpr int C_AQ = 0, C_AK = 1536, C_AV = 3072, C_AG = 4608, C_BQ = 5120, C_BK = 6144, C_BV = 6400, C_BG = 6656, C_GA = 7680, C_GB = 8704;
constexpr int YW = 1536;
constexpr float ALPHA = 1.41421356237309515f;
constexpr float RMS_EPS = 1e-6f, LN_EPS = 1e-5f;
constexpr size_t WS_WIN = 0;
constexpr size_t WS_WAB = WS_WIN + (size_t)2 * INW * DM * 2;
constexpr size_t WS_WO  = WS_WAB + (size_t)2 * DM * YW * 2;
constexpr size_t WS_XB  = WS_WO + (size_t)2 * DM * DM * 2;
constexpr size_t WS_H   = WS_XB + (size_t)CT * DM * 2;
constexpr size_t WS_Y   = WS_H + (size_t)CT * INW * 2;
constexpr size_t WS_MRG = WS_Y + (size_t)CT * YW * 2;
constexpr size_t WS_LSE = WS_MRG + (size_t)CT * DM * 2;
constexpr size_t WS_ROPE = WS_LSE + (size_t)CT * 12 * 4;
constexpr size_t WS_BAR = WS_ROPE + 256 * 32 * 2 * 4;
constexpr size_t WS_LNC = (WS_BAR + 3456 * 4 + 255) / 256 * 256;
constexpr size_t WS_ZERO_END = WS_LNC + (size_t)6 * 64 * 64 * 4;
constexpr size_t WS_LNX = WS_ZERO_END;
constexpr size_t WS_Q8  = (WS_LNX + (size_t)CT * 4 * 8 + 255) / 256 * 256;
constexpr size_t WS_K8  = WS_Q8 + (size_t)CT * 1024;
constexpr size_t WS_V8T = WS_K8 + (size_t)2 * CT * 128;
constexpr size_t WS_END = WS_V8T + (size_t)2 * CT * 128;
constexpr int LDS_BYTES = 132 * 1024;
#ifndef USE_LN_FUSED
#define USE_LN_FUSED 1
#endif
#ifndef USE_FP8_P1
#define USE_FP8_P1 1
#endif
#ifndef USE_FP8_B
#define USE_FP8_B 1
#endif
#ifndef DBG_UNIFORM
#define DBG_UNIFORM 0
#endif
#ifndef DBG_NAIVE_A
#define DBG_NAIVE_A 0
#endif
#ifndef DBG_NAIVE_B
#define DBG_NAIVE_B 0
#endif
#ifndef DBG_REP_A
#define DBG_REP_A 1
#endif
#ifndef DBG_REP_P4
#define DBG_REP_P4 1
#endif
#ifndef DBG_REP_C
#define DBG_REP_C 1
#endif
#ifndef DBG_REP_P1
#define DBG_REP_P1 1
#endif
#ifndef DBG_REP_B
#define DBG_REP_B 1
#endif
#ifndef DBG_NO_B
#define DBG_NO_B 0
#endif

struct Params {
  const float *x_prompt, *x_sample, *w_in, *b_in, *q_gain, *k_gain, *w_pa, *w_pb, *w_out, *ln_g, *ln_b;
  float* out; char* ws;
};

__device__ __forceinline__ int fresh_tid() { int t = threadIdx.x; asm volatile("" : "+v"(t)); return t; }
__device__ __forceinline__ unsigned cvtpk(float lo, float hi) { unsigned r; asm volatile("v_cvt_pk_bf16_f32 %0, %1, %2" : "=v"(r) : "v"(lo), "v"(hi)); return r; }
__device__ __forceinline__ float bflo(unsigned w) { return __uint_as_float(w << 16); }
__device__ __forceinline__ float bfhi(unsigned w) { return __uint_as_float(w & 0xffff0000u); }
__device__ __forceinline__ float bf2f(bf16_t b) { return __uint_as_float(((unsigned)b) << 16); }
__device__ __forceinline__ unsigned pk4_fp8(float a, float b, float c, float d) { const int t = __builtin_amdgcn_cvt_pk_fp8_f32(a, b, 0, false); return (unsigned)__builtin_amdgcn_cvt_pk_fp8_f32(c, d, t, true); }
typedef float f32x2_t __attribute__((ext_vector_type(2)));
__device__ __forceinline__ void fp8x4_to_f32(unsigned w, float* o) { const f32x2_t lo = __builtin_amdgcn_cvt_pk_f32_fp8((int)w, false), hi = __builtin_amdgcn_cvt_pk_f32_fp8((int)w, true); o[0] = lo[0]; o[1] = lo[1]; o[2] = hi[0]; o[3] = hi[1]; }
__device__ __forceinline__ float sigmoidf_(float x) { return __builtin_amdgcn_rcpf(1.f + __builtin_amdgcn_exp2f(-1.4426950408889634f * x)); }

namespace pg8 {
constexpr int BM = 256, BK = 64, HALF = 128, HTB = HALF * BK * 2, STAGE_BYTES = 8 * HTB, NXCD = 8, WGM = 8;
__device__ __forceinline__ int lds_byte(int r, int c) { const int st = (r >> 4) * 2 + (c >> 5), rr = r & 15, cc = c & 31, ob = rr * 64 + cc * 2; return st * 1024 + (ob ^ (((ob >> 9) & 1) << 5)); }
__device__ __forceinline__ void stage_rc(int b, int& R, int& C) { const int st = b / 1024, sb = b % 1024, swz = sb ^ (((sb >> 9) & 1) << 5); R = (st >> 1) * 16 + swz / 64; C = (st & 1) * 32 + (swz % 64) / 2; }
__device__ __forceinline__ int perm32(int rho) { const int n = rho >> 4, i = rho & 15; return 8 * (i >> 2) + 4 * n + (i & 3); }
struct Unit { int pm, pn, kind; };
__device__ __forceinline__ bool tile_of(int L, int nM, int nN, int& pm, int& pn) {
  const int nwg = nM * nN; if (L >= nwg) return false;
  int wgid = L; { const int q = nwg / NXCD, r = nwg % NXCD, xcd = wgid % NXCD, off = wgid / NXCD; wgid = (xcd < r ? xcd * (q + 1) : r * (q + 1) + (xcd - r) * q) + off; }
  const int nig = WGM * nN, gid = wgid / nig, fm = gid * WGM, gsz = (nM - fm) < WGM ? (nM - fm) : WGM;
  pm = fm + ((wgid % nig) % gsz); pn = (wgid % nig) / gsz; return true;
}
struct SchedStd {
  int nM, nN, G, c, lda, ldb, nt; const char *A, *B;
  __device__ __forceinline__ bool next(int i, Unit& u) const { u.kind = 0; return tile_of(i * G + c, nM, nN, u.pm, u.pn); }
  __device__ __forceinline__ void op(const Unit& u, const char*& a, const char*& b, int& n) const { a = A + (size_t)u.pm * BM * lda * 2; b = B + (size_t)u.pn * BM * ldb * 2; n = nt; }
};
struct SchedMerge {
  int nM, nN, G, c, lda, ldb; const char *A, *B;
  __device__ __forceinline__ bool next(int i, Unit& u) const { u.kind = i & 1; return tile_of((i >> 1) * G + c, nM, nN, u.pm, u.pn); }
  __device__ __forceinline__ void op(const Unit& u, const char*& a, const char*& b, int& n) const {
    a = A + (size_t)u.pm * BM * lda * 2 + (u.kind ? 1024 : 0); b = B + (size_t)u.pn * BM * ldb * 2 + (u.kind ? 1024 : 0); n = u.kind ? 16 : 8; }
};

struct EpiIn {
  static __device__ __forceinline__ bool keep_acc(const Unit&) { return false; }
  static constexpr bool AFTER_DRAIN = false;
  static constexpr bool PERM = true;
  bf16_t* H; const float* bias; float ascale;
  __device__ __forceinline__ void operator()(const f32x4 (&acc)[2][2][4][2], const Unit& u, int wr, int wc, int fr, int fq) const {
    const int row0 = u.pm * BM + wr * 64 + fr, col0 = u.pn * BM + wc * 32 + 8 * fq;
    const int act = (u.pn >= 30) ? 2 : (((u.pn >= 18 && u.pn < 20) || (u.pn >= 26)) ? 1 : 0);
    const bool f8 = (u.pn >= 20 && u.pn < 30) || (u.pn >= 34);
    const int fs = (u.pn < 24) ? C_BQ : (u.pn == 24) ? C_BK : (u.pn == 25) ? C_BV : (u.pn < 30) ? C_BG : C_GB;
    f32x4 bv[2][2];
#pragma unroll
    for (int bj = 0; bj < 2; ++bj)
#pragma unroll
      for (int n = 0; n < 2; ++n) bv[bj][n] = *(const f32x4*)(bias + col0 + bj * HALF + 4 * n);
#pragma unroll
    for (int ai = 0; ai < 2; ++ai)
#pragma unroll
      for (int m = 0; m < 4; ++m) { bf16_t* rowp = H + (size_t)(row0 + ai * HALF + m * 16) * INW + col0;
#pragma unroll
        for (int bj = 0; bj < 2; ++bj) { f32x4 v0 = acc[ai][bj][m][0] * ascale + bv[bj][0], v1 = acc[ai][bj][m][1] * ascale + bv[bj][1];
          if (act) {
#pragma unroll
            for (int j = 0; j < 4; ++j) { const float s0 = sigmoidf_(v0[j]), s1 = sigmoidf_(v1[j]); v0[j] = (act == 1) ? v0[j] * s0 : s0; v1[j] = (act == 1) ? v1[j] * s1 : s1; } }
          if (f8) { u32x2 w8; w8.x = pk4_fp8(v0[0], v0[1], v0[2], v0[3]); w8.y = pk4_fp8(v1[0], v1[1], v1[2], v1[3]);
            *(u32x2*)((unsigned char*)H + (size_t)(row0 + ai * HALF + m * 16) * (INW * 2) + fs * 2 + (col0 - fs) + bj * HALF) = w8; }
          else { u32x4 w; w.x = cvtpk(v0[0], v0[1]); w.y = cvtpk(v0[2], v0[3]); w.z = cvtpk(v1[0], v1[1]); w.w = cvtpk(v1[2], v1[3]);
            *(u32x4*)(rowp + bj * HALF) = w; } } }
  }
};
struct EpiMerge {
  static constexpr bool AFTER_DRAIN = false;
  static constexpr bool PERM = true;
  const bf16_t* H; bf16_t* T; bf16_t* MRG;
  static __device__ __forceinline__ bool keep_acc(const Unit& u) { return u.kind == 0; }
  __device__ __forceinline__ void operator()(f32x4 (&acc)[2][2][4][2], const Unit& u, int wr, int wc, int fr, int fq) const {
    const int row0 = u.pm * BM + wr * 64 + fr, col0 = u.pn * BM + wc * 32 + 8 * fq;
#pragma unroll
    for (int ai = 0; ai < 2; ++ai)
#pragma unroll
      for (int m = 0; m < 4; ++m) { const size_t row = (size_t)(row0 + ai * HALF + m * 16);
#pragma unroll
        for (int bj = 0; bj < 2; ++bj) {
          float gb[8];
          { const u32x2 g8 = *(const u32x2*)((const unsigned char*)H + row * (INW * 2) + C_GB * 2 + col0 + bj * HALF); fp8x4_to_f32(g8.x, gb); fp8x4_to_f32(g8.y, gb + 4); }
#pragma unroll
          for (int j = 0; j < 8; ++j) gb[j] = fmaxf(gb[j], 9.765625e-4f);
          if (u.kind == 0) {
            const u32x4 g = *(const u32x4*)(H + row * INW + C_GA + col0 + bj * HALF);
            const float ga[8] = {bflo(g.x), bfhi(g.x), bflo(g.y), bfhi(g.y), bflo(g.z), bfhi(g.z), bflo(g.w), bfhi(g.w)};
#pragma unroll
            for (int j = 0; j < 4; ++j) { acc[ai][bj][m][0][j] *= ga[j] * __builtin_amdgcn_rcpf(gb[j]); acc[ai][bj][m][1][j] *= ga[4 + j] * __builtin_amdgcn_rcpf(gb[4 + j]); }
          } else {
            const f32x4 a0 = acc[ai][bj][m][0], a1 = acc[ai][bj][m][1];
            u32x4 w; w.x = cvtpk(a0[0] * gb[0], a0[1] * gb[1]); w.y = cvtpk(a0[2] * gb[2], a0[3] * gb[3]); w.z = cvtpk(a1[0] * gb[4], a1[1] * gb[5]); w.w = cvtpk(a1[2] * gb[6], a1[3] * gb[7]);
            *(u32x4*)(MRG + row * DM + col0 + bj * HALF) = w; } } }
  }
};
struct EpiOut {
  static __device__ __forceinline__ bool keep_acc(const Unit&) { return false; }
  static constexpr bool AFTER_DRAIN = false;
  static constexpr bool PERM = true;
  const float* X; float* Z;
  __device__ __forceinline__ void operator()(const f32x4 (&acc)[2][2][4][2], const Unit& u, int wr, int wc, int fr, int fq) const {
    const int row0 = u.pm * BM + wr * 64 + fr, col0 = u.pn * BM + wc * 32 + 8 * fq;
#pragma unroll
    for (int ai = 0; ai < 2; ++ai)
#pragma unroll
      for (int m = 0; m < 4; ++m) { const size_t off = (size_t)(row0 + ai * HALF + m * 16) * DM + col0;
#pragma unroll
        for (int bj = 0; bj < 2; ++bj)
#pragma unroll
          for (int n = 0; n < 2; ++n) { const f32x4 xv = *(const f32x4*)(X + off + bj * HALF + n * 4); *(f32x4*)(Z + off + bj * HALF + n * 4) = xv * ALPHA + acc[ai][bj][m][n]; } }
  }
};


struct EpiLN {
  static __device__ __forceinline__ bool keep_acc(const Unit&) { return false; }
  static constexpr bool PERM = true, AFTER_DRAIN = true;
  const float* X; float* Yo; unsigned char* XB8; const float* g; const float* b; unsigned long long* slots; unsigned* cnt; int write_xb;
  __device__ __forceinline__ void fused(f32x4 (&acc)[2][2][4][2], const Unit& u, int wr, int wc, int fr, int fq, LAS unsigned char* lds, int wid, int lane) const {
    typedef float f32x2v __attribute__((ext_vector_type(2)));
    LAS f32x2v* P = (LAS f32x2v*)lds;
    LAS f32x2v* S = (LAS f32x2v*)(lds + 8192);
    const int col0 = u.pn * BM + wc * 32 + 8 * fq;
#pragma unroll
    for (int ai = 0; ai < 2; ++ai)
#pragma unroll
      for (int m = 0; m < 4; ++m) { const int rl = ai * HALF + wr * 64 + m * 16 + fr; const size_t off = (size_t)(u.pm * BM + rl) * DM + col0;
        float s1 = 0.f, s2 = 0.f;
#pragma unroll
        for (int bj = 0; bj < 2; ++bj)
#pragma unroll
          for (int n = 0; n < 2; ++n) { const f32x4 xv = *(const f32x4*)(X + off + bj * HALF + n * 4); const f32x4 z = xv * ALPHA + acc[ai][bj][m][n]; acc[ai][bj][m][n] = z;
            s1 += (z[0] + z[1]) + (z[2] + z[3]); s2 += (z[0] * z[0] + z[1] * z[1]) + (z[2] * z[2] + z[3] * z[3]); }
        s1 += __shfl_xor(s1, 16); s1 += __shfl_xor(s1, 32); s2 += __shfl_xor(s2, 16); s2 += __shfl_xor(s2, 32);
        if (fq == 0) P[rl * 4 + wc] = (f32x2v){s1, s2};
        asm volatile("" ::: "memory"); }
    asm volatile("s_waitcnt lgkmcnt(0)" ::: "memory"); __builtin_amdgcn_s_barrier(); asm volatile("" ::: "memory");
    const int t = wid * 64 + lane;
    if (t < 256) { const f32x2v a = P[t * 4 + 0], b2 = P[t * 4 + 1], c = P[t * 4 + 2], d = P[t * 4 + 3];
      const float m1 = (a.x + b2.x) + (c.x + d.x), m2 = (a.y + b2.y) + (c.y + d.y);
      __hip_atomic_store(slots + ((size_t)(u.pm * BM + t) * 4 + u.pn), ((unsigned long long)__float_as_uint(m2) << 32) | __float_as_uint(m1), __ATOMIC_RELAXED, __HIP_MEMORY_SCOPE_AGENT); }
    asm volatile("s_waitcnt vmcnt(0)" ::: "memory"); __builtin_amdgcn_s_barrier(); asm volatile("" ::: "memory");
    if (t == 0) { __hip_atomic_fetch_add(cnt + 64 * u.pm, 1u, __ATOMIC_RELAXED, __HIP_MEMORY_SCOPE_AGENT);
      unsigned sp = 0; while (__hip_atomic_load(cnt + 64 * u.pm, __ATOMIC_RELAXED, __HIP_MEMORY_SCOPE_AGENT) < 4u) { __builtin_amdgcn_s_sleep(2); if (++sp > (1u << 22)) break; }
      __builtin_amdgcn_fence(__ATOMIC_ACQUIRE, "agent"); asm volatile("s_waitcnt vmcnt(0)" ::: "memory"); }
    __builtin_amdgcn_s_barrier(); asm volatile("" ::: "memory");
    if (t < 256) { const unsigned long long* sl = slots + (size_t)(u.pm * BM + t) * 4; float m1 = 0.f, m2 = 0.f;
#pragma unroll
      for (int q = 0; q < 4; ++q) { const unsigned long long w = __hip_atomic_load(sl + q, __ATOMIC_RELAXED, __HIP_MEMORY_SCOPE_AGENT); m1 += __uint_as_float((unsigned)w); m2 += __uint_as_float((unsigned)(w >> 32)); }
      const float mean = m1 * (1.f / DM), var = fmaxf(m2 * (1.f / DM) - mean * mean, 0.f);
      S[t] = (f32x2v){mean, rsqrtf(var + LN_EPS)}; }
    asm volatile("s_waitcnt lgkmcnt(0)" ::: "memory"); __builtin_amdgcn_s_barrier(); asm volatile("" ::: "memory");
#pragma unroll
    for (int bj = 0; bj < 2; ++bj)
#pragma unroll
      for (int n = 0; n < 2; ++n) { const f32x4 gv = *(const f32x4*)(g + col0 + bj * HALF + n * 4), bv = *(const f32x4*)(b + col0 + bj * HALF + n * 4);
#pragma unroll
        for (int ai = 0; ai < 2; ++ai)
#pragma unroll
          for (int m = 0; m < 4; ++m) { const int rl = ai * HALF + wr * 64 + m * 16 + fr; const f32x2v st = S[rl]; const size_t row = (size_t)(u.pm * BM + rl);
            const f32x4 y = (acc[ai][bj][m][n] - st.x) * st.y * gv + bv;
            *(f32x4*)(Yo + row * DM + col0 + bj * HALF + n * 4) = y;
            if (write_xb) *(unsigned*)(XB8 + row * DM + col0 + bj * HALF + n * 4) = pk4_fp8(y[0], y[1], y[2], y[3]); } }
  }
};

template <class Epi, class Sched, bool FP8 = false>
__device__ __forceinline__ void gemm_phase(LAS unsigned char* lds, const Sched& S, const Epi& E) {
  const int tid = fresh_tid(), wid = __builtin_amdgcn_readfirstlane(tid >> 6), lane = tid & 63, wr = wid >> 2, wc = wid & 3, fr = lane & 15, fq = lane >> 4;
  const int lda = S.lda, ldb = S.ldb;
  unsigned voffA[2], voffB[2];
#pragma unroll
  for (int i = 0; i < 2; ++i) { int R, C; stage_rc(tid * 16 + i * 8192, R, C); const int Rb = Epi::PERM ? ((R & ~31) + perm32(R & 31)) : R;
    voffA[i] = (unsigned)(R * lda + C) * 2u; voffB[i] = (unsigned)(Rb * ldb + C) * 2u; }
  const size_t kstep = (size_t)(BK * 2);
  const size_t hstepA = (size_t)HALF * lda * 2, hstepB = (size_t)HALF * ldb * 2;
  const unsigned ldsw = (unsigned)wid * 1024u;
  const int aoff = lds_byte(wr * 64 + fr, fq * 8), boff = lds_byte(wc * 32 + fr, fq * 8);
#define PG8_SA(b, h) (((b) * 2 + (h)) * HTB)
#define PG8_SB(b, h) ((4 + (b) * 2 + (h)) * HTB)
#define PG8_STAGE(bufoff, gbase, voff) do { _Pragma("unroll") for (int _i = 0; _i < 2; ++_i) \
    __builtin_amdgcn_global_load_lds((const unsigned*)((const char*)(gbase) + (voff)[_i]), (LAS unsigned*)(lds + (bufoff) + ldsw + _i * 8192), 16, 0, 0); } while (0)
#define PG8_LDA(dst, b, h) do { if constexpr (FP8) { _Pragma("unroll") for (int m = 0; m < 4; ++m) dst##8[m] = __builtin_shufflevector(*(const LAS v4i_t*)(lds + PG8_SA(b, h) + aoff + m * 2048), *(const LAS v4i_t*)(lds + PG8_SA(b, h) + aoff + m * 2048 + 1024), 0, 1, 2, 3, 4, 5, 6, 7); } \
    else { _Pragma("unroll") for (int m = 0; m < 4; ++m) _Pragma("unroll") for (int k = 0; k < 2; ++k) dst[m][k] = *(const LAS bf16x8*)(lds + PG8_SA(b, h) + aoff + m * 2048 + k * 1024); } } while (0)
#define PG8_LDB(dst, b, h) do { if constexpr (FP8) { _Pragma("unroll") for (int n = 0; n < 2; ++n) dst##8[n] = __builtin_shufflevector(*(const LAS v4i_t*)(lds + PG8_SB(b, h) + boff + n * 2048), *(const LAS v4i_t*)(lds + PG8_SB(b, h) + boff + n * 2048 + 1024), 0, 1, 2, 3, 4, 5, 6, 7); } \
    else { _Pragma("unroll") for (int n = 0; n < 2; ++n) _Pragma("unroll") for (int k = 0; k < 2; ++k) dst[n][k] = *(const LAS bf16x8*)(lds + PG8_SB(b, h) + boff + n * 2048 + k * 1024); } } while (0)
#define PG8_CAT(x, y) __builtin_shufflevector(__builtin_bit_cast(v4i_t, x), __builtin_bit_cast(v4i_t, y), 0, 1, 2, 3, 4, 5, 6, 7)
#define PG8_MMA(ai, bj, At, Bt) do { __builtin_amdgcn_s_setprio(1); \
    if constexpr (FP8) { _Pragma("unroll") for (int m = 0; m < 4; ++m) _Pragma("unroll") for (int n = 0; n < 2; ++n) \
      asm volatile("v_mfma_f32_16x16x128_f8f6f4 %0, %1, %2, %0" : "+v"(acc[ai][bj][m][n]) : "v"(Bt##8[n]), "v"(At##8[m])); } \
    else { _Pragma("unroll") for (int m = 0; m < 4; ++m) _Pragma("unroll") for (int n = 0; n < 2; ++n) _Pragma("unroll") for (int k = 0; k < 2; ++k) \
      acc[ai][bj][m][n] = __builtin_amdgcn_mfma_f32_16x16x32_bf16(Bt[n][k], At[m][k], acc[ai][bj][m][n], 0, 0, 0); } \
    __builtin_amdgcn_s_setprio(0); } while (0)
#define PG8_WAIT_V(n) asm volatile("s_waitcnt vmcnt(" #n ")" ::: "memory")
#define PG8_WAIT_L(n) asm volatile("s_waitcnt lgkmcnt(" #n ")" ::: "memory")
#define PG8_BAR __builtin_amdgcn_s_barrier()
#define PG8_SCHED __builtin_amdgcn_sched_barrier(0)
  Unit cur, nxt; int ui = 0;
  if (!S.next(0, cur)) return;
  f32x4 acc[2][2][4][2];
#pragma unroll
  for (int a = 0; a < 2; ++a)
#pragma unroll
    for (int b = 0; b < 2; ++b)
#pragma unroll
      for (int m = 0; m < 4; ++m)
#pragma unroll
        for (int n = 0; n < 2; ++n) acc[a][b][m][n] = (f32x4){0.f, 0.f, 0.f, 0.f};
  bf16x8 At[4][2], B0[2][2], B1[2][2]; v8i_t At8[4], B08[2], B18[2]; (void)At; (void)B0; (void)B1; (void)At8; (void)B08; (void)B18;
  const char *cA, *cB; int nt; S.op(cur, cA, cB, nt);
  PG8_STAGE(PG8_SB(0, 0), cB, voffB); PG8_STAGE(PG8_SA(0, 0), cA, voffA); PG8_STAGE(PG8_SB(0, 1), cB + hstepB, voffB); PG8_STAGE(PG8_SA(0, 1), cA + hstepA, voffA);
  if (wr == 1) PG8_BAR;
  PG8_WAIT_V(4); PG8_BAR;
  PG8_STAGE(PG8_SB(1, 0), cB + kstep, voffB); PG8_STAGE(PG8_SA(1, 0), cA + kstep, voffA); PG8_STAGE(PG8_SB(1, 1), cB + hstepB + kstep, voffB);
  PG8_WAIT_V(6); PG8_BAR;
  for (;;) {
    const bool has_next = S.next(ui + 1, nxt);
    const char *nA = cA, *nB = cB; int nnt = nt;
    if (has_next) S.op(nxt, nA, nB, nnt);
    for (int t = 0; t < nt; t += 2) {
      const bool last = (t == nt - 2);
      const char* a1 = cA + (size_t)(t + 1) * kstep;
      const char* a2 = last ? nA : cA + (size_t)(t + 2) * kstep; const char* b2 = last ? nB : cB + (size_t)(t + 2) * kstep;
      const char* a3 = a2 + kstep; const char* b3 = b2 + kstep;
      PG8_LDB(B0, 0, 0); PG8_SCHED; PG8_LDA(At, 0, 0); PG8_STAGE(PG8_SA(1, 1), a1 + hstepA, voffA);
      PG8_WAIT_L(8); PG8_BAR; PG8_WAIT_L(0); PG8_MMA(0, 0, At, B0); PG8_BAR; PG8_SCHED;
      PG8_LDB(B1, 0, 1); PG8_STAGE(PG8_SB(0, 0), b2, voffB);
      PG8_BAR; PG8_WAIT_L(0); PG8_MMA(0, 1, At, B1); PG8_BAR;
      PG8_LDA(At, 0, 1); PG8_STAGE(PG8_SA(0, 0), a2, voffA);
      PG8_BAR; PG8_WAIT_L(0); PG8_MMA(1, 0, At, B0); PG8_BAR; PG8_SCHED;
      PG8_STAGE(PG8_SB(0, 1), b2 + hstepB, voffB);
      PG8_WAIT_V(6); PG8_BAR; PG8_MMA(1, 1, At, B1); PG8_BAR;
      PG8_LDB(B0, 1, 0); PG8_SCHED; PG8_LDA(At, 1, 0); PG8_STAGE(PG8_SA(0, 1), a2 + hstepA, voffA);
      PG8_WAIT_L(8); PG8_BAR; PG8_WAIT_L(0); PG8_MMA(0, 0, At, B0); PG8_BAR; PG8_SCHED;
      PG8_LDB(B1, 1, 1); PG8_STAGE(PG8_SB(1, 0), b3, voffB);
      PG8_BAR; PG8_WAIT_L(0); PG8_MMA(0, 1, At, B1); PG8_BAR;
      PG8_LDA(At, 1, 1); PG8_STAGE(PG8_SA(1, 0), a3, voffA);
      PG8_BAR; PG8_WAIT_L(0); PG8_MMA(1, 0, At, B0); PG8_BAR; PG8_SCHED;
      PG8_STAGE(PG8_SB(1, 1), b3 + hstepB, voffB);
      PG8_WAIT_V(6); PG8_BAR; PG8_MMA(1, 1, At, B1); PG8_BAR;
    }
    if constexpr (FP8) asm volatile("s_nop 15\n\ts_nop 15\n\ts_nop 15" ::: "memory");
    if constexpr (!Epi::AFTER_DRAIN) { Unit ue = cur; int fr_ = fr, fq_ = fq;
      asm volatile("" : "+s"(ue.pm), "+s"(ue.pn), "+s"(ue.kind), "+v"(fr_), "+v"(fq_));
      E(acc, ue, wr, wc, fr_, fq_); }
    if (!has_next) break;
    if (!Epi::keep_acc(cur)) {
#pragma unroll
    for (int a = 0; a < 2; ++a)
#pragma unroll
      for (int b = 0; b < 2; ++b)
#pragma unroll
        for (int m = 0; m < 4; ++m)
#pragma unroll
          for (int n = 0; n < 2; ++n) acc[a][b][m][n] = (f32x4){0.f, 0.f, 0.f, 0.f};
    }
    cur = nxt; cA = nA; cB = nB; nt = nnt; ++ui;
  }
  PG8_WAIT_V(0);
  if (wr == 0) PG8_BAR;
  PG8_BAR;
  if constexpr (Epi::AFTER_DRAIN) { Unit ue = cur; int fr_ = fr, fq_ = fq;
    asm volatile("" : "+s"(ue.pm), "+s"(ue.pn), "+v"(fr_), "+v"(fq_));
    E.fused(acc, ue, wr, wc, fr_, fq_, lds, wid, lane); }
#undef PG8_SA
#undef PG8_SB
#undef PG8_STAGE
#undef PG8_LDA
#undef PG8_LDB
#undef PG8_MMA
#undef PG8_CAT
#undef PG8_WAIT_V
#undef PG8_WAIT_L
#undef PG8_BAR
#undef PG8_SCHED
}
}


__device__ __forceinline__ void store_tile_rows(const f32x16* o, const float* rli, char* wl, int r32, int hi, int lane, bf16_t* Orow0, long ostride, const unsigned char* Grow0, long gstride) {
#pragma unroll
  for (int r = 0; r < 16; ++r) { const int row = (r & 3) + 8 * (r >> 2) + 4 * hi;
#pragma unroll
    for (int d0 = 0; d0 < 4; ++d0) *(bf16_t*)(wl + row * 256 + (d0 * 32 + r32) * 2) = (bf16_t)(cvtpk(o[d0][r] * rli[r], 0.f) & 0xffffu);
    asm volatile("" ::: "memory"); }
  asm volatile("s_waitcnt lgkmcnt(0)" ::: "memory");
#pragma unroll 1
  for (int it = 0; it < 8; ++it) { const int chunk = it * 64 + lane, row = chunk >> 4, cc = chunk & 15;
    u32x4 v = *(const u32x4*)(wl + chunk * 16);
    if (Grow0) { const u32x2 g8 = *(const u32x2*)(Grow0 + (long)row * gstride + cc * 8); float gf[8]; fp8x4_to_f32(g8.x, gf); fp8x4_to_f32(g8.y, gf + 4);
      v.x = cvtpk(bflo(v.x) * gf[0], bfhi(v.x) * gf[1]); v.y = cvtpk(bflo(v.y) * gf[2], bfhi(v.y) * gf[3]);
      v.z = cvtpk(bflo(v.z) * gf[4], bfhi(v.z) * gf[5]); v.w = cvtpk(bflo(v.w) * gf[6], bfhi(v.w) * gf[7]); }
    *(u32x4*)(Orow0 + (long)row * ostride + cc * 8) = v; }
  asm volatile("s_waitcnt lgkmcnt(0)" ::: "memory");
}
constexpr int EPI_LDS_OFF = 66 * 1024;

namespace at {
constexpr int D = 128, NW = 8, QBLK = 32, KVBLK = 64;
constexpr float SCALE = 0.088388347648318440f;
constexpr float THR = 8.f;
constexpr size_t SHM_V = KVBLK * D * 2, SHM_K = KVBLK * D * 2, SHM_ATTN = 2 * SHM_V + 2 * SHM_K + NW * 64 * 4;
#define KSWZ(row, colB) ((row) * 256 + ((colB) ^ (((row) & 7) << 4)))
#define SBAR() __builtin_amdgcn_sched_barrier(0)
__device__ __forceinline__ int crow(int r, int hi) { return (r & 3) + 8 * (r >> 2) + 4 * hi; }

template <bool BAND>
__device__ __forceinline__ void partialSM(f32x16& p0, f32x16& p1, float& m_reg, float& mn, float& alpha, int kb, int uq, int L, float sl, int hi) {
  constexpr float C = SCALE * 1.4426950408889634f;
#if DBG_UNIFORM
  if constexpr (!BAND) { p0 = p0 * 0.f; p1 = p1 * 0.f; }
#endif
  if constexpr (BAND) {
#pragma unroll
    for (int r = 0; r < 16; ++r) {
      const int k0i = kb + crow(r, hi), k1i = k0i + 32;
      const float a0 = fabsf((float)(k0i - uq)), a1 = fabsf((float)(k1i - uq));
      const bool ok0 = (a0 <= 64.f) && ((unsigned)k0i < (unsigned)L), ok1 = (a1 <= 64.f) && ((unsigned)k1i < (unsigned)L);
      p0[r] = ok0 ? fmaf(-a0, sl, p0[r]) : -1e30f; p1[r] = ok1 ? fmaf(-a1, sl, p1[r]) : -1e30f;
    }
  }
  float pmax = p0[0];
#pragma unroll
  for (int r = 1; r < 16; ++r) pmax = fmaxf(pmax, p0[r]);
#pragma unroll
  for (int r = 0; r < 16; ++r) pmax = fmaxf(pmax, p1[r]);
  { auto rr = __builtin_amdgcn_permlane32_swap(__float_as_uint(pmax), __float_as_uint(pmax), false, false);
    pmax = fmaxf(__uint_as_float(rr[0]), __uint_as_float(rr[1])); }
  if (__builtin_expect(__all(pmax - m_reg <= THR / SCALE), 1)) { mn = m_reg; alpha = 1.f; }
  else { mn = fmaxf(m_reg, pmax); alpha = __builtin_amdgcn_exp2f((m_reg - mn) * C); m_reg = mn; }
  const float mnC = -mn * C;
#pragma unroll
  for (int r = 0; r < 16; ++r) p0[r] = fmaf(p0[r], C, mnC);
#pragma unroll
  for (int r = 0; r < 16; ++r) p1[r] = fmaf(p1[r], C, mnC);
#pragma unroll
  for (int r = 0; r < 16; ++r) p0[r] = __builtin_amdgcn_exp2f(p0[r]);
}
__device__ __forceinline__ void finishSM(f32x16& p0, f32x16& p1, float alpha, float& l_reg, bf16x8& pa0, bf16x8& pa1, bf16x8& pa2, bf16x8& pa3) {
#pragma unroll
  for (int r = 0; r < 16; ++r) p1[r] = __builtin_amdgcn_exp2f(p1[r]);
  float ps = 0;
#pragma unroll
  for (int r = 0; r < 16; ++r) ps += p0[r];
#pragma unroll
  for (int r = 0; r < 16; ++r) ps += p1[r];
  { auto rr = __builtin_amdgcn_permlane32_swap(__float_as_uint(ps), __float_as_uint(ps), false, false);
    ps = __uint_as_float(rr[0]) + __uint_as_float(rr[1]); }
  l_reg = l_reg * alpha + ps;
#define PK4(P, BASE, OUT) do { unsigned a0 = cvtpk(P[BASE + 0], P[BASE + 1]), a1 = cvtpk(P[BASE + 2], P[BASE + 3]);   \
    unsigned b0 = cvtpk(P[BASE + 4], P[BASE + 5]), b1 = cvtpk(P[BASE + 6], P[BASE + 7]);                              \
    auto r0 = __builtin_amdgcn_permlane32_swap(a0, b0, false, false); auto r1 = __builtin_amdgcn_permlane32_swap(a1, b1, false, false); \
    u32x4 w = {r0[0], r1[0], r0[1], r1[1]}; OUT = *reinterpret_cast<bf16x8*>(&w); } while (0)
  PK4(p0, 0, pa0); PK4(p0, 8, pa1); PK4(p1, 0, pa2); PK4(p1, 8, pa3);
#undef PK4
}
__device__ __forceinline__ void qkt(f32x16& p0, f32x16& p1, const char* Ks, const bf16x8* qr, int r32, int hi) {
  p0 = f32x16{}; p1 = f32x16{};
#pragma unroll
  for (int d0 = 0; d0 < 8; ++d0) { const int cb = (d0 * 16 + hi * 8) * 2;
    bf16x8 b0 = *reinterpret_cast<const bf16x8*>(Ks + KSWZ(r32, cb));
    bf16x8 b1 = *reinterpret_cast<const bf16x8*>(Ks + KSWZ(32 + r32, cb));
    p0 = __builtin_amdgcn_mfma_f32_32x32x16_bf16(b0, qr[d0], p0, 0, 0, 0);
    p1 = __builtin_amdgcn_mfma_f32_32x32x16_bf16(b1, qr[d0], p1, 0, 0, 0); }
}
__device__ __forceinline__ int v_st(int k, int c) { const int kk = (k & ~0xC) | ((k & 4) << 1) | ((k & 8) >> 1); return ((kk >> 3) * 4 + (c >> 5)) * 512 + ((kk & 7) * 32 + (c & 31)) * 2; }
__device__ __forceinline__ int v_rd_base(int lane) { return ((lane & 3) << 3) | (((lane >> 2) & 3) << 6) | (((lane >> 4) & 1) << 5) | (((lane >> 5) & 1) << 8); }
constexpr int v_rd_off(int d0, int ks, int half) { return d0 * 512 + ks * 4096 + half * 2048; }
template <int OFF> __device__ __forceinline__ s16x4 tr_read(int vb) {
  s16x4 r; asm volatile("ds_read_b64_tr_b16 %0, %1 offset:%2" : "=&v"(r) : "v"(vb), "i"(OFF) : "memory"); return r;
}
template <int D0> __device__ __forceinline__ void pv_one(f32x16& od, int vb, bf16x8 pa0, bf16x8 pa1, bf16x8 pa2, bf16x8 pa3) {
  const s16x4 l0 = tr_read<v_rd_off(D0, 0, 0)>(vb), h0 = tr_read<v_rd_off(D0, 0, 1)>(vb), l1 = tr_read<v_rd_off(D0, 1, 0)>(vb), h1 = tr_read<v_rd_off(D0, 1, 1)>(vb);
  const s16x4 l2 = tr_read<v_rd_off(D0, 2, 0)>(vb), h2 = tr_read<v_rd_off(D0, 2, 1)>(vb), l3 = tr_read<v_rd_off(D0, 3, 0)>(vb), h3 = tr_read<v_rd_off(D0, 3, 1)>(vb);
  asm volatile("s_waitcnt lgkmcnt(0)" ::: "memory"); SBAR();
#define PK(L, H) (bf16x8){L[0], L[1], L[2], L[3], H[0], H[1], H[2], H[3]}
  od = __builtin_amdgcn_mfma_f32_32x32x16_bf16(pa0, PK(l0, h0), od, 0, 0, 0);
  od = __builtin_amdgcn_mfma_f32_32x32x16_bf16(pa1, PK(l1, h1), od, 0, 0, 0);
  od = __builtin_amdgcn_mfma_f32_32x32x16_bf16(pa2, PK(l2, h2), od, 0, 0, 0);
  od = __builtin_amdgcn_mfma_f32_32x32x16_bf16(pa3, PK(l3, h3), od, 0, 0, 0);
#undef PK
}
__device__ __forceinline__ void pv_d0(f32x16* o, int vb, bf16x8 pa0, bf16x8 pa1, bf16x8 pa2, bf16x8 pa3) {
  pv_one<0>(o[0], vb, pa0, pa1, pa2, pa3); pv_one<1>(o[1], vb, pa0, pa1, pa2, pa3); pv_one<2>(o[2], vb, pa0, pa1, pa2, pa3); pv_one<3>(o[3], vb, pa0, pa1, pa2, pa3);
}

template <bool BAND>
__device__ __forceinline__ void attn_body(const bf16_t* Qb, const bf16_t* Kh, const bf16_t* Vh, long rs, int NT,
                                          int ubase, int u0, int L, float sl,
                                          bf16_t* Ob, const bf16_t* Gb, float* Lp, long lse_stride, char* lds, bool do_store = true) {
  const int tid = fresh_tid(), wid = tid >> 6, lane = tid & 63, r32 = lane & 31, hi = lane >> 5;
  if (__builtin_amdgcn_readfirstlane(wid) >= 4) __builtin_amdgcn_s_setprio(1);
  char* V_lds = lds; char* K_lds = lds + 2 * SHM_V;
  float* wsl = (float*)(lds + 2 * SHM_V + 2 * SHM_K) + wid * 64; float* li_l = wsl; float* al_l = wsl + 32;
  float m_reg = BAND ? -1e5f : -1e30f, l_reg = 0; f32x16 o[4] = {}; bf16x8 qr[8];
  const int uq = u0 + wid * QBLK + r32;
  const bf16_t* Qw = Qb + (long)(wid * QBLK + r32) * rs + hi * 8;
#pragma unroll
  for (int d0 = 0; d0 < 8; ++d0) qr[d0] = *reinterpret_cast<const bf16x8*>(Qw + d0 * 16);
  const int sr = tid >> 4, sc = (tid & 15) * 8, vst0 = v_st(sr, sc), vst1 = v_st(32 + sr, sc);
  const int vb0 = (int)(uintptr_t)V_lds + v_rd_base(lane);
  struct { bf16x8 vs0, vs1, ks0, ks1; } sr_[2];
#define KROW(k) (BAND ? (long)min(max(ubase + (k), 0), L - 1) * rs : (long)(k) * rs)
#define SLOAD(i, k0) do { const long ra_ = KROW((k0) + sr) + sc, rb_ = KROW((k0) + 32 + sr) + sc; \
    sr_[i].vs0 = *reinterpret_cast<const bf16x8*>(Vh + ra_); sr_[i].vs1 = *reinterpret_cast<const bf16x8*>(Vh + rb_); \
    sr_[i].ks0 = *reinterpret_cast<const bf16x8*>(Kh + ra_); sr_[i].ks1 = *reinterpret_cast<const bf16x8*>(Kh + rb_); } while (0)
#define SWRITE(b, i) do { *(bf16x8*)(V_lds + (b) * SHM_V + vst0) = sr_[i].vs0;          \
    *(bf16x8*)(V_lds + (b) * SHM_V + vst1) = sr_[i].vs1; const int kc = sc * 2;               \
    *(bf16x8*)(K_lds + (b) * SHM_K + KSWZ(sr, kc)) = sr_[i].ks0;                       \
    *(bf16x8*)(K_lds + (b) * SHM_K + KSWZ(32 + sr, kc)) = sr_[i].ks1; } while (0)
#define SWAIT() asm volatile("s_waitcnt vmcnt(4)" ::: "memory")
#define RESC(a) do { if (__any((a) < 1.f)) { if (hi == 0) al_l[r32] = (a); asm volatile("s_waitcnt lgkmcnt(0)" ::: "memory"); \
    _Pragma("unroll") for (int d = 0; d < 4; ++d) _Pragma("unroll") for (int r = 0; r < 16; ++r) o[d][r] *= al_l[crow(r, hi)]; } } while (0)
  f32x16 pA0, pA1, pB0, pB1; float mnA, mnB, alA, alB; bf16x8 pa0, pa1, pa2, pa3;
  constexpr int SE = 0, SO = 1;
  SLOAD(SE, 0); SLOAD(SO, KVBLK); SWAIT(); SWRITE(0, SE); __syncthreads();
  qkt(pA0, pA1, K_lds, qr, r32, hi); partialSM<BAND>(pA0, pA1, m_reg, mnA, alA, ubase, uq, L, sl, hi);
  if (2 < NT) SLOAD(SE, 2 * KVBLK);
  SWAIT(); SWRITE(1, SO); __syncthreads();
  for (int j = 1; j + 1 < NT; j += 2) {
    SBAR(); qkt(pB0, pB1, K_lds + SHM_K, qr, r32, hi);
    finishSM(pA0, pA1, alA, l_reg, pa0, pa1, pa2, pa3); SBAR();
    SLOAD(SO, (j + 2) * KVBLK); SBAR();
    pv_d0(o, vb0, pa0, pa1, pa2, pa3); partialSM<BAND>(pB0, pB1, m_reg, mnB, alB, ubase + j * KVBLK, uq, L, sl, hi);
    __syncthreads(); SWAIT(); SWRITE(0, SE);
    RESC(alB); __syncthreads();
    SBAR(); qkt(pA0, pA1, K_lds, qr, r32, hi);
    finishSM(pB0, pB1, alB, l_reg, pa0, pa1, pa2, pa3); SBAR();
    if (j + 3 < NT) SLOAD(SE, (j + 3) * KVBLK); SBAR();
    pv_d0(o, vb0 + (int)SHM_V, pa0, pa1, pa2, pa3); partialSM<BAND>(pA0, pA1, m_reg, mnA, alA, ubase + (j + 1) * KVBLK, uq, L, sl, hi);
    __syncthreads(); SWAIT(); SWRITE(1, SO);
    RESC(alA); __syncthreads();
  }
  SBAR(); qkt(pB0, pB1, K_lds + SHM_K, qr, r32, hi);
  finishSM(pA0, pA1, alA, l_reg, pa0, pa1, pa2, pa3); SBAR();
  pv_d0(o, vb0, pa0, pa1, pa2, pa3); partialSM<BAND>(pB0, pB1, m_reg, mnB, alB, ubase + (NT - 1) * KVBLK, uq, L, sl, hi);
  __syncthreads(); RESC(alB);
  finishSM(pB0, pB1, alB, l_reg, pa0, pa1, pa2, pa3); SBAR();
  pv_d0(o, vb0 + (int)SHM_V, pa0, pa1, pa2, pa3);
  __builtin_amdgcn_s_setprio(0);
  if (hi == 0) li_l[r32] = l_reg; asm volatile("s_waitcnt lgkmcnt(0)" ::: "memory");
  float rli[16];
#pragma unroll
  for (int r = 0; r < 16; ++r) rli[r] = __builtin_amdgcn_rcpf(li_l[crow(r, hi)]);
  if (!do_store) return;
  if constexpr (BAND) {
    if (hi == 0) Lp[(long)(wid * QBLK + r32) * lse_stride] = m_reg * SCALE + __logf(l_reg);
    store_tile_rows(o, rli, lds + EPI_LDS_OFF + wid * 8192, r32, hi, lane, Ob + (long)(wid * QBLK) * rs, rs, nullptr, 0);
  } else {
    bf16_t* Ow = Ob + (long)(wid * QBLK) * YW; const bf16_t* Gw = Gb + (long)(wid * QBLK) * INW;
#pragma unroll
    for (int r = 0; r < 16; ++r) { const long orow = crow(r, hi);
#pragma unroll
      for (int d0 = 0; d0 < 4; ++d0) { const float g = bf2f(Gw[orow * INW + d0 * 32 + r32]);
        Ow[orow * YW + d0 * 32 + r32] = (bf16_t)(cvtpk(o[d0][r] * rli[r] * g, 0.f) & 0xffffu); } }
  }
#undef KROW
#undef SLOAD
#undef SWRITE
#undef SWAIT
#undef RESC
}
}


namespace a8 {
typedef int v8i __attribute__((ext_vector_type(8)));
typedef int v4i __attribute__((ext_vector_type(4)));
constexpr float PSHIFT = 5.f, CAP = 8.75f;
constexpr int TILE_B = 8192;
#define A8_MFMA(a, b, c) __builtin_amdgcn_mfma_scale_f32_32x32x64_f8f6f4((a), (b), (c), 0, 0, 0, 0, 0, 0)
__device__ __forceinline__ v8i cat8(v4i a, v4i b) { return (v8i){a[0], a[1], a[2], a[3], b[0], b[1], b[2], b[3]}; }
__device__ __forceinline__ void partialSM(f32x16& p0, f32x16& p1, float& pm, f32x16& negM, float& alpha) {
  float dmax = p0[0];
#pragma unroll
  for (int r = 1; r < 16; ++r) dmax = fmaxf(dmax, p0[r]);
#pragma unroll
  for (int r = 0; r < 16; ++r) dmax = fmaxf(dmax, p1[r]);
  { auto rr = __builtin_amdgcn_permlane32_swap(__float_as_uint(dmax), __float_as_uint(dmax), false, false);
    dmax = fmaxf(__uint_as_float(rr[0]), __uint_as_float(rr[1])); }
  if (__builtin_expect(__all(dmax <= CAP), 1)) { alpha = 1.f; }
  else { const float delta = fmaxf(dmax - PSHIFT, 0.f); alpha = __builtin_amdgcn_exp2f(-delta); pm += delta;
#pragma unroll
    for (int r = 0; r < 16; ++r) { p0[r] -= delta; p1[r] -= delta; }
    const float nm = -pm;
#pragma unroll
    for (int r = 0; r < 16; ++r) negM[r] = nm; }
#pragma unroll
  for (int r = 0; r < 16; ++r) p0[r] = __builtin_amdgcn_exp2f(p0[r]);
}
__device__ __forceinline__ void finishSM(f32x16& p0, f32x16& p1, v8i& pa) {
#pragma unroll
  for (int r = 0; r < 16; ++r) p1[r] = __builtin_amdgcn_exp2f(p1[r]);
#pragma unroll
  for (int v = 0; v < 4; ++v) { int w = __builtin_amdgcn_cvt_pk_fp8_f32(p0[4 * v], p0[4 * v + 1], 0, false); pa[v] = __builtin_amdgcn_cvt_pk_fp8_f32(p0[4 * v + 2], p0[4 * v + 3], w, true); }
#pragma unroll
  for (int v = 0; v < 4; ++v) { int w = __builtin_amdgcn_cvt_pk_fp8_f32(p1[4 * v], p1[4 * v + 1], 0, false); pa[4 + v] = __builtin_amdgcn_cvt_pk_fp8_f32(p1[4 * v + 2], p1[4 * v + 3], w, true); }
}
__device__ __forceinline__ void qkt(f32x16& p0, f32x16& p1, const f32x16& negM, const char* Ks, v8i q0, v8i q1, int kb, int ko00, int ko01, int ko10, int ko11) {
  const v4i a00 = *(const v4i*)(Ks + kb + ko00), a01 = *(const v4i*)(Ks + kb + ko01), a10 = *(const v4i*)(Ks + kb + ko10), a11 = *(const v4i*)(Ks + kb + ko11);
  const v4i b00 = *(const v4i*)(Ks + 4096 + kb + ko00), b01 = *(const v4i*)(Ks + 4096 + kb + ko01), b10 = *(const v4i*)(Ks + 4096 + kb + ko10), b11 = *(const v4i*)(Ks + 4096 + kb + ko11);
  p0 = A8_MFMA(cat8(a00, a01), q0, negM); p1 = A8_MFMA(cat8(b00, b01), q0, negM);
  p0 = A8_MFMA(cat8(a10, a11), q1, p0); p1 = A8_MFMA(cat8(b10, b11), q1, p1);
}
__device__ __forceinline__ void pv(f32x16* o, const char* Vs, v8i pa, const char* onesp, int vb, int vo0, int vo1) {
  const v8i ones = cat8(*(const v4i*)(onesp), *(const v4i*)(onesp + 16));
  const v4i x0 = *(const v4i*)(Vs + vb + vo0), y0 = *(const v4i*)(Vs + vb + vo1), x1 = *(const v4i*)(Vs + 2048 + vb + vo0), y1 = *(const v4i*)(Vs + 2048 + vb + vo1);
  const v4i x2 = *(const v4i*)(Vs + 4096 + vb + vo0), y2 = *(const v4i*)(Vs + 4096 + vb + vo1), x3 = *(const v4i*)(Vs + 6144 + vb + vo0), y3 = *(const v4i*)(Vs + 6144 + vb + vo1);
  o[4] = A8_MFMA(pa, ones, o[4]);
  o[0] = A8_MFMA(pa, cat8(x0, y0), o[0]); o[1] = A8_MFMA(pa, cat8(x1, y1), o[1]); o[2] = A8_MFMA(pa, cat8(x2, y2), o[2]); o[3] = A8_MFMA(pa, cat8(x3, y3), o[3]);
}
__device__ __forceinline__ void attn_body(const unsigned char* Q8, const unsigned char* K8, const unsigned char* V8T, int NT, bf16_t* Ob, const unsigned char* Gb, char* lds) {
  using at::crow;
  const int tid = fresh_tid(), wid = tid >> 6, lane = tid & 63, r32 = lane & 31, hi = lane >> 5;
  if (__builtin_amdgcn_readfirstlane(wid) >= 4) __builtin_amdgcn_s_setprio(1);
  char* V_lds = lds; char* K_lds = lds + 2 * TILE_B;
  float* al_l = (float*)(lds + 4 * TILE_B) + wid * 32;
  float pm = -PSHIFT; f32x16 o[5] = {}; f32x16 negM;
#pragma unroll
  for (int r = 0; r < 16; ++r) negM[r] = PSHIFT;
  { int t_; asm volatile("v_mov_b32 %0, 0x38383838" : "=v"(t_)); *(int*)(lds + 4 * TILE_B + 1024 + tid * 4) = t_; }
  const char* ones = lds + 4 * TILE_B + 1024 + lane * 32;
  v8i q0, q1;
  { const unsigned char* Qw = Q8 + (long)(wid * 32 + r32) * 1024 + hi * 32;
    q0 = cat8(*(const v4i*)(Qw), *(const v4i*)(Qw + 16)); q1 = cat8(*(const v4i*)(Qw + 64), *(const v4i*)(Qw + 80)); }
  const int kb = r32 * 128, ksw = (r32 >> 1) & 7;
  const int ko00 = ((2 * hi) ^ ksw) << 4, ko01 = ((2 * hi + 1) ^ ksw) << 4, ko10 = ((4 + 2 * hi) ^ ksw) << 4, ko11 = ((5 + 2 * hi) ^ ksw) << 4;
  const int vb = r32 * 64, vsw = (r32 >> 2) & 3, vo0 = ((2 * hi) ^ vsw) << 4, vo1 = ((2 * hi + 1) ^ vsw) << 4;
  const int krow = tid >> 3, kst = krow * 128 + (((tid & 7) ^ ((krow >> 1) & 7)) << 4);
  const int vd = tid >> 2, vst = vd * 64 + (((tid & 3) ^ ((vd >> 2) & 3)) << 4);
  const unsigned char* Kg = K8 + tid * 16; const unsigned char* Vg = V8T + tid * 16;
  struct { v4i k, v; } sr_[2];
#define SLOAD(i, t) do { sr_[i].k = *(const v4i*)(Kg + (long)(t) * TILE_B); sr_[i].v = *(const v4i*)(Vg + (long)(t) * TILE_B); } while (0)
#define SWRITE(b, i) do { *(v4i*)(K_lds + (b) * TILE_B + kst) = sr_[i].k; *(v4i*)(V_lds + (b) * TILE_B + vst) = sr_[i].v; } while (0)
#define SWAIT() asm volatile("s_waitcnt vmcnt(2)" ::: "memory")
#define RESC(a) do { if (__any((a) < 1.f)) { if (hi == 0) al_l[r32] = (a); asm volatile("s_waitcnt lgkmcnt(0)" ::: "memory"); \
    _Pragma("unroll") for (int d = 0; d < 5; ++d) _Pragma("unroll") for (int r = 0; r < 16; ++r) o[d][r] *= al_l[crow(r, hi)]; } } while (0)
  f32x16 pA0, pA1, pB0, pB1; float alA, alB; v8i pa;
  constexpr int SE = 0, SO = 1;
  SLOAD(SE, 0); SLOAD(SO, 1); SWAIT(); SWRITE(0, SE); __syncthreads();
  qkt(pA0, pA1, negM, K_lds, q0, q1, kb, ko00, ko01, ko10, ko11); partialSM(pA0, pA1, pm, negM, alA);
  if (2 < NT) SLOAD(SE, 2);
  SWAIT(); SWRITE(1, SO); __syncthreads();
  for (int j = 1; j + 1 < NT; j += 2) {
    SBAR(); qkt(pB0, pB1, negM, K_lds + TILE_B, q0, q1, kb, ko00, ko01, ko10, ko11);
    finishSM(pA0, pA1, pa); SBAR();
    SLOAD(SO, j + 2); SBAR();
    pv(o, V_lds, pa, ones, vb, vo0, vo1); partialSM(pB0, pB1, pm, negM, alB);
    __syncthreads(); SWAIT(); SWRITE(0, SE);
    RESC(alB); __syncthreads();
    SBAR(); qkt(pA0, pA1, negM, K_lds, q0, q1, kb, ko00, ko01, ko10, ko11);
    finishSM(pB0, pB1, pa); SBAR();
    if (j + 3 < NT) SLOAD(SE, j + 3); SBAR();
    pv(o, V_lds + TILE_B, pa, ones, vb, vo0, vo1); partialSM(pA0, pA1, pm, negM, alA);
    __syncthreads(); SWAIT(); SWRITE(1, SO);
    RESC(alA); __syncthreads();
  }
  SBAR(); qkt(pB0, pB1, negM, K_lds + TILE_B, q0, q1, kb, ko00, ko01, ko10, ko11);
  finishSM(pA0, pA1, pa); SBAR();
  pv(o, V_lds, pa, ones, vb, vo0, vo1); partialSM(pB0, pB1, pm, negM, alB);
  __syncthreads(); RESC(alB);
  finishSM(pB0, pB1, pa); SBAR();
  pv(o, V_lds + TILE_B, pa, ones, vb, vo0, vo1);
  __builtin_amdgcn_s_setprio(0);
  float rli[16];
#pragma unroll
  for (int r = 0; r < 16; ++r) rli[r] = __builtin_amdgcn_rcpf(o[4][r]);
  store_tile_rows(o, rli, lds + EPI_LDS_OFF + wid * 8192, r32, hi, lane, Ob + (long)(wid * 32) * YW, YW, Gb + (long)(wid * 32) * (INW * 2), INW * 2);
#undef SLOAD
#undef SWRITE
#undef SWAIT
#undef RESC
}
}

#if DBG_NAIVE_A || DBG_NAIVE_B
__device__ __forceinline__ void naive_row(const bf16_t* qrow, const bf16_t* Kb, const bf16_t* Vb, long rs, int first, int count, int uc, float sl, int lane, float& m, float& l, float& o0, float& o1) {
  const unsigned qw = *(const unsigned*)(qrow + 2 * lane); const float q0 = bflo(qw), q1 = bfhi(qw);
  m = -1e30f; l = 0.f; o0 = 0.f; o1 = 0.f;
  for (int i = first; i < first + count; ++i) {
    const unsigned kw = *(const unsigned*)(Kb + (long)i * rs + 2 * lane), vw = *(const unsigned*)(Vb + (long)i * rs + 2 * lane);
    float s = q0 * bflo(kw) + q1 * bfhi(kw);
#pragma unroll
    for (int off = 1; off < 64; off <<= 1) s += __shfl_xor(s, off);
    s = s * 0.088388347648318440f - sl * fabsf((float)(i - uc));
    const float mn = fmaxf(m, s), a = __expf(m - mn), p = __expf(s - mn);
    l = l * a + p; o0 = o0 * a + p * bflo(vw); o1 = o1 * a + p * bfhi(vw); m = mn;
  }
}
#endif

#define XB_TMO      128
#define XB_XCNT(j)  (256  + 64 * (j))
#define XB_XSUB(j)  (1280 + 64 * (j))
#define XB_XGEN(j)  (2304 + 64 * (j))
#define XB_TOP      3328
#define XB_TOPGEN   3392
#define XCD_BAR_WORDS 3456
#define XB_SPIN_CAP (1u << 20)
__device__ __forceinline__ unsigned xb_ld(unsigned* p)              { return __hip_atomic_load(p, __ATOMIC_RELAXED, __HIP_MEMORY_SCOPE_AGENT); }
__device__ __forceinline__ unsigned xb_add(unsigned* p, unsigned v) { return __hip_atomic_fetch_add(p, v, __ATOMIC_RELAXED, __HIP_MEMORY_SCOPE_AGENT); }
__device__ __forceinline__ unsigned xb_xcc_id() { return (unsigned)__builtin_amdgcn_s_getreg((3 << 11) | 20) & 0xFu; }
#define XB_SPIN(cond, bar) do { unsigned _sp = 0; while (cond) { __builtin_amdgcn_s_sleep(1); \
    if ((++_sp & 255u) == 0u) { if (xb_ld(&(bar)[XB_TMO])) break; if (_sp > XB_SPIN_CAP) { atomicAdd(&(bar)[XB_TMO], 1u); break; } } } } while (0)
struct XcdBarrier { unsigned* bar; unsigned x; volatile LAS unsigned* st; };
__device__ __forceinline__ XcdBarrier xcd_barrier_post(unsigned* bar, volatile LAS unsigned* st) {
  XcdBarrier b; b.bar = bar; b.x = xb_xcc_id(); b.st = st;
  if (threadIdx.x == 0) (void)xb_add(&bar[XB_XCNT(b.x)], 1u);
  return b;
}
__device__ __forceinline__ void xcd_barrier_complete(unsigned* bar, unsigned x, unsigned& nloc, unsigned& nx) {
  const unsigned G = gridDim.x * gridDim.y * gridDim.z;
  unsigned sum, cnt, mine, sp = 0u;
  for (;;) {
    sum = 0u; cnt = 0u; mine = 0u;
#pragma unroll
    for (unsigned j = 0; j < 16; ++j) { const unsigned c = xb_ld(&bar[XB_XCNT(j)]); sum += c; cnt += (c > 0u) ? 1u : 0u; mine = (j == x) ? c : mine; }
    if (sum == G) break;
    __builtin_amdgcn_s_sleep(1);
    if ((++sp & 255u) == 0u) { if (xb_ld(&bar[XB_TMO])) break; if (sp > XB_SPIN_CAP) { atomicAdd(&bar[XB_TMO], 1u); break; } }
  }
  nloc = mine > 0u ? mine : 1u; nx = cnt > 0u ? cnt : 1u;
}
__device__ __forceinline__ void xcd_barrier(const XcdBarrier& b) {
  asm volatile("s_waitcnt vmcnt(0)" ::: "memory");
  __syncthreads();
  if (threadIdx.x == 0) {
    unsigned* bar = b.bar;
    __builtin_amdgcn_s_waitcnt(0);
    unsigned nloc = b.st[0], nx = b.st[1];
    if (nloc == 0u) { xcd_barrier_complete(bar, b.x, nloc, nx); b.st[0] = nloc; b.st[1] = nx; }
    const unsigned old = xb_add(&bar[XB_XSUB(b.x)], 1u);
    const unsigned gen = old / nloc;
    if (old + 1u == (gen + 1u) * nloc) {
      __builtin_amdgcn_fence(__ATOMIC_RELEASE, "agent");
      asm volatile("s_waitcnt vmcnt(0)" ::: "memory");
      const unsigned og = xb_add(&bar[XB_TOP], 1u);
      const unsigned tg = og / nx;
      if (og + 1u == (tg + 1u) * nx) xb_add(&bar[XB_TOPGEN], 1u);
      else XB_SPIN(xb_ld(&bar[XB_TOPGEN]) == tg, bar);
      __builtin_amdgcn_fence(__ATOMIC_ACQUIRE, "agent");
      xb_add(&bar[XB_XGEN(b.x)], 1u);
      asm volatile("s_waitcnt vmcnt(0)" ::: "memory");
    } else {
      XB_SPIN(xb_ld(&bar[XB_XGEN(b.x)]) == gen, bar);
      __builtin_amdgcn_fence(__ATOMIC_ACQUIRE, "agent");
      asm volatile("s_waitcnt vmcnt(0)" ::: "memory");
    }
  }
  __syncthreads();
}

__device__ __forceinline__ float wave_sum(float v) {
#pragma unroll
  for (int o = 1; o < 64; o <<= 1) v += __shfl_xor(v, o);
  return v;
}
__device__ __forceinline__ void transpose_item(const float* W, int N, bf16_t* WT, int ldt, int koff, LAS float* scr, int item, int lane) {
  const int nblk = N / 32, kb = item / nblk, nb = item % nblk, k0 = 64 * kb, n0 = 32 * nb;
#pragma unroll
  for (int i = 0; i < 8; ++i) { const int kk = 8 * i + (lane >> 3), n4 = (lane & 7) * 4;
    const f32x4 w = *(const f32x4*)(W + (size_t)(k0 + kk) * N + n0 + n4);
    scr[kk * 33 + n4] = w[0]; scr[kk * 33 + n4 + 1] = w[1]; scr[kk * 33 + n4 + 2] = w[2]; scr[kk * 33 + n4 + 3] = w[3]; }
  asm volatile("s_waitcnt lgkmcnt(0)" ::: "memory");
  const int c = lane & 7;
#pragma unroll
  for (int j = 0; j < 4; ++j) { const int n = (lane >> 3) + 8 * j; const LAS float* s = scr + (8 * c) * 33 + n;
    u32x4 o; o.x = cvtpk(s[0 * 33], s[1 * 33]); o.y = cvtpk(s[2 * 33], s[3 * 33]); o.z = cvtpk(s[4 * 33], s[5 * 33]); o.w = cvtpk(s[6 * 33], s[7 * 33]);
    *(u32x4*)(WT + (size_t)(n0 + n) * ldt + koff + k0 + 8 * c) = o; }
  asm volatile("s_waitcnt lgkmcnt(0)" ::: "memory");
}

__device__ __forceinline__ void transpose_item8(const float* W, int N, unsigned char* WT, int ldt, float wscale, LAS float* scr, int item, int lane) {
  const int nblk = N / 32, kb = item / nblk, nb = item % nblk, k0 = 64 * kb, n0 = 32 * nb;
#pragma unroll
  for (int i = 0; i < 8; ++i) { const int kk = 8 * i + (lane >> 3), n4 = (lane & 7) * 4;
    const f32x4 w = *(const f32x4*)(W + (size_t)(k0 + kk) * N + n0 + n4) * wscale;
    scr[kk * 33 + n4] = w[0]; scr[kk * 33 + n4 + 1] = w[1]; scr[kk * 33 + n4 + 2] = w[2]; scr[kk * 33 + n4 + 3] = w[3]; }
  asm volatile("s_waitcnt lgkmcnt(0)" ::: "memory");
  const int c = lane & 7;
#pragma unroll
  for (int j = 0; j < 4; ++j) { const int n = (lane >> 3) + 8 * j; const LAS float* s = scr + (8 * c) * 33 + n;
    u32x2 o; o.x = pk4_fp8(s[0 * 33], s[1 * 33], s[2 * 33], s[3 * 33]); o.y = pk4_fp8(s[4 * 33], s[5 * 33], s[6 * 33], s[7 * 33]);
    *(u32x2*)(WT + (size_t)(n0 + n) * ldt + k0 + 8 * c) = o; }
  asm volatile("s_waitcnt lgkmcnt(0)" ::: "memory");
}
__device__ __forceinline__ void sincos_d(double a, double& s, double& c) {
  const double q = rint(a * 0.63661977236758134308);
  double r = fma(-q, 1.57079632679489655800e+00, a); r = fma(-q, 6.12323399573676603587e-17, r);
  const int qi = ((int)q) & 3; const double r2 = r * r;
  const double sp = r + r * r2 * (-1.0 / 6 + r2 * (1.0 / 120 + r2 * (-1.0 / 5040 + r2 * (1.0 / 362880 + r2 * (-1.0 / 39916800 + r2 * (1.0 / 6227020800.0 + r2 * (-1.0 / 1307674368000.0)))))));
  const double cp = 1.0 + r2 * (-0.5 + r2 * (1.0 / 24 + r2 * (-1.0 / 720 + r2 * (1.0 / 40320 + r2 * (-1.0 / 3628800 + r2 * (1.0 / 479001600 + r2 * (-1.0 / 87178291200.0 + r2 * (1.0 / 20922789888000.0))))))));
  s = (qi == 0) ? sp : (qi == 1) ? cp : (qi == 2) ? -sp : -cp;
  c = (qi == 0) ? cp : (qi == 1) ? -sp : (qi == 2) ? -cp : sp;
}
__device__ __forceinline__ void convert_x(const float* x, bf16_t* xb, int gtid, int gthreads) {
  for (int i = gtid; i < CT * DM / 8; i += gthreads) {
    const f32x4 a = *(const f32x4*)(x + (size_t)i * 8), b = *(const f32x4*)(x + (size_t)i * 8 + 4);
#if USE_FP8_P1
    u32x2 w; w.x = pk4_fp8(a[0], a[1], a[2], a[3]); w.y = pk4_fp8(b[0], b[1], b[2], b[3]);
    *(u32x2*)((unsigned char*)xb + (size_t)i * 8) = w; }
#else
    u32x4 w; w.x = cvtpk(a[0], a[1]); w.y = cvtpk(a[2], a[3]); w.z = cvtpk(b[0], b[1]); w.w = cvtpk(b[2], b[3]);
    *(u32x4*)(xb + (size_t)i * 8) = w; }
#endif
}

__global__ void __launch_bounds__(512, 2) fwd_megakernel(Params p) {
  extern __shared__ __attribute__((aligned(16))) unsigned char smem[];
  cg::grid_group grid = cg::this_grid();
  const int G = gridDim.x, cb = blockIdx.x, NGW = G * 8, gthreads = G * 512;
  volatile LAS unsigned* xst = (volatile LAS unsigned*)((LAS unsigned char*)smem + 131 * 1024);
  if (threadIdx.x == 0) { xst[0] = 0u; xst[1] = 0u; }
  __syncthreads();
  const XcdBarrier xb = xcd_barrier_post((unsigned*)(p.ws + WS_BAR), xst);
#define GSYNC() xcd_barrier(xb)
#define THIN_IDS() const int tid = fresh_tid(), wid = tid >> 6, lane = tid & 63, gw = cb * 8 + wid, gtid = cb * 512 + tid; (void)gw; (void)gtid; (void)lane
  bf16_t* WIN = (bf16_t*)(p.ws + WS_WIN); bf16_t* WAB = (bf16_t*)(p.ws + WS_WAB); bf16_t* WO = (bf16_t*)(p.ws + WS_WO);
  bf16_t* XB = (bf16_t*)(p.ws + WS_XB); bf16_t* T = XB; bf16_t* H = (bf16_t*)(p.ws + WS_H); bf16_t* Y = (bf16_t*)(p.ws + WS_Y);
  unsigned char* Q8 = (unsigned char*)(p.ws + WS_Q8); unsigned char* K8 = (unsigned char*)(p.ws + WS_K8); unsigned char* V8T = (unsigned char*)(p.ws + WS_V8T);
  bf16_t* MRG = (bf16_t*)(p.ws + WS_MRG); float* LSE = (float*)(p.ws + WS_LSE); float* ROPE = (float*)(p.ws + WS_ROPE);

  {
    THIN_IDS();
    LAS float* scr = (LAS float*)((LAS unsigned char*)smem + wid * 8704);
    constexpr int I_IN = (DM / 64) * (INW / 32), I_A = (512 / 64) * (DM / 32), I_B = (DM / 64) * (DM / 32), I_O = I_B, I_L = I_IN + I_A + I_B + I_O;
    for (int it = gw; it < 2 * I_L; it += NGW) {
      const int l = it / I_L; int r = it % I_L;
#if USE_FP8_P1
      if (r < I_IN) { transpose_item8(p.w_in + (size_t)l * DM * INW, INW, (unsigned char*)WIN + (size_t)l * INW * DM, DM, 32.f, scr, r, lane); continue; } r -= I_IN;
#else
      if (r < I_IN) { transpose_item(p.w_in + (size_t)l * DM * INW, INW, WIN + (size_t)l * INW * DM, DM, 0, scr, r, lane); continue; } r -= I_IN;
#endif
      if (r < I_A) { transpose_item(p.w_pa + (size_t)l * 512 * DM, DM, WAB + (size_t)l * DM * YW, YW, 0, scr, r, lane); continue; } r -= I_A;
      if (r < I_B) { transpose_item(p.w_pb + (size_t)l * DM * DM, DM, WAB + (size_t)l * DM * YW, YW, 512, scr, r, lane); continue; } r -= I_B;
      transpose_item(p.w_out + (size_t)l * DM * DM, DM, WO + (size_t)l * DM * DM, DM, 0, scr, r, lane);
    }
    for (int e = cb + G * tid; e < 256 * 32 && tid < (256 * 32 + G - 1) / G; e += gthreads) { const int pos = e >> 5, i = e & 31;
      const float inv = exp2f(-(float)i * (13.287712379549449f / 32.f));
      const float ang = (float)pos * inv; double s, c; sincos_d((double)ang, s, c);
      ROPE[e * 2] = (float)c; ROPE[e * 2 + 1] = (float)s; }
    convert_x(p.x_prompt, XB, gtid, gthreads);
  }
  grid.sync();

#pragma unroll 1
  for (int ch = 0; ch < NCH; ++ch) {
    const int S = (ch < 2) ? 8192 : 16384;
    const float* xin = (ch < 2) ? p.x_prompt + (size_t)ch * CT * DM : p.x_sample;
    float* outc = p.out + (size_t)ch * CT * DM;
#pragma unroll 1
    for (int l = 0; l < DEPTH; ++l) {
#if USE_FP8_P1
      { pg8::SchedStd s; s.nM = CT / 256; s.nN = INW / 256; s.G = G; s.c = cb; s.lda = DM / 2; s.ldb = DM / 2; s.nt = DM / 128; s.A = (const char*)XB; s.B = (const char*)WIN + (size_t)l * INW * DM;
        pg8::EpiIn e; e.H = H; e.bias = p.b_in + (size_t)l * INW; e.ascale = 1.f / 32.f;
        for (int rep = 0; rep < DBG_REP_P1; ++rep) pg8::gemm_phase<pg8::EpiIn, pg8::SchedStd, true>(( LAS unsigned char*)smem, s, e); }
#else
      { pg8::SchedStd s; s.nM = CT / 256; s.nN = INW / 256; s.G = G; s.c = cb; s.lda = DM; s.ldb = DM; s.nt = DM / 64; s.A = (const char*)XB; s.B = (const char*)(WIN + (size_t)l * INW * DM);
        pg8::EpiIn e; e.H = H; e.bias = p.b_in + (size_t)l * INW; e.ascale = 1.f;
        for (int rep = 0; rep < DBG_REP_P1; ++rep) pg8::gemm_phase(( LAS unsigned char*)smem, s, e); }
#endif
      GSYNC();
      {
        { THIN_IDS();
        const float* qg = p.q_gain + l * 128; const float* kg = p.k_gain + l * 128;
        const int l16 = lane & 15;
        for (int idx0 = gw * 4 + (lane >> 4); idx0 < CT * 10; idx0 += NGW * 16) {
          const unsigned char* ptr[4]; u32x2 w[4]; bool ok[4]; int tokk[4], hhk[4];
#pragma unroll
          for (int k = 0; k < 4; ++k) { const int idx = idx0 + k * NGW * 4; ok[k] = idx < CT * 10; const int idc = ok[k] ? idx : idx0;
            tokk[k] = idc / 10; hhk[k] = idc % 10;
            const int boff = (hhk[k] < 8 ? C_BQ * 2 + hhk[k] * 128 : C_BK * 2 + (hhk[k] - 8) * 128) + l16 * 8;
            ptr[k] = (const unsigned char*)H + (size_t)tokk[k] * (INW * 2) + boff; w[k] = *(const u32x2*)ptr[k]; }
#pragma unroll
          for (int k = 0; k < 4; ++k) {
            float v[8]; fp8x4_to_f32(w[k].x, v); fp8x4_to_f32(w[k].y, v + 4);
            float ss = 0.f;
#pragma unroll
            for (int j = 0; j < 8; ++j) ss += v[j] * v[j];
            ss += __shfl_xor(ss, 1); ss += __shfl_xor(ss, 2); ss += __shfl_xor(ss, 4); ss += __shfl_xor(ss, 8);
            const float rms = rsqrtf(ss * (1.f / 128.f) + RMS_EPS);
            const float* gp = (hhk[k] < 8 ? qg : kg) + l16 * 8;
            const int tpos = tokk[k] & (S - 1);
            const int pos = (l16 < 8) ? (tpos >> 6) : (tpos & 63);
            const f32x4* rt = (const f32x4*)(ROPE + ((size_t)pos * 32 + (l16 & 3) * 8) * 2);
            const f32x4 g0 = *(const f32x4*)gp, g1 = *(const f32x4*)(gp + 4);
            const float gg[8] = {g0[0], g0[1], g0[2], g0[3], g1[0], g1[1], g1[2], g1[3]};
            float o[8];
#pragma unroll
            for (int j = 0; j < 8; ++j) v[j] = v[j] * rms * gg[j];
#pragma unroll
            for (int j2 = 0; j2 < 4; ++j2) { const f32x4 cs = rt[j2];
              const float pr0 = __shfl_xor(v[2 * j2], 4), pr1 = __shfl_xor(v[2 * j2 + 1], 4);
              o[2 * j2] = v[2 * j2] * cs[0] + ((l16 & 4) ? pr0 : -pr0) * cs[1];
              o[2 * j2 + 1] = v[2 * j2 + 1] * cs[2] + ((l16 & 4) ? pr1 : -pr1) * cs[3]; }
            u32x4 wo; wo.x = cvtpk(o[0], o[1]); wo.y = cvtpk(o[2], o[3]); wo.z = cvtpk(o[4], o[5]); wo.w = cvtpk(o[6], o[7]);
            if (ok[k]) {
#if USE_FP8_B
#pragma unroll
              for (int j = 0; j < 8; ++j) o[j] *= 0.35709583f;
              u32x2 w8; int t0 = __builtin_amdgcn_cvt_pk_fp8_f32(o[0], o[1], 0, false); w8.x = (unsigned)__builtin_amdgcn_cvt_pk_fp8_f32(o[2], o[3], t0, true);
              int t1 = __builtin_amdgcn_cvt_pk_fp8_f32(o[4], o[5], 0, false); w8.y = (unsigned)__builtin_amdgcn_cvt_pk_fp8_f32(o[6], o[7], t1, true);
              unsigned char* d8 = (hhk[k] < 8) ? Q8 + (size_t)tokk[k] * 1024 + hhk[k] * 128 + l16 * 8 : K8 + ((size_t)(hhk[k] - 8) * CT + tokk[k]) * 128 + l16 * 8;
              *(u32x2*)d8 = w8;
#else
              (void)wo;
#endif
            }
          }
        } }
#if USE_FP8_B
        { THIN_IDS();
          const int kk = lane & 31, khi = (kk >> 2) & 1, slot = khi * 32 + (kk & 3) + 4 * (kk >> 3) + 16 * (lane >> 5);
          for (int it = gw; it < 2 * (CT / 64); it += NGW) {
            const int kvh = it / (CT / 64), tl = it % (CT / 64);
            const unsigned char* vrow = (const unsigned char*)H + (size_t)(tl * 64 + lane) * (INW * 2) + C_BV * 2 + kvh * 128;
            unsigned char* dst = V8T + ((size_t)(kvh * (CT / 64) + tl) * 128) * 64 + slot;
#pragma unroll 4
            for (int d8 = 0; d8 < 16; ++d8) { const u32x2 w = *(const u32x2*)(vrow + d8 * 8);
#pragma unroll
              for (int j = 0; j < 8; ++j) dst[(d8 * 8 + j) * 64] = (unsigned char)(((j < 4 ? w.x : w.y) >> (8 * (j & 3))) & 0xff); }
          } }
#endif
#if DBG_NAIVE_A
        { THIN_IDS();
          for (int idx = gw; idx < CT * 12; idx += NGW) {
            const int tok = idx / 12, gh = idx % 12, g = gh >> 2;
            const int dil = (g == 0) ? 1 : (g == 1) ? 4 : 16, L = S / dil;
            const int seq = tok / S, tp = tok % S, r = tp % dil, u = tp / dil;
            const float slope = exp2f(-8.f * (float)(gh + 1) / 12.f);
            const size_t tok0 = (size_t)seq * S + r; const long rs = (long)dil * INW;
            bf16_t* qrow = H + (size_t)tok * INW + C_AQ + gh * 128;
            const int first = max(u - 64, 0), last = min(u + 64, L - 1);
            float m, l, o0, o1;
            naive_row(qrow, H + tok0 * INW + C_AK + gh * 128, H + tok0 * INW + C_AV + gh * 128, rs, first, last - first + 1, u, slope * (float)dil, lane, m, l, o0, o1);
            *(unsigned*)(qrow + 2 * lane) = cvtpk(o0 / l, o1 / l);
            if (lane == 0) LSE[(size_t)tok * 12 + gh] = m + __logf(l);
          } }
        for (int it = 64 * 12; it < 64 * 12; it += G) {
#else
        for (int rep = 0; rep < DBG_REP_A; ++rep)
        for (int it = cb; it < 64 * 12; it += G) {
#endif
          const int bi = it / 12, gh = it % 12, g = gh >> 2, hs = gh & 3;
          const int dil = (g == 0) ? 1 : (g == 1) ? 4 : 16, L = S / dil, bpc = L / 256;
          const int bps = S / 256, seq = bi / bps, w = bi % bps, r = w / bpc, u0 = (w % bpc) * 256;
          const float slope = exp2f(-8.f * (float)(gh + 1) / 12.f);
          const float sl = slope * (float)dil / at::SCALE;
          const size_t tok0 = (size_t)seq * S + r;
          bf16_t* Qh = H + tok0 * INW + C_AQ + gh * 128;
          const bf16_t* Kh = H + tok0 * INW + C_AK + gh * 128; const bf16_t* Vh = H + tok0 * INW + C_AV + gh * 128;
          const long rs = (long)dil * INW;
          __syncthreads();
          at::attn_body<true>(Qh + (long)u0 * rs, Kh, Vh, rs, 6, u0 - 64, u0, L, sl, Qh + (long)u0 * rs, nullptr,
                              LSE + (tok0 + (size_t)u0 * dil) * 12 + gh, (long)dil * 12, (char*)smem, rep == DBG_REP_A - 1);
        }
      }
      GSYNC();
      {
        const int bps = S / 256;
#if DBG_NAIVE_B
        { THIN_IDS();
          for (int idx = gw; idx < CT * 8; idx += NGW) {
            const int tok = idx >> 3, h = idx & 7, seq = tok / S; const size_t tok0 = (size_t)seq * S;
            float m, l, o0, o1;
            naive_row(H + (size_t)tok * INW + C_BQ + h * 128, H + tok0 * INW + C_BK + (h >> 2) * 128, H + tok0 * INW + C_BV + (h >> 2) * 128, (long)INW, 0, S, 0, 0.f, lane, m, l, o0, o1);
            const unsigned gw_ = *(const unsigned*)(H + (size_t)tok * INW + C_BG + h * 128 + 2 * lane);
            *(unsigned*)(Y + (size_t)tok * YW + 512 + h * 128 + 2 * lane) = cvtpk(o0 / l * bflo(gw_), o1 / l * bfhi(gw_));
          } }
        for (int it = 64 * 8; it < 64 * 8; it += G) {
#else
        for (int rep = 0; rep < DBG_REP_B; ++rep)
        for (int it = cb; it < 64 * 8; it += G) {
#endif
          int qb, h, seq;
          if (G == 256) {
            const int x = cb & 7, idx = (x >> 1) * 64 + (cb >> 3) * 2 + (it >> 8), qblk = idx & 63;
            h = (x & 1) * 4 + (idx >> 6); seq = qblk / bps; qb = qblk % bps;
          } else { qb = it % bps; const int sh = it / bps; h = sh & 7; seq = sh >> 3; }
          const size_t tok0 = (size_t)seq * S, row0 = tok0 + (size_t)qb * 256;
#if DBG_NO_B
          { const int t_ = fresh_tid(); for (int e = t_; e < 256 * 16; e += 512) { u32x4 z = {0u, 0u, 0u, 0u}; *(u32x4*)(Y + (row0 + (e >> 4)) * YW + 512 + h * 128 + (e & 15) * 8) = z; } }
#else
          __syncthreads();
#if USE_FP8_B
          a8::attn_body(Q8 + row0 * 1024 + h * 128, K8 + ((size_t)(h >> 2) * CT + tok0) * 128, V8T + ((size_t)(h >> 2) * (CT / 64) + tok0 / 64) * 8192, S / 64,
                        Y + row0 * YW + 512 + h * 128, (const unsigned char*)H + row0 * (INW * 2) + C_BG * 2 + h * 128, (char*)smem);
#else
          at::attn_body<false>(H + row0 * INW + C_BQ + h * 128, H + tok0 * INW + C_BK + (h >> 2) * 128, H + tok0 * INW + C_BV + (h >> 2) * 128, (long)INW, S / 64,
                               0, 0, 0, 0.f, Y + row0 * YW + 512 + h * 128, H + row0 * INW + C_BG + h * 128, nullptr, 0, (char*)smem);
#endif
#endif
        }
        THIN_IDS();
        const int l16 = lane & 15;
        for (int rep = 0; rep < DBG_REP_C; ++rep)
        for (int idx0 = gw * 4 + (lane >> 4); idx0 < CT * 4; idx0 += NGW * 16) {
          float l0[4], l1[4], l2[4]; u32x4 a[4], b[4], c[4], gt[4]; int tokk[4], hsk[4]; bool ok[4];
#pragma unroll
          for (int k = 0; k < 4; ++k) { const int idx = idx0 + k * NGW * 4; ok[k] = idx < CT * 4; const int idc = ok[k] ? idx : idx0; tokk[k] = idc >> 2; hsk[k] = idc & 3;
            const float* lp = LSE + (size_t)tokk[k] * 12 + hsk[k]; l0[k] = lp[0]; l1[k] = lp[4]; l2[k] = lp[8];
            const bf16_t* hp = H + (size_t)tokk[k] * INW + hsk[k] * 128 + l16 * 8;
            a[k] = *(const u32x4*)(hp); b[k] = *(const u32x4*)(hp + 512); c[k] = *(const u32x4*)(hp + 1024); gt[k] = *(const u32x4*)(hp + C_AG); }
#pragma unroll
          for (int k = 0; k < 4; ++k) {
            const float mx = fmaxf(l0[k], fmaxf(l1[k], l2[k]));
            float e0 = __expf(l0[k] - mx), e1 = __expf(l1[k] - mx), e2 = __expf(l2[k] - mx);
            const float inv = 1.f / (e0 + e1 + e2); e0 *= inv; e1 *= inv; e2 *= inv;
            float o[8];
#define CMB(j, W, HL) o[j] = (e0 * HL(a[k].W) + e1 * HL(b[k].W) + e2 * HL(c[k].W)) * HL(gt[k].W)
            CMB(0, x, bflo); CMB(1, x, bfhi); CMB(2, y, bflo); CMB(3, y, bfhi); CMB(4, z, bflo); CMB(5, z, bfhi); CMB(6, w, bflo); CMB(7, w, bfhi);
#undef CMB
            u32x4 wo; wo.x = cvtpk(o[0], o[1]); wo.y = cvtpk(o[2], o[3]); wo.z = cvtpk(o[4], o[5]); wo.w = cvtpk(o[6], o[7]);
            if (ok[k]) *(u32x4*)(Y + (size_t)tokk[k] * YW + hsk[k] * 128 + l16 * 8) = wo;
          }
        }
      }
      GSYNC();
      { pg8::SchedMerge s; s.nM = CT / 256; s.nN = DM / 256; s.G = G; s.c = cb; s.lda = YW; s.ldb = YW; s.A = (const char*)Y; s.B = (const char*)(WAB + (size_t)l * DM * YW);
        pg8::EpiMerge e; e.H = H; e.T = T; e.MRG = MRG;
        for (int rep = 0; rep < DBG_REP_P4; ++rep) pg8::gemm_phase((LAS unsigned char*)smem, s, e); }
      GSYNC();
#if USE_LN_FUSED
      if (G == 256) {
      { pg8::SchedStd s; s.nM = CT / 256; s.nN = DM / 256; s.G = G; s.c = cb; s.lda = DM; s.ldb = DM; s.nt = DM / 64; s.A = (const char*)MRG; s.B = (const char*)(WO + (size_t)l * DM * DM);
        pg8::EpiLN e; e.X = (l == 0) ? xin : (const float*)outc; e.Yo = outc; e.XB8 = (unsigned char*)XB; e.g = p.ln_g + l * DM; e.b = p.ln_b + l * DM;
        e.slots = (unsigned long long*)(p.ws + WS_LNX); e.cnt = (unsigned*)(p.ws + WS_LNC) + (size_t)(ch * DEPTH + l) * 64 * 64; e.write_xb = (l == 0);
        pg8::gemm_phase((LAS unsigned char*)smem, s, e); }
      if (l == DEPTH - 1 && ch + 1 < NCH) { THIN_IDS(); convert_x((ch + 1 < 2) ? p.x_prompt + (size_t)(ch + 1) * CT * DM : p.x_sample, XB, gtid, gthreads); }
      GSYNC();
      } else
#endif
      {
      { pg8::SchedStd s; s.nM = CT / 256; s.nN = DM / 256; s.G = G; s.c = cb; s.lda = DM; s.ldb = DM; s.nt = DM / 64; s.A = (const char*)MRG; s.B = (const char*)(WO + (size_t)l * DM * DM);
        pg8::EpiOut e; e.X = (l == 0) ? xin : (const float*)outc; e.Z = outc;
        pg8::gemm_phase((LAS unsigned char*)smem, s, e); }
      GSYNC();
      {
        THIN_IDS();
        const float* gmm = p.ln_g + l * DM; const float* bta = p.ln_b + l * DM;
        f32x4 gv[4], bv[4];
#pragma unroll
        for (int j = 0; j < 4; ++j) { gv[j] = *(const f32x4*)(gmm + (j * 64 + lane) * 4); bv[j] = *(const f32x4*)(bta + (j * 64 + lane) * 4); }
        for (int row0 = gw; row0 < CT; row0 += NGW * 4) {
          f32x4 v[4][4];
#pragma unroll
          for (int k = 0; k < 4; ++k) { const int row = min(row0 + k * NGW, CT - 1); const float* zr = outc + (size_t)row * DM;
#pragma unroll
            for (int j = 0; j < 4; ++j) v[k][j] = *(const f32x4*)(zr + (j * 64 + lane) * 4); }
#pragma unroll
          for (int k = 0; k < 4; ++k) { const int row = row0 + k * NGW; float* zr = outc + (size_t)min(row, CT - 1) * DM;
            float s = 0.f;
#pragma unroll
            for (int j = 0; j < 4; ++j) s += (v[k][j][0] + v[k][j][1]) + (v[k][j][2] + v[k][j][3]);
            const float mean = wave_sum(s) * (1.f / DM); float s2 = 0.f;
#pragma unroll
            for (int j = 0; j < 4; ++j) { v[k][j] = v[k][j] - mean; s2 += (v[k][j][0] * v[k][j][0] + v[k][j][1] * v[k][j][1]) + (v[k][j][2] * v[k][j][2] + v[k][j][3] * v[k][j][3]); }
            const float rstd = rsqrtf(wave_sum(s2) * (1.f / DM) + LN_EPS);
            if (row < CT) {
#pragma unroll
              for (int j = 0; j < 4; ++j) { const f32x4 y = v[k][j] * rstd * gv[j] + bv[j]; *(f32x4*)(zr + (j * 64 + lane) * 4) = y;
#if USE_FP8_P1
                if (l == 0) *(unsigned*)((unsigned char*)XB + (size_t)row * DM + (j * 64 + lane) * 4) = pk4_fp8(y[0], y[1], y[2], y[3]); } }
#else
                if (l == 0) { u32x2 w; w.x = cvtpk(y[0], y[1]); w.y = cvtpk(y[2], y[3]); *(u32x2*)(XB + (size_t)row * DM + (j * 64 + lane) * 4) = w; } } }
#endif
          }
        }
        if (l == DEPTH - 1 && ch + 1 < NCH) convert_x((ch + 1 < 2) ? p.x_prompt + (size_t)(ch + 1) * CT * DM : p.x_sample, XB, gtid, gthreads);
      }
      GSYNC();
      }
    }
  }
}

extern "C" void kernel_launch(void* const* d_in, const int* in_sizes, int n_in, void* d_out, int out_size, void* d_ws, size_t ws_size, hipStream_t stream) {
  static int grid_blocks = 0;
  if (grid_blocks == 0) {
    if (n_in != 11 || out_size != NCH * CT * DM || ws_size < WS_END) { fprintf(stderr, "kernel_launch: unexpected shapes n_in %d out %d ws %zu (need %zu)\n", n_in, out_size, ws_size, (size_t)WS_END); grid_blocks = -1; return; }
    int dev = 0, cus = 0, per_cu = 0;
    hipGetDevice(&dev);
    hipDeviceGetAttribute(&cus, hipDeviceAttributeMultiprocessorCount, dev);
    if (hipFuncSetAttribute((const void*)fwd_megakernel, hipFuncAttributeMaxDynamicSharedMemorySize, LDS_BYTES) != hipSuccess) { fprintf(stderr, "kernel_launch: hipFuncSetAttribute failed\n"); grid_blocks = -1; return; }
    hipOccupancyMaxActiveBlocksPerMultiprocessor(&per_cu, (const void*)fwd_megakernel, 512, LDS_BYTES);
    if (per_cu < 1) { fprintf(stderr, "kernel_launch: occupancy query says %d blocks per CU\n", per_cu); per_cu = 1; }
    (void)hipGetLastError();
    grid_blocks = cus;
  }
  if (grid_blocks < 0) return;
  Params p{};
  p.x_prompt = (const float*)d_in[0]; p.x_sample = (const float*)d_in[1]; p.w_in = (const float*)d_in[2]; p.b_in = (const float*)d_in[3];
  p.q_gain = (const float*)d_in[4]; p.k_gain = (const float*)d_in[5]; p.w_pa = (const float*)d_in[6]; p.w_pb = (const float*)d_in[7];
  p.w_out = (const float*)d_in[8]; p.ln_g = (const float*)d_in[9]; p.ln_b = (const float*)d_in[10];
  p.out = (float*)d_out; p.ws = (char*)d_ws;
  if (hipMemsetAsync((char*)d_ws + WS_BAR, 0, WS_ZERO_END - WS_BAR, stream) != hipSuccess) { fprintf(stderr, "kernel_launch: memset of the barrier words failed\n"); return; }
  void* args[] = {&p};
  hipError_t e = hipLaunchCooperativeKernel((const void*)fwd_megakernel, dim3(grid_blocks), dim3(512), args, LDS_BYTES, stream);
  if (e != hipSuccess) fprintf(stderr, "cooperative launch failed: %s (grid %d)\n", hipGetErrorString(e), grid_blocks);
}
```

```cpp
#include <hip/hip_runtime.h>
#include <hip/hip_cooperative_groups.h>
#include <cstdio>
#include <cstdint>
namespace cg = cooperative_groups;

#define LAS __attribute__((address_space(3)))
typedef unsigned short bf16_t;
typedef short bf16x8 __attribute__((ext_vector_type(8)));
typedef short s16x4 __attribute__((ext_vector_type(4)));
typedef float f32x4 __attribute__((ext_vector_type(4)));
typedef float f32x16 __attribute__((ext_vector_type(16)));
typedef unsigned u32x4 __attribute__((ext_vector_type(4)));
typedef unsigned u32x2 __attribute__((ext_vector_type(2)));
typedef int v4i_t __attribute__((ext_vector_type(4)));
typedef int v8i_t __attribute__((ext_vector_type(8)));

constexpr int DM = 1024, INW = 9728, CT = 16384, NCH = 3, DEPTH = 2;
constexpr int C_AQ = 0, C_AK = 1536, C_AV = 3072, C_AG = 4608, C_BQ = 5120, C_BK = 6144, C_BV = 6400, C_BG = 6656, C_GA = 7680, C_GB = 8704;
constexpr int YW = 1536;
constexpr float ALPHA = 1.41421356237309515f;
constexpr float RMS_EPS = 1e-6f, LN_EPS = 1e-5f;
constexpr size_t WS_WIN = 0;
constexpr size_t WS_WAB = WS_WIN + (size_t)2 * INW * DM * 2;
constexpr size_t WS_WO  = WS_WAB + (size_t)2 * DM * YW * 2;
constexpr size_t WS_XB  = WS_WO + (size_t)2 * DM * DM * 2;
constexpr size_t WS_H   = WS_XB + (size_t)CT * DM * 2;
constexpr size_t WS_Y   = WS_H + (size_t)CT * INW * 2;
constexpr size_t WS_MRG = WS_Y + (size_t)CT * YW * 2;
constexpr size_t WS_LSE = WS_MRG + (size_t)CT * DM * 2;
constexpr size_t WS_ROPE = WS_LSE + (size_t)CT * 12 * 4;
constexpr size_t WS_BAR = WS_ROPE + 256 * 32 * 2 * 4;
constexpr size_t WS_LNC = (WS_BAR + 3456 * 4 + 255) / 256 * 256;
constexpr size_t WS_ZERO_END = WS_LNC + (size_t)6 * 64 * 64 * 4;
constexpr size_t WS_LNX = WS_ZERO_END;
constexpr size_t WS_Q8  = (WS_LNX + (size_t)CT * 4 * 8 + 255) / 256 * 256;
constexpr size_t WS_K8  = WS_Q8 + (size_t)CT * 1024;
constexpr size_t WS_V8T = WS_K8 + (size_t)2 * CT * 128;
constexpr size_t WS_END = WS_V8T + (size_t)2 * CT * 128;
constexpr int LDS_BYTES = 132 * 1024;
#ifndef USE_LN_FUSED
#define USE_LN_FUSED 1
#endif
#ifndef USE_FP8_P1
#define USE_FP8_P1 1
#endif
#ifndef USE_FP8_B
#define USE_FP8_B 1
#endif
#ifndef DBG_UNIFORM
#define DBG_UNIFORM 0
#endif
#ifndef DBG_NAIVE_A
#define DBG_NAIVE_A 0
#endif
#ifndef DBG_NAIVE_B
#define DBG_NAIVE_B 0
#endif
#ifndef DBG_REP_A
#define DBG_REP_A 1
#endif
#ifndef DBG_REP_P4
#define DBG_REP_P4 1
#endif
#ifndef DBG_REP_C
#define DBG_REP_C 1
#endif
#ifndef DBG_REP_P1
#define DBG_REP_P1 1
#endif
#ifndef DBG_REP_B
#define DBG_REP_B 1
#endif
#ifndef DBG_NO_B
#define DBG_NO_B 0
#endif

struct Params {
  const float *x_prompt, *x_sample, *w_in, *b_in, *q_gain, *k_gain, *w_pa, *w_pb, *w_out, *ln_g, *ln_b;
  float* out; char* ws;
};

__device__ __forceinline__ int fresh_tid() { int t = threadIdx.x; asm volatile("" : "+v"(t)); return t; }
__device__ __forceinline__ unsigned cvtpk(float lo, float hi) { unsigned r; asm volatile("v_cvt_pk_bf16_f32 %0, %1, %2" : "=v"(r) : "v"(lo), "v"(hi)); return r; }
__device__ __forceinline__ float bflo(unsigned w) { return __uint_as_float(w << 16); }
__device__ __forceinline__ float bfhi(unsigned w) { return __uint_as_float(w & 0xffff0000u); }
__device__ __forceinline__ float bf2f(bf16_t b) { return __uint_as_float(((unsigned)b) << 16); }
__device__ __forceinline__ unsigned pk4_fp8(float a, float b, float c, float d) { const int t = __builtin_amdgcn_cvt_pk_fp8_f32(a, b, 0, false); return (unsigned)__builtin_amdgcn_cvt_pk_fp8_f32(c, d, t, true); }
typedef float f32x2_t __attribute__((ext_vector_type(2)));
__device__ __forceinline__ void fp8x4_to_f32(unsigned w, float* o) { const f32x2_t lo = __builtin_amdgcn_cvt_pk_f32_fp8((int)w, false), hi = __builtin_amdgcn_cvt_pk_f32_fp8((int)w, true); o[0] = lo[0]; o[1] = lo[1]; o[2] = hi[0]; o[3] = hi[1]; }
__device__ __forceinline__ float sigmoidf_(float x) { return __builtin_amdgcn_rcpf(1.f + __builtin_amdgcn_exp2f(-1.4426950408889634f * x)); }

namespace pg8 {
constexpr int BM = 256, BK = 64, HALF = 128, HTB = HALF * BK * 2, STAGE_BYTES = 8 * HTB, NXCD = 8, WGM = 4;
__device__ __forceinline__ int lds_byte(int r, int c) { const int st = (r >> 4) * 2 + (c >> 5), rr = r & 15, cc = c & 31, ob = rr * 64 + cc * 2; return st * 1024 + (ob ^ (((ob >> 9) & 1) << 5)); }
__device__ __forceinline__ void stage_rc(int b, int& R, int& C) { const int st = b / 1024, sb = b % 1024, swz = sb ^ (((sb >> 9) & 1) << 5); R = (st >> 1) * 16 + swz / 64; C = (st & 1) * 32 + (swz % 64) / 2; }
__device__ __forceinline__ int perm32(int rho) { const int n = rho >> 4, i = rho & 15; return 8 * (i >> 2) + 4 * n + (i & 3); }
struct Unit { int pm, pn, kind; };
__device__ __forceinline__ bool tile_of(int L, int nM, int nN, int& pm, int& pn) {
  const int nwg = nM * nN; if (L >= nwg) return false;
  int wgid = L; { const int q = nwg / NXCD, r = nwg % NXCD, xcd = wgid % NXCD, off = wgid / NXCD; wgid = (xcd < r ? xcd * (q + 1) : r * (q + 1) + (xcd - r) * q) + off; }
  const int nig = WGM * nN, gid = wgid / nig, fm = gid * WGM, gsz = (nM - fm) < WGM ? (nM - fm) : WGM;
  pm = fm + ((wgid % nig) % gsz); pn = (wgid % nig) / gsz; return true;
}
struct SchedStd {
  int nM, nN, G, c, lda, ldb, nt; const char *A, *B;
  __device__ __forceinline__ bool next(int i, Unit& u) const { u.kind = 0; return tile_of(i * G + c, nM, nN, u.pm, u.pn); }
  __device__ __forceinline__ void op(const Unit& u, const char*& a, const char*& b, int& n) const { a = A + (size_t)u.pm * BM * lda * 2; b = B + (size_t)u.pn * BM * ldb * 2; n = nt; }
};
struct SchedMerge {
  int nM, nN, G, c, lda, ldb; const char *A, *B;
  __device__ __forceinline__ bool next(int i, Unit& u) const { u.kind = i & 1; return tile_of((i >> 1) * G + c, nM, nN, u.pm, u.pn); }
  __device__ __forceinline__ void op(const Unit& u, const char*& a, const char*& b, int& n) const {
    a = A + (size_t)u.pm * BM * lda * 2 + (u.kind ? 1024 : 0); b = B + (size_t)u.pn * BM * ldb * 2 + (u.kind ? 1024 : 0); n = u.kind ? 16 : 8; }
};

struct EpiIn {
  static __device__ __forceinline__ bool keep_acc(const Unit&) { return false; }
  static constexpr bool AFTER_DRAIN = false;
  static constexpr bool PERM = true;
  bf16_t* H; const float* bias; float ascale;
  __device__ __forceinline__ void operator()(const f32x4 (&acc)[2][2][4][2], const Unit& u, int wr, int wc, int fr, int fq) const {
    const int row0 = u.pm * BM + wr * 64 + fr, col0 = u.pn * BM + wc * 32 + 8 * fq;
    const int act = (u.pn >= 30) ? 2 : (((u.pn >= 18 && u.pn < 20) || (u.pn >= 26)) ? 1 : 0);
    const bool f8 = (u.pn >= 20 && u.pn < 30) || (u.pn >= 34);
    const int fs = (u.pn < 24) ? C_BQ : (u.pn == 24) ? C_BK : (u.pn == 25) ? C_BV : (u.pn < 30) ? C_BG : C_GB;
    f32x4 bv[2][2];
#pragma unroll
    for (int bj = 0; bj < 2; ++bj)
#pragma unroll
      for (int n = 0; n < 2; ++n) bv[bj][n] = *(const f32x4*)(bias + col0 + bj * HALF + 4 * n);
#pragma unroll
    for (int ai = 0; ai < 2; ++ai)
#pragma unroll
      for (int m = 0; m < 4; ++m) { bf16_t* rowp = H + (size_t)(row0 + ai * HALF + m * 16) * INW + col0;
#pragma unroll
        for (int bj = 0; bj < 2; ++bj) { f32x4 v0 = acc[ai][bj][m][0] * ascale + bv[bj][0], v1 = acc[ai][bj][m][1] * ascale + bv[bj][1];
          if (act) {
#pragma unroll
            for (int j = 0; j < 4; ++j) { const float s0 = sigmoidf_(v0[j]), s1 = sigmoidf_(v1[j]); v0[j] = (act == 1) ? v0[j] * s0 : s0; v1[j] = (act == 1) ? v1[j] * s1 : s1; } }
          if (f8) { u32x2 w8; w8.x = pk4_fp8(v0[0], v0[1], v0[2], v0[3]); w8.y = pk4_fp8(v1[0], v1[1], v1[2], v1[3]);
            *(u32x2*)((unsigned char*)H + (size_t)(row0 + ai * HALF + m * 16) * (INW * 2) + fs * 2 + (col0 - fs) + bj * HALF) = w8; }
          else { u32x4 w; w.x = cvtpk(v0[0], v0[1]); w.y = cvtpk(v0[2], v0[3]); w.z = cvtpk(v1[0], v1[1]); w.w = cvtpk(v1[2], v1[3]);
            *(u32x4*)(rowp + bj * HALF) = w; } } }
  }
};
struct EpiMerge {
  static constexpr bool AFTER_DRAIN = false;
  static constexpr bool PERM = true;
  const bf16_t* H; bf16_t* T; bf16_t* MRG;
  static __device__ __forceinline__ bool keep_acc(const Unit& u) { return u.kind == 0; }
  __device__ __forceinline__ void operator()(f32x4 (&acc)[2][2][4][2], const Unit& u, int wr, int wc, int fr, int fq) const {
    const int row0 = u.pm * BM + wr * 64 + fr, col0 = u.pn * BM + wc * 32 + 8 * fq;
#pragma unroll
    for (int ai = 0; ai < 2; ++ai)
#pragma unroll
      for (int m = 0; m < 4; ++m) { const size_t row = (size_t)(row0 + ai * HALF + m * 16);
#pragma unroll
        for (int bj = 0; bj < 2; ++bj) {
          float gb[8];
          { const u32x2 g8 = *(const u32x2*)((const unsigned char*)H + row * (INW * 2) + C_GB * 2 + col0 + bj * HALF); fp8x4_to_f32(g8.x, gb); fp8x4_to_f32(g8.y, gb + 4); }
#pragma unroll
          for (int j = 0; j < 8; ++j) gb[j] = fmaxf(gb[j], 9.765625e-4f);
          if (u.kind == 0) {
            const u32x4 g = *(const u32x4*)(H + row * INW + C_GA + col0 + bj * HALF);
            const float ga[8] = {bflo(g.x), bfhi(g.x), bflo(g.y), bfhi(g.y), bflo(g.z), bfhi(g.z), bflo(g.w), bfhi(g.w)};
#pragma unroll
            for (int j = 0; j < 4; ++j) { acc[ai][bj][m][0][j] *= ga[j] * __builtin_amdgcn_rcpf(gb[j]); acc[ai][bj][m][1][j] *= ga[4 + j] * __builtin_amdgcn_rcpf(gb[4 + j]); }
          } else {
            const f32x4 a0 = acc[ai][bj][m][0], a1 = acc[ai][bj][m][1];
            u32x4 w; w.x = cvtpk(a0[0] * gb[0], a0[1] * gb[1]); w.y = cvtpk(a0[2] * gb[2], a0[3] * gb[3]); w.z = cvtpk(a1[0] * gb[4], a1[1] * gb[5]); w.w = cvtpk(a1[2] * gb[6], a1[3] * gb[7]);
            *(u32x4*)(MRG + row * DM + col0 + bj * HALF) = w; } } }
  }
};
struct EpiOut {
  static __device__ __forceinline__ bool keep_acc(const Unit&) { return false; }
  static constexpr bool AFTER_DRAIN = false;
  static constexpr bool PERM = true;
  const float* X; float* Z;
  __device__ __forceinline__ void operator()(const f32x4 (&acc)[2][2][4][2], const Unit& u, int wr, int wc, int fr, int fq) const {
    const int row0 = u.pm * BM + wr * 64 + fr, col0 = u.pn * BM + wc * 32 + 8 * fq;
#pragma unroll
    for (int ai = 0; ai < 2; ++ai)
#pragma unroll
      for (int m = 0; m < 4; ++m) { const size_t off = (size_t)(row0 + ai * HALF + m * 16) * DM + col0;
#pragma unroll
        for (int bj = 0; bj < 2; ++bj)
#pragma unroll
          for (int n = 0; n < 2; ++n) { const f32x4 xv = *(const f32x4*)(X + off + bj * HALF + n * 4); *(f32x4*)(Z + off + bj * HALF + n * 4) = xv * ALPHA + acc[ai][bj][m][n]; } }
  }
};


struct EpiLN {
  static __device__ __forceinline__ bool keep_acc(const Unit&) { return false; }
  static constexpr bool PERM = true, AFTER_DRAIN = true;
  const float* X; float* Yo; unsigned char* XB8; const float* g; const float* b; unsigned long long* slots; unsigned* cnt; int write_xb;
  __device__ __forceinline__ void fused(f32x4 (&acc)[2][2][4][2], const Unit& u, int wr, int wc, int fr, int fq, LAS unsigned char* lds, int wid, int lane) const {
    typedef float f32x2v __attribute__((ext_vector_type(2)));
    LAS f32x2v* P = (LAS f32x2v*)lds;
    LAS f32x2v* S = (LAS f32x2v*)(lds + 8192);
    const int col0 = u.pn * BM + wc * 32 + 8 * fq;
#pragma unroll
    for (int ai = 0; ai < 2; ++ai)
#pragma unroll
      for (int m = 0; m < 4; ++m) { const int rl = ai * HALF + wr * 64 + m * 16 + fr; const size_t off = (size_t)(u.pm * BM + rl) * DM + col0;
        float s1 = 0.f, s2 = 0.f;
#pragma unroll
        for (int bj = 0; bj < 2; ++bj)
#pragma unroll
          for (int n = 0; n < 2; ++n) { const f32x4 xv = *(const f32x4*)(X + off + bj * HALF + n * 4); const f32x4 z = xv * ALPHA + acc[ai][bj][m][n]; acc[ai][bj][m][n] = z;
            s1 += (z[0] + z[1]) + (z[2] + z[3]); s2 += (z[0] * z[0] + z[1] * z[1]) + (z[2] * z[2] + z[3] * z[3]); }
        s1 += __shfl_xor(s1, 16); s1 += __shfl_xor(s1, 32); s2 += __shfl_xor(s2, 16); s2 += __shfl_xor(s2, 32);
        if (fq == 0) P[rl * 4 + wc] = (f32x2v){s1, s2};
        asm volatile("" ::: "memory"); }
    asm volatile("s_waitcnt lgkmcnt(0)" ::: "memory"); __builtin_amdgcn_s_barrier(); asm volatile("" ::: "memory");
    const int t = wid * 64 + lane;
    if (t < 256) { const f32x2v a = P[t * 4 + 0], b2 = P[t * 4 + 1], c = P[t * 4 + 2], d = P[t * 4 + 3];
      const float m1 = (a.x + b2.x) + (c.x + d.x), m2 = (a.y + b2.y) + (c.y + d.y);
      __hip_atomic_store(slots + ((size_t)(u.pm * BM + t) * 4 + u.pn), ((unsigned long long)__float_as_uint(m2) << 32) | __float_as_uint(m1), __ATOMIC_RELAXED, __HIP_MEMORY_SCOPE_AGENT); }
    asm volatile("s_waitcnt vmcnt(0)" ::: "memory"); __builtin_amdgcn_s_barrier(); asm volatile("" ::: "memory");
    if (t == 0) { __hip_atomic_fetch_add(cnt + 64 * u.pm, 1u, __ATOMIC_RELAXED, __HIP_MEMORY_SCOPE_AGENT);
      unsigned sp = 0; while (__hip_atomic_load(cnt + 64 * u.pm, __ATOMIC_RELAXED, __HIP_MEMORY_SCOPE_AGENT) < 4u) { __builtin_amdgcn_s_sleep(2); if (++sp > (1u << 22)) break; }
      __builtin_amdgcn_fence(__ATOMIC_ACQUIRE, "agent"); asm volatile("s_waitcnt vmcnt(0)" ::: "memory"); }
    __builtin_amdgcn_s_barrier(); asm volatile("" ::: "memory");
    if (t < 256) { const unsigned long long* sl = slots + (size_t)(u.pm * BM + t) * 4; float m1 = 0.f, m2 = 0.f;
#pragma unroll
      for (int q = 0; q < 4; ++q) { const unsigned long long w = __hip_atomic_load(sl + q, __ATOMIC_RELAXED, __HIP_MEMORY_SCOPE_AGENT); m1 += __uint_as_float((unsigned)w); m2 += __uint_as_float((unsigned)(w >> 32)); }
      const float mean = m1 * (1.f / DM), var = fmaxf(m2 * (1.f / DM) - mean * mean, 0.f);
      S[t] = (f32x2v){mean, rsqrtf(var + LN_EPS)}; }
    asm volatile("s_waitcnt lgkmcnt(0)" ::: "memory"); __builtin_amdgcn_s_barrier(); asm volatile("" ::: "memory");
#pragma unroll
    for (int bj = 0; bj < 2; ++bj)
#pragma unroll
      for (int n = 0; n < 2; ++n) { const f32x4 gv = *(const f32x4*)(g + col0 + bj * HALF + n * 4), bv = *(const f32x4*)(b + col0 + bj * HALF + n * 4);
#pragma unroll
        for (int ai = 0; ai < 2; ++ai)
#pragma unroll
          for (int m = 0; m < 4; ++m) { const int rl = ai * HALF + wr * 64 + m * 16 + fr; const f32x2v st = S[rl]; const size_t row = (size_t)(u.pm * BM + rl);
            const f32x4 y = (acc[ai][bj][m][n] - st.x) * st.y * gv + bv;
            *(f32x4*)(Yo + row * DM + col0 + bj * HALF + n * 4) = y;
            if (write_xb) *(unsigned*)(XB8 + row * DM + col0 + bj * HALF + n * 4) = pk4_fp8(y[0], y[1], y[2], y[3]); } }
  }
};

template <class Epi, class Sched, bool FP8 = false>
__device__ __forceinline__ void gemm_phase(LAS unsigned char* lds, const Sched& S, const Epi& E) {
  const int tid = fresh_tid(), wid = __builtin_amdgcn_readfirstlane(tid >> 6), lane = tid & 63, wr = wid >> 2, wc = wid & 3, fr = lane & 15, fq = lane >> 4;
  const int lda = S.lda, ldb = S.ldb;
  unsigned voffA[2], voffB[2];
#pragma unroll
  for (int i = 0; i < 2; ++i) { int R, C; stage_rc(tid * 16 + i * 8192, R, C); const int Rb = Epi::PERM ? ((R & ~31) + perm32(R & 31)) : R;
    voffA[i] = (unsigned)(R * lda + C) * 2u; voffB[i] = (unsigned)(Rb * ldb + C) * 2u; }
  const size_t kstep = (size_t)(BK * 2);
  const size_t hstepA = (size_t)HALF * lda * 2, hstepB = (size_t)HALF * ldb * 2;
  const unsigned ldsw = (unsigned)wid * 1024u;
  const int aoff = lds_byte(wr * 64 + fr, fq * 8), boff = lds_byte(wc * 32 + fr, fq * 8);
#define PG8_SA(b, h) (((b) * 2 + (h)) * HTB)
#define PG8_SB(b, h) ((4 + (b) * 2 + (h)) * HTB)
#define PG8_STAGE(bufoff, gbase, voff) do { _Pragma("unroll") for (int _i = 0; _i < 2; ++_i) \
    __builtin_amdgcn_global_load_lds((const unsigned*)((const char*)(gbase) + (voff)[_i]), (LAS unsigned*)(lds + (bufoff) + ldsw + _i * 8192), 16, 0, 0); } while (0)
#define PG8_LDA(dst, b, h) do { if constexpr (FP8) { _Pragma("unroll") for (int m = 0; m < 4; ++m) dst##8[m] = __builtin_shufflevector(*(const LAS v4i_t*)(lds + PG8_SA(b, h) + aoff + m * 2048), *(const LAS v4i_t*)(lds + PG8_SA(b, h) + aoff + m * 2048 + 1024), 0, 1, 2, 3, 4, 5, 6, 7); } \
    else { _Pragma("unroll") for (int m = 0; m < 4; ++m) _Pragma("unroll") for (int k = 0; k < 2; ++k) dst[m][k] = *(const LAS bf16x8*)(lds + PG8_SA(b, h) + aoff + m * 2048 + k * 1024); } } while (0)
#define PG8_LDB(dst, b, h) do { if constexpr (FP8) { _Pragma("unroll") for (int n = 0; n < 2; ++n) dst##8[n] = __builtin_shufflevector(*(const LAS v4i_t*)(lds + PG8_SB(b, h) + boff + n * 2048), *(const LAS v4i_t*)(lds + PG8_SB(b, h) + boff + n * 2048 + 1024), 0, 1, 2, 3, 4, 5, 6, 7); } \
    else { _Pragma("unroll") for (int n = 0; n < 2; ++n) _Pragma("unroll") for (int k = 0; k < 2; ++k) dst[n][k] = *(const LAS bf16x8*)(lds + PG8_SB(b, h) + boff + n * 2048 + k * 1024); } } while (0)
#define PG8_CAT(x, y) __builtin_shufflevector(__builtin_bit_cast(v4i_t, x), __builtin_bit_cast(v4i_t, y), 0, 1, 2, 3, 4, 5, 6, 7)
#define PG8_MMA(ai, bj, At, Bt) do { __builtin_amdgcn_s_setprio(1); \
    if constexpr (FP8) { _Pragma("unroll") for (int m = 0; m < 4; ++m) _Pragma("unroll") for (int n = 0; n < 2; ++n) \
      asm volatile("v_mfma_f32_16x16x128_f8f6f4 %0, %1, %2, %0" : "+v"(acc[ai][bj][m][n]) : "v"(Bt##8[n]), "v"(At##8[m])); } \
    else { _Pragma("unroll") for (int m = 0; m < 4; ++m) _Pragma("unroll") for (int n = 0; n < 2; ++n) _Pragma("unroll") for (int k = 0; k < 2; ++k) \
      acc[ai][bj][m][n] = __builtin_amdgcn_mfma_f32_16x16x32_bf16(Bt[n][k], At[m][k], acc[ai][bj][m][n], 0, 0, 0); } \
    __builtin_amdgcn_s_setprio(0); } while (0)
#define PG8_WAIT_V(n) asm volatile("s_waitcnt vmcnt(" #n ")" ::: "memory")
#define PG8_WAIT_L(n) asm volatile("s_waitcnt lgkmcnt(" #n ")" ::: "memory")
#define PG8_BAR __builtin_amdgcn_s_barrier()
#define PG8_SCHED __builtin_amdgcn_sched_barrier(0)
  Unit cur, nxt; int ui = 0;
  if (!S.next(0, cur)) return;
  f32x4 acc[2][2][4][2];
#pragma unroll
  for (int a = 0; a < 2; ++a)
#pragma unroll
    for (int b = 0; b < 2; ++b)
#pragma unroll
      for (int m = 0; m < 4; ++m)
#pragma unroll
        for (int n = 0; n < 2; ++n) acc[a][b][m][n] = (f32x4){0.f, 0.f, 0.f, 0.f};
  bf16x8 At[4][2], B0[2][2], B1[2][2]; v8i_t At8[4], B08[2], B18[2]; (void)At; (void)B0; (void)B1; (void)At8; (void)B08; (void)B18;
  const char *cA, *cB; int nt; S.op(cur, cA, cB, nt);
  PG8_STAGE(PG8_SB(0, 0), cB, voffB); PG8_STAGE(PG8_SA(0, 0), cA, voffA); PG8_STAGE(PG8_SB(0, 1), cB + hstepB, voffB); PG8_STAGE(PG8_SA(0, 1), cA + hstepA, voffA);
  if (wr == 1) PG8_BAR;
  PG8_WAIT_V(4); PG8_BAR;
  PG8_STAGE(PG8_SB(1, 0), cB + kstep, voffB); PG8_STAGE(PG8_SA(1, 0), cA + kstep, voffA); PG8_STAGE(PG8_SB(1, 1), cB + hstepB + kstep, voffB);
  PG8_WAIT_V(6); PG8_BAR;
  for (;;) {
    const bool has_next = S.next(ui + 1, nxt);
    const char *nA = cA, *nB = cB; int nnt = nt;
    if (has_next) S.op(nxt, nA, nB, nnt);
    for (int t = 0; t < nt; t += 2) {
      const bool last = (t == nt - 2);
      const char* a1 = cA + (size_t)(t + 1) * kstep;
      const char* a2 = last ? nA : cA + (size_t)(t + 2) * kstep; const char* b2 = last ? nB : cB + (size_t)(t + 2) * kstep;
      const char* a3 = a2 + kstep; const char* b3 = b2 + kstep;
      PG8_LDB(B0, 0, 0); PG8_SCHED; PG8_LDA(At, 0, 0); PG8_STAGE(PG8_SA(1, 1), a1 + hstepA, voffA);
      PG8_WAIT_L(8); PG8_BAR; PG8_WAIT_L(0); PG8_MMA(0, 0, At, B0); PG8_BAR; PG8_SCHED;
      PG8_LDB(B1, 0, 1); PG8_STAGE(PG8_SB(0, 0), b2, voffB);
      PG8_BAR; PG8_WAIT_L(0); PG8_MMA(0, 1, At, B1); PG8_BAR;
      PG8_LDA(At, 0, 1); PG8_STAGE(PG8_SA(0, 0), a2, voffA);
      PG8_BAR; PG8_WAIT_L(0); PG8_MMA(1, 0, At, B0); PG8_BAR; PG8_SCHED;
      PG8_STAGE(PG8_SB(0, 1), b2 + hstepB, voffB);
      PG8_WAIT_V(6); PG8_BAR; PG8_MMA(1, 1, At, B1); PG8_BAR;
      PG8_LDB(B0, 1, 0); PG8_SCHED; PG8_LDA(At, 1, 0); PG8_STAGE(PG8_SA(0, 1), a2 + hstepA, voffA);
      PG8_WAIT_L(8); PG8_BAR; PG8_WAIT_L(0); PG8_MMA(0, 0, At, B0); PG8_BAR; PG8_SCHED;
      PG8_LDB(B1, 1, 1); PG8_STAGE(PG8_SB(1, 0), b3, voffB);
      PG8_BAR; PG8_WAIT_L(0); PG8_MMA(0, 1, At, B1); PG8_BAR;
      PG8_LDA(At, 1, 1); PG8_STAGE(PG8_SA(1, 0), a3, voffA);
      PG8_BAR; PG8_WAIT_L(0); PG8_MMA(1, 0, At, B0); PG8_BAR; PG8_SCHED;
      PG8_STAGE(PG8_SB(1, 1), b3 + hstepB, voffB);
      PG8_WAIT_V(6); PG8_BAR; PG8_MMA(1, 1, At, B1); PG8_BAR;
    }
    if constexpr (FP8) asm volatile("s_nop 15\n\ts_nop 15\n\ts_nop 15" ::: "memory");
    if constexpr (!Epi::AFTER_DRAIN) { Unit ue = cur; int fr_ = fr, fq_ = fq;
      asm volatile("" : "+s"(ue.pm), "+s"(ue.pn), "+s"(ue.kind), "+v"(fr_), "+v"(fq_));
      E(acc, ue, wr, wc, fr_, fq_); }
    if (!has_next) break;
    if (!Epi::keep_acc(cur)) {
#pragma unroll
    for (int a = 0; a < 2; ++a)
#pragma unroll
      for (int b = 0; b < 2; ++b)
#pragma unroll
        for (int m = 0; m < 4; ++m)
#pragma unroll
          for (int n = 0; n < 2; ++n) acc[a][b][m][n] = (f32x4){0.f, 0.f, 0.f, 0.f};
    }
    cur = nxt; cA = nA; cB = nB; nt = nnt; ++ui;
  }
  PG8_WAIT_V(0);
  if (wr == 0) PG8_BAR;
  PG8_BAR;
  if constexpr (Epi::AFTER_DRAIN) { Unit ue = cur; int fr_ = fr, fq_ = fq;
    asm volatile("" : "+s"(ue.pm), "+s"(ue.pn), "+v"(fr_), "+v"(fq_));
    E.fused(acc, ue, wr, wc, fr_, fq_, lds, wid, lane); }
#undef PG8_SA
#undef PG8_SB
#undef PG8_STAGE
#undef PG8_LDA
#undef PG8_LDB
#undef PG8_MMA
#undef PG8_CAT
#undef PG8_WAIT_V
#undef PG8_WAIT_L
#undef PG8_BAR
#undef PG8_SCHED
}
}


__device__ __forceinline__ void store_tile_rows(const f32x16* o, const float* rli, char* wl, int r32, int hi, int lane, bf16_t* Orow0, long ostride, const unsigned char* Grow0, long gstride) {
#pragma unroll
  for (int r = 0; r < 16; ++r) { const int row = (r & 3) + 8 * (r >> 2) + 4 * hi;
#pragma unroll
    for (int d0 = 0; d0 < 4; ++d0) *(bf16_t*)(wl + row * 256 + (d0 * 32 + r32) * 2) = (bf16_t)(cvtpk(o[d0][r] * rli[r], 0.f) & 0xffffu);
    asm volatile("" ::: "memory"); }
  asm volatile("s_waitcnt lgkmcnt(0)" ::: "memory");
#pragma unroll 1
  for (int it = 0; it < 8; ++it) { const int chunk = it * 64 + lane, row = chunk >> 4, cc = chunk & 15;
    u32x4 v = *(const u32x4*)(wl + chunk * 16);
    if (Grow0) { const u32x2 g8 = *(const u32x2*)(Grow0 + (long)row * gstride + cc * 8); float gf[8]; fp8x4_to_f32(g8.x, gf); fp8x4_to_f32(g8.y, gf + 4);
      v.x = cvtpk(bflo(v.x) * gf[0], bfhi(v.x) * gf[1]); v.y = cvtpk(bflo(v.y) * gf[2], bfhi(v.y) * gf[3]);
      v.z = cvtpk(bflo(v.z) * gf[4], bfhi(v.z) * gf[5]); v.w = cvtpk(bflo(v.w) * gf[6], bfhi(v.w) * gf[7]); }
    *(u32x4*)(Orow0 + (long)row * ostride + cc * 8) = v; }
  asm volatile("s_waitcnt lgkmcnt(0)" ::: "memory");
}
constexpr int EPI_LDS_OFF = 66 * 1024;

namespace at {
constexpr int D = 128, NW = 8, QBLK = 32, KVBLK = 64;
constexpr float SCALE = 0.088388347648318440f;
constexpr float THR = 8.f;
constexpr size_t SHM_V = KVBLK * D * 2, SHM_K = KVBLK * D * 2, SHM_ATTN = 2 * SHM_V + 2 * SHM_K + NW * 64 * 4;
#define KSWZ(row, colB) ((row) * 256 + ((colB) ^ (((row) & 7) << 4)))
#define SBAR() __builtin_amdgcn_sched_barrier(0)
__device__ __forceinline__ int crow(int r, int hi) { return (r & 3) + 8 * (r >> 2) + 4 * hi; }

template <bool BAND>
__device__ __forceinline__ void partialSM(f32x16& p0, f32x16& p1, float& m_reg, float& mn, float& alpha, int kb, int uq, int L, float sl, int hi) {
  constexpr float C = SCALE * 1.4426950408889634f;
#if DBG_UNIFORM
  if constexpr (!BAND) { p0 = p0 * 0.f; p1 = p1 * 0.f; }
#endif
  if constexpr (BAND) {
#pragma unroll
    for (int r = 0; r < 16; ++r) {
      const int k0i = kb + crow(r, hi), k1i = k0i + 32;
      const float a0 = fabsf((float)(k0i - uq)), a1 = fabsf((float)(k1i - uq));
      const bool ok0 = (a0 <= 64.f) && ((unsigned)k0i < (unsigned)L), ok1 = (a1 <= 64.f) && ((unsigned)k1i < (unsigned)L);
      p0[r] = ok0 ? fmaf(-a0, sl, p0[r]) : -1e30f; p1[r] = ok1 ? fmaf(-a1, sl, p1[r]) : -1e30f;
    }
  }
  float pmax = p0[0];
#pragma unroll
  for (int r = 1; r < 16; ++r) pmax = fmaxf(pmax, p0[r]);
#pragma unroll
  for (int r = 0; r < 16; ++r) pmax = fmaxf(pmax, p1[r]);
  { auto rr = __builtin_amdgcn_permlane32_swap(__float_as_uint(pmax), __float_as_uint(pmax), false, false);
    pmax = fmaxf(__uint_as_float(rr[0]), __uint_as_float(rr[1])); }
  if (__builtin_expect(__all(pmax - m_reg <= THR / SCALE), 1)) { mn = m_reg; alpha = 1.f; }
  else { mn = fmaxf(m_reg, pmax); alpha = __builtin_amdgcn_exp2f((m_reg - mn) * C); m_reg = mn; }
  const float mnC = -mn * C;
#pragma unroll
  for (int r = 0; r < 16; ++r) p0[r] = fmaf(p0[r], C, mnC);
#pragma unroll
  for (int r = 0; r < 16; ++r) p1[r] = fmaf(p1[r], C, mnC);
#pragma unroll
  for (int r = 0; r < 16; ++r) p0[r] = __builtin_amdgcn_exp2f(p0[r]);
}
__device__ __forceinline__ void finishSM(f32x16& p0, f32x16& p1, float alpha, float& l_reg, bf16x8& pa0, bf16x8& pa1, bf16x8& pa2, bf16x8& pa3) {
#pragma unroll
  for (int r = 0; r < 16; ++r) p1[r] = __builtin_amdgcn_exp2f(p1[r]);
  float ps = 0;
#pragma unroll
  for (int r = 0; r < 16; ++r) ps += p0[r];
#pragma unroll
  for (int r = 0; r < 16; ++r) ps += p1[r];
  { auto rr = __builtin_amdgcn_permlane32_swap(__float_as_uint(ps), __float_as_uint(ps), false, false);
    ps = __uint_as_float(rr[0]) + __uint_as_float(rr[1]); }
  l_reg = l_reg * alpha + ps;
#define PK4(P, BASE, OUT) do { unsigned a0 = cvtpk(P[BASE + 0], P[BASE + 1]), a1 = cvtpk(P[BASE + 2], P[BASE + 3]);   \
    unsigned b0 = cvtpk(P[BASE + 4], P[BASE + 5]), b1 = cvtpk(P[BASE + 6], P[BASE + 7]);                              \
    auto r0 = __builtin_amdgcn_permlane32_swap(a0, b0, false, false); auto r1 = __builtin_amdgcn_permlane32_swap(a1, b1, false, false); \
    u32x4 w = {r0[0], r1[0], r0[1], r1[1]}; OUT = *reinterpret_cast<bf16x8*>(&w); } while (0)
  PK4(p0, 0, pa0); PK4(p0, 8, pa1); PK4(p1, 0, pa2); PK4(p1, 8, pa3);
#undef PK4
}
__device__ __forceinline__ void qkt(f32x16& p0, f32x16& p1, const char* Ks, const bf16x8* qr, int r32, int hi) {
  p0 = f32x16{}; p1 = f32x16{};
#pragma unroll
  for (int d0 = 0; d0 < 8; ++d0) { const int cb = (d0 * 16 + hi * 8) * 2;
    bf16x8 b0 = *reinterpret_cast<const bf16x8*>(Ks + KSWZ(r32, cb));
    bf16x8 b1 = *reinterpret_cast<const bf16x8*>(Ks + KSWZ(32 + r32, cb));
    p0 = __builtin_amdgcn_mfma_f32_32x32x16_bf16(b0, qr[d0], p0, 0, 0, 0);
    p1 = __builtin_amdgcn_mfma_f32_32x32x16_bf16(b1, qr[d0], p1, 0, 0, 0); }
}
__device__ __forceinline__ int v_st(int k, int c) { const int kk = (k & ~0xC) | ((k & 4) << 1) | ((k & 8) >> 1); return ((kk >> 3) * 4 + (c >> 5)) * 512 + ((kk & 7) * 32 + (c & 31)) * 2; }
__device__ __forceinline__ int v_rd_base(int lane) { return ((lane & 3) << 3) | (((lane >> 2) & 3) << 6) | (((lane >> 4) & 1) << 5) | (((lane >> 5) & 1) << 8); }
constexpr int v_rd_off(int d0, int ks, int half) { return d0 * 512 + ks * 4096 + half * 2048; }
template <int OFF> __device__ __forceinline__ s16x4 tr_read(int vb) {
  s16x4 r; asm volatile("ds_read_b64_tr_b16 %0, %1 offset:%2" : "=&v"(r) : "v"(vb), "i"(OFF) : "memory"); return r;
}
template <int D0> __device__ __forceinline__ void pv_one(f32x16& od, int vb, bf16x8 pa0, bf16x8 pa1, bf16x8 pa2, bf16x8 pa3) {
  const s16x4 l0 = tr_read<v_rd_off(D0, 0, 0)>(vb), h0 = tr_read<v_rd_off(D0, 0, 1)>(vb), l1 = tr_read<v_rd_off(D0, 1, 0)>(vb), h1 = tr_read<v_rd_off(D0, 1, 1)>(vb);
  const s16x4 l2 = tr_read<v_rd_off(D0, 2, 0)>(vb), h2 = tr_read<v_rd_off(D0, 2, 1)>(vb), l3 = tr_read<v_rd_off(D0, 3, 0)>(vb), h3 = tr_read<v_rd_off(D0, 3, 1)>(vb);
  asm volatile("s_waitcnt lgkmcnt(0)" ::: "memory"); SBAR();
#define PK(L, H) (bf16x8){L[0], L[1], L[2], L[3], H[0], H[1], H[2], H[3]}
  od = __builtin_amdgcn_mfma_f32_32x32x16_bf16(pa0, PK(l0, h0), od, 0, 0, 0);
  od = __builtin_amdgcn_mfma_f32_32x32x16_bf16(pa1, PK(l1, h1), od, 0, 0, 0);
  od = __builtin_amdgcn_mfma_f32_32x32x16_bf16(pa2, PK(l2, h2), od, 0, 0, 0);
  od = __builtin_amdgcn_mfma_f32_32x32x16_bf16(pa3, PK(l3, h3), od, 0, 0, 0);
#undef PK
}
__device__ __forceinline__ void pv_d0(f32x16* o, int vb, bf16x8 pa0, bf16x8 pa1, bf16x8 pa2, bf16x8 pa3) {
  pv_one<0>(o[0], vb, pa0, pa1, pa2, pa3); pv_one<1>(o[1], vb, pa0, pa1, pa2, pa3); pv_one<2>(o[2], vb, pa0, pa1, pa2, pa3); pv_one<3>(o[3], vb, pa0, pa1, pa2, pa3);
}

template <bool BAND>
__device__ __forceinline__ void attn_body(const bf16_t* Qb, const bf16_t* Kh, const bf16_t* Vh, long rs, int NT,
                                          int ubase, int u0, int L, float sl,
                                          bf16_t* Ob, const bf16_t* Gb, float* Lp, long lse_stride, char* lds, bool do_store = true) {
  const int tid = fresh_tid(), wid = tid >> 6, lane = tid & 63, r32 = lane & 31, hi = lane >> 5;
  if (__builtin_amdgcn_readfirstlane(wid) >= 4) __builtin_amdgcn_s_setprio(1);
  char* V_lds = lds; char* K_lds = lds + 2 * SHM_V;
  float* wsl = (float*)(lds + 2 * SHM_V + 2 * SHM_K) + wid * 64; float* li_l = wsl; float* al_l = wsl + 32;
  float m_reg = BAND ? -1e5f : -1e30f, l_reg = 0; f32x16 o[4] = {}; bf16x8 qr[8];
  const int uq = u0 + wid * QBLK + r32;
  const bf16_t* Qw = Qb + (long)(wid * QBLK + r32) * rs + hi * 8;
#pragma unroll
  for (int d0 = 0; d0 < 8; ++d0) qr[d0] = *reinterpret_cast<const bf16x8*>(Qw + d0 * 16);
  const int sr = tid >> 4, sc = (tid & 15) * 8, vst0 = v_st(sr, sc), vst1 = v_st(32 + sr, sc);
  const int vb0 = (int)(uintptr_t)V_lds + v_rd_base(lane);
  struct { bf16x8 vs0, vs1, ks0, ks1; } sr_[2];
#define KROW(k) (BAND ? (long)min(max(ubase + (k), 0), L - 1) * rs : (long)(k) * rs)
#define SLOAD(i, k0) do { const long ra_ = KROW((k0) + sr) + sc, rb_ = KROW((k0) + 32 + sr) + sc; \
    sr_[i].vs0 = *reinterpret_cast<const bf16x8*>(Vh + ra_); sr_[i].vs1 = *reinterpret_cast<const bf16x8*>(Vh + rb_); \
    sr_[i].ks0 = *reinterpret_cast<const bf16x8*>(Kh + ra_); sr_[i].ks1 = *reinterpret_cast<const bf16x8*>(Kh + rb_); } while (0)
#define SWRITE(b, i) do { *(bf16x8*)(V_lds + (b) * SHM_V + vst0) = sr_[i].vs0;          \
    *(bf16x8*)(V_lds + (b) * SHM_V + vst1) = sr_[i].vs1; const int kc = sc * 2;               \
    *(bf16x8*)(K_lds + (b) * SHM_K + KSWZ(sr, kc)) = sr_[i].ks0;                       \
    *(bf16x8*)(K_lds + (b) * SHM_K + KSWZ(32 + sr, kc)) = sr_[i].ks1; } while (0)
#define SWAIT() asm volatile("s_waitcnt vmcnt(4)" ::: "memory")
#define RESC(a) do { if (__any((a) < 1.f)) { if (hi == 0) al_l[r32] = (a); asm volatile("s_waitcnt lgkmcnt(0)" ::: "memory"); \
    _Pragma("unroll") for (int d = 0; d < 4; ++d) _Pragma("unroll") for (int r = 0; r < 16; ++r) o[d][r] *= al_l[crow(r, hi)]; } } while (0)
  f32x16 pA0, pA1, pB0, pB1; float mnA, mnB, alA, alB; bf16x8 pa0, pa1, pa2, pa3;
  constexpr int SE = 0, SO = 1;
  SLOAD(SE, 0); SLOAD(SO, KVBLK); SWAIT(); SWRITE(0, SE); __syncthreads();
  qkt(pA0, pA1, K_lds, qr, r32, hi); partialSM<BAND>(pA0, pA1, m_reg, mnA, alA, ubase, uq, L, sl, hi);
  if (2 < NT) SLOAD(SE, 2 * KVBLK);
  SWAIT(); SWRITE(1, SO); __syncthreads();
  for (int j = 1; j + 1 < NT; j += 2) {
    SBAR(); qkt(pB0, pB1, K_lds + SHM_K, qr, r32, hi);
    finishSM(pA0, pA1, alA, l_reg, pa0, pa1, pa2, pa3); SBAR();
    SLOAD(SO, (j + 2) * KVBLK); SBAR();
    pv_d0(o, vb0, pa0, pa1, pa2, pa3); partialSM<BAND>(pB0, pB1, m_reg, mnB, alB, ubase + j * KVBLK, uq, L, sl, hi);
    __syncthreads(); SWAIT(); SWRITE(0, SE);
    RESC(alB); __syncthreads();
    SBAR(); qkt(pA0, pA1, K_lds, qr, r32, hi);
    finishSM(pB0, pB1, alB, l_reg, pa0, pa1, pa2, pa3); SBAR();
    if (j + 3 < NT) SLOAD(SE, (j + 3) * KVBLK); SBAR();
    pv_d0(o, vb0 + (int)SHM_V, pa0, pa1, pa2, pa3); partialSM<BAND>(pA0, pA1, m_reg, mnA, alA, ubase + (j + 1) * KVBLK, uq, L, sl, hi);
    __syncthreads(); SWAIT(); SWRITE(1, SO);
    RESC(alA); __syncthreads();
  }
  SBAR(); qkt(pB0, pB1, K_lds + SHM_K, qr, r32, hi);
  finishSM(pA0, pA1, alA, l_reg, pa0, pa1, pa2, pa3); SBAR();
  pv_d0(o, vb0, pa0, pa1, pa2, pa3); partialSM<BAND>(pB0, pB1, m_reg, mnB, alB, ubase + (NT - 1) * KVBLK, uq, L, sl, hi);
  __syncthreads(); RESC(alB);
  finishSM(pB0, pB1, alB, l_reg, pa0, pa1, pa2, pa3); SBAR();
  pv_d0(o, vb0 + (int)SHM_V, pa0, pa1, pa2, pa3);
  __builtin_amdgcn_s_setprio(0);
  if (hi == 0) li_l[r32] = l_reg; asm volatile("s_waitcnt lgkmcnt(0)" ::: "memory");
  float rli[16];
#pragma unroll
  for (int r = 0; r < 16; ++r) rli[r] = __builtin_amdgcn_rcpf(li_l[crow(r, hi)]);
  if (!do_store) return;
  if constexpr (BAND) {
    if (hi == 0) Lp[(long)(wid * QBLK + r32) * lse_stride] = m_reg * SCALE + __logf(l_reg);
    store_tile_rows(o, rli, lds + EPI_LDS_OFF + wid * 8192, r32, hi, lane, Ob + (long)(wid * QBLK) * rs, rs, nullptr, 0);
  } else {
    bf16_t* Ow = Ob + (long)(wid * QBLK) * YW; const bf16_t* Gw = Gb + (long)(wid * QBLK) * INW;
#pragma unroll
    for (int r = 0; r < 16; ++r) { const long orow = crow(r, hi);
#pragma unroll
      for (int d0 = 0; d0 < 4; ++d0) { const float g = bf2f(Gw[orow * INW + d0 * 32 + r32]);
        Ow[orow * YW + d0 * 32 + r32] = (bf16_t)(cvtpk(o[d0][r] * rli[r] * g, 0.f) & 0xffffu); } }
  }
#undef KROW
#undef SLOAD
#undef SWRITE
#undef SWAIT
#undef RESC
}
}


namespace a8 {
typedef int v8i __attribute__((ext_vector_type(8)));
typedef int v4i __attribute__((ext_vector_type(4)));
constexpr float PSHIFT = 5.f, CAP = 8.75f;
constexpr int TILE_B = 8192;
#define A8_MFMA(a, b, c) __builtin_amdgcn_mfma_scale_f32_32x32x64_f8f6f4((a), (b), (c), 0, 0, 0, 0, 0, 0)
__device__ __forceinline__ v8i cat8(v4i a, v4i b) { return (v8i){a[0], a[1], a[2], a[3], b[0], b[1], b[2], b[3]}; }
__device__ __forceinline__ void partialSM(f32x16& p0, f32x16& p1, float& pm, f32x16& negM, float& alpha) {
  float dmax = p0[0];
#pragma unroll
  for (int r = 1; r < 16; ++r) dmax = fmaxf(dmax, p0[r]);
#pragma unroll
  for (int r = 0; r < 16; ++r) dmax = fmaxf(dmax, p1[r]);
  { auto rr = __builtin_amdgcn_permlane32_swap(__float_as_uint(dmax), __float_as_uint(dmax), false, false);
    dmax = fmaxf(__uint_as_float(rr[0]), __uint_as_float(rr[1])); }
  if (__builtin_expect(__all(dmax <= CAP), 1)) { alpha = 1.f; }
  else { const float delta = fmaxf(dmax - PSHIFT, 0.f); alpha = __builtin_amdgcn_exp2f(-delta); pm += delta;
#pragma unroll
    for (int r = 0; r < 16; ++r) { p0[r] -= delta; p1[r] -= delta; }
    const float nm = -pm;
#pragma unroll
    for (int r = 0; r < 16; ++r) negM[r] = nm; }
#pragma unroll
  for (int r = 0; r < 16; ++r) p0[r] = __builtin_amdgcn_exp2f(p0[r]);
}
__device__ __forceinline__ void finishSM(f32x16& p0, f32x16& p1, v8i& pa) {
#pragma unroll
  for (int r = 0; r < 16; ++r) p1[r] = __builtin_amdgcn_exp2f(p1[r]);
#pragma unroll
  for (int v = 0; v < 4; ++v) { int w = __builtin_amdgcn_cvt_pk_fp8_f32(p0[4 * v], p0[4 * v + 1], 0, false); pa[v] = __builtin_amdgcn_cvt_pk_fp8_f32(p0[4 * v + 2], p0[4 * v + 3], w, true); }
#pragma unroll
  for (int v = 0; v < 4; ++v) { int w = __builtin_amdgcn_cvt_pk_fp8_f32(p1[4 * v], p1[4 * v + 1], 0, false); pa[4 + v] = __builtin_amdgcn_cvt_pk_fp8_f32(p1[4 * v + 2], p1[4 * v + 3], w, true); }
}
__device__ __forceinline__ void qkt(f32x16& p0, f32x16& p1, const f32x16& negM, const char* Ks, v8i q0, v8i q1, int kb, int ko00, int ko01, int ko10, int ko11) {
  const v4i a00 = *(const v4i*)(Ks + kb + ko00), a01 = *(const v4i*)(Ks + kb + ko01), a10 = *(const v4i*)(Ks + kb + ko10), a11 = *(const v4i*)(Ks + kb + ko11);
  const v4i b00 = *(const v4i*)(Ks + 4096 + kb + ko00), b01 = *(const v4i*)(Ks + 4096 + kb + ko01), b10 = *(const v4i*)(Ks + 4096 + kb + ko10), b11 = *(const v4i*)(Ks + 4096 + kb + ko11);
  p0 = A8_MFMA(cat8(a00, a01), q0, negM); p1 = A8_MFMA(cat8(b00, b01), q0, negM);
  p0 = A8_MFMA(cat8(a10, a11), q1, p0); p1 = A8_MFMA(cat8(b10, b11), q1, p1);
}
__device__ __forceinline__ void pv(f32x16* o, const char* Vs, v8i pa, const char* onesp, int vb, int vo0, int vo1) {
  const v8i ones = cat8(*(const v4i*)(onesp), *(const v4i*)(onesp + 16));
  const v4i x0 = *(const v4i*)(Vs + vb + vo0), y0 = *(const v4i*)(Vs + vb + vo1), x1 = *(const v4i*)(Vs + 2048 + vb + vo0), y1 = *(const v4i*)(Vs + 2048 + vb + vo1);
  const v4i x2 = *(const v4i*)(Vs + 4096 + vb + vo0), y2 = *(const v4i*)(Vs + 4096 + vb + vo1), x3 = *(const v4i*)(Vs + 6144 + vb + vo0), y3 = *(const v4i*)(Vs + 6144 + vb + vo1);
  o[4] = A8_MFMA(pa, ones, o[4]);
  o[0] = A8_MFMA(pa, cat8(x0, y0), o[0]); o[1] = A8_MFMA(pa, cat8(x1, y1), o[1]); o[2] = A8_MFMA(pa, cat8(x2, y2), o[2]); o[3] = A8_MFMA(pa, cat8(x3, y3), o[3]);
}
__device__ __forceinline__ void attn_body(const unsigned char* Q8, const unsigned char* K8, const unsigned char* V8T, int NT, bf16_t* Ob, const unsigned char* Gb, char* lds) {
  using at::crow;
  const int tid = fresh_tid(), wid = tid >> 6, lane = tid & 63, r32 = lane & 31, hi = lane >> 5;
  if (__builtin_amdgcn_readfirstlane(wid) >= 4) __builtin_amdgcn_s_setprio(1);
  char* V_lds = lds; char* K_lds = lds + 2 * TILE_B;
  float* al_l = (float*)(lds + 4 * TILE_B) + wid * 32;
  float pm = -PSHIFT; f32x16 o[5] = {}; f32x16 negM;
#pragma unroll
  for (int r = 0; r < 16; ++r) negM[r] = PSHIFT;
  { int t_; asm volatile("v_mov_b32 %0, 0x38383838" : "=v"(t_)); *(int*)(lds + 4 * TILE_B + 1024 + tid * 4) = t_; }
  const char* ones = lds + 4 * TILE_B + 1024 + lane * 32;
  v8i q0, q1;
  { const unsigned char* Qw = Q8 + (long)(wid * 32 + r32) * 1024 + hi * 32;
    q0 = cat8(*(const v4i*)(Qw), *(const v4i*)(Qw + 16)); q1 = cat8(*(const v4i*)(Qw + 64), *(const v4i*)(Qw + 80)); }
  const int kb = r32 * 128, ksw = (r32 >> 1) & 7;
  const int ko00 = ((2 * hi) ^ ksw) << 4, ko01 = ((2 * hi + 1) ^ ksw) << 4, ko10 = ((4 + 2 * hi) ^ ksw) << 4, ko11 = ((5 + 2 * hi) ^ ksw) << 4;
  const int vb = r32 * 64, vsw = (r32 >> 2) & 3, vo0 = ((2 * hi) ^ vsw) << 4, vo1 = ((2 * hi + 1) ^ vsw) << 4;
  const int krow = tid >> 3, kst = krow * 128 + (((tid & 7) ^ ((krow >> 1) & 7)) << 4);
  const int vd = tid >> 2, vst = vd * 64 + (((tid & 3) ^ ((vd >> 2) & 3)) << 4);
  const unsigned char* Kg = K8 + tid * 16; const unsigned char* Vg = V8T + tid * 16;
  struct { v4i k, v; } sr_[2];
#define SLOAD(i, t) do { sr_[i].k = *(const v4i*)(Kg + (long)(t) * TILE_B); sr_[i].v = *(const v4i*)(Vg + (long)(t) * TILE_B); } while (0)
#define SWRITE(b, i) do { *(v4i*)(K_lds + (b) * TILE_B + kst) = sr_[i].k; *(v4i*)(V_lds + (b) * TILE_B + vst) = sr_[i].v; } while (0)
#define SWAIT() asm volatile("s_waitcnt vmcnt(2)" ::: "memory")
#define RESC(a) do { if (__any((a) < 1.f)) { if (hi == 0) al_l[r32] = (a); asm volatile("s_waitcnt lgkmcnt(0)" ::: "memory"); \
    _Pragma("unroll") for (int d = 0; d < 5; ++d) _Pragma("unroll") for (int r = 0; r < 16; ++r) o[d][r] *= al_l[crow(r, hi)]; } } while (0)
  f32x16 pA0, pA1, pB0, pB1; float alA, alB; v8i pa;
  constexpr int SE = 0, SO = 1;
  SLOAD(SE, 0); SLOAD(SO, 1); SWAIT(); SWRITE(0, SE); __syncthreads();
  qkt(pA0, pA1, negM, K_lds, q0, q1, kb, ko00, ko01, ko10, ko11); partialSM(pA0, pA1, pm, negM, alA);
  if (2 < NT) SLOAD(SE, 2);
  SWAIT(); SWRITE(1, SO); __syncthreads();
  for (int j = 1; j + 1 < NT; j += 2) {
    SBAR(); qkt(pB0, pB1, negM, K_lds + TILE_B, q0, q1, kb, ko00, ko01, ko10, ko11);
    finishSM(pA0, pA1, pa); SBAR();
    SLOAD(SO, j + 2); SBAR();
    pv(o, V_lds, pa, ones, vb, vo0, vo1); partialSM(pB0, pB1, pm, negM, alB);
    __syncthreads(); SWAIT(); SWRITE(0, SE);
    RESC(alB); __syncthreads();
    SBAR(); qkt(pA0, pA1, negM, K_lds, q0, q1, kb, ko00, ko01, ko10, ko11);
    finishSM(pB0, pB1, pa); SBAR();
    if (j + 3 < NT) SLOAD(SE, j + 3); SBAR();
    pv(o, V_lds + TILE_B, pa, ones, vb, vo0, vo1); partialSM(pA0, pA1, pm, negM, alA);
    __syncthreads(); SWAIT(); SWRITE(1, SO);
    RESC(alA); __syncthreads();
  }
  SBAR(); qkt(pB0, pB1, negM, K_lds + TILE_B, q0, q1, kb, ko00, ko01, ko10, ko11);
  finishSM(pA0, pA1, pa); SBAR();
  pv(o, V_lds, pa, ones, vb, vo0, vo1); partialSM(pB0, pB1, pm, negM, alB);
  __syncthreads(); RESC(alB);
  finishSM(pB0, pB1, pa); SBAR();
  pv(o, V_lds + TILE_B, pa, ones, vb, vo0, vo1);
  __builtin_amdgcn_s_setprio(0);
  float rli[16];
#pragma unroll
  for (int r = 0; r < 16; ++r) rli[r] = __builtin_amdgcn_rcpf(o[4][r]);
  store_tile_rows(o, rli, lds + EPI_LDS_OFF + wid * 8192, r32, hi, lane, Ob + (long)(wid * 32) * YW, YW, Gb + (long)(wid * 32) * (INW * 2), INW * 2);
#undef SLOAD
#undef SWRITE
#undef SWAIT
#undef RESC
}
}

#if DBG_NAIVE_A || DBG_NAIVE_B
__device__ __forceinline__ void naive_row(const bf16_t* qrow, const bf16_t* Kb, const bf16_t* Vb, long rs, int first, int count, int uc, float sl, int lane, float& m, float& l, float& o0, float& o1) {
  const unsigned qw = *(const unsigned*)(qrow + 2 * lane); const float q0 = bflo(qw), q1 = bfhi(qw);
  m = -1e30f; l = 0.f; o0 = 0.f; o1 = 0.f;
  for (int i = first; i < first + count; ++i) {
    const unsigned kw = *(const unsigned*)(Kb + (long)i * rs + 2 * lane), vw = *(const unsigned*)(Vb + (long)i * rs + 2 * lane);
    float s = q0 * bflo(kw) + q1 * bfhi(kw);
#pragma unroll
    for (int off = 1; off < 64; off <<= 1) s += __shfl_xor(s, off);
    s = s * 0.088388347648318440f - sl * fabsf((float)(i - uc));
    const float mn = fmaxf(m, s), a = __expf(m - mn), p = __expf(s - mn);
    l = l * a + p; o0 = o0 * a + p * bflo(vw); o1 = o1 * a + p * bfhi(vw); m = mn;
  }
}
#endif

#define XB_TMO      128
#define XB_XCNT(j)  (256  + 64 * (j))
#define XB_XSUB(j)  (1280 + 64 * (j))
#define XB_XGEN(j)  (2304 + 64 * (j))
#define XB_TOP      3328
#define XB_TOPGEN   3392
#define XCD_BAR_WORDS 3456
#define XB_SPIN_CAP (1u << 20)
__device__ __forceinline__ unsigned xb_ld(unsigned* p)              { return __hip_atomic_load(p, __ATOMIC_RELAXED, __HIP_MEMORY_SCOPE_AGENT); }
__device__ __forceinline__ unsigned xb_add(unsigned* p, unsigned v) { return __hip_atomic_fetch_add(p, v, __ATOMIC_RELAXED, __HIP_MEMORY_SCOPE_AGENT); }
__device__ __forceinline__ unsigned xb_xcc_id() { return (unsigned)__builtin_amdgcn_s_getreg((3 << 11) | 20) & 0xFu; }
#define XB_SPIN(cond, bar) do { unsigned _sp = 0; while (cond) { __builtin_amdgcn_s_sleep(1); \
    if ((++_sp & 255u) == 0u) { if (xb_ld(&(bar)[XB_TMO])) break; if (_sp > XB_SPIN_CAP) { atomicAdd(&(bar)[XB_TMO], 1u); break; } } } } while (0)
struct XcdBarrier { unsigned* bar; unsigned x; volatile LAS unsigned* st; };
__device__ __forceinline__ XcdBarrier xcd_barrier_post(unsigned* bar, volatile LAS unsigned* st) {
  XcdBarrier b; b.bar = bar; b.x = xb_xcc_id(); b.st = st;
  if (threadIdx.x == 0) (void)xb_add(&bar[XB_XCNT(b.x)], 1u);
  return b;
}
__device__ __forceinline__ void xcd_barrier_complete(unsigned* bar, unsigned x, unsigned& nloc, unsigned& nx) {
  const unsigned G = gridDim.x * gridDim.y * gridDim.z;
  unsigned sum, cnt, mine, sp = 0u;
  for (;;) {
    sum = 0u; cnt = 0u; mine = 0u;
#pragma unroll
    for (unsigned j = 0; j < 16; ++j) { const unsigned c = xb_ld(&bar[XB_XCNT(j)]); sum += c; cnt += (c > 0u) ? 1u : 0u; mine = (j == x) ? c : mine; }
    if (sum == G) break;
    __builtin_amdgcn_s_sleep(1);
    if ((++sp & 255u) == 0u) { if (xb_ld(&bar[XB_TMO])) break; if (sp > XB_SPIN_CAP) { atomicAdd(&bar[XB_TMO], 1u); break; } }
  }
  nloc = mine > 0u ? mine : 1u; nx = cnt > 0u ? cnt : 1u;
}
__device__ __forceinline__ void xcd_barrier(const XcdBarrier& b) {
  asm volatile("s_waitcnt vmcnt(0)" ::: "memory");
  __syncthreads();
  if (threadIdx.x == 0) {
    unsigned* bar = b.bar;
    __builtin_amdgcn_s_waitcnt(0);
    unsigned nloc = b.st[0], nx = b.st[1];
    if (nloc == 0u) { xcd_barrier_complete(bar, b.x, nloc, nx); b.st[0] = nloc; b.st[1] = nx; }
    const unsigned old = xb_add(&bar[XB_XSUB(b.x)], 1u);
    const unsigned gen = old / nloc;
    if (old + 1u == (gen + 1u) * nloc) {
      __builtin_amdgcn_fence(__ATOMIC_RELEASE, "agent");
      asm volatile("s_waitcnt vmcnt(0)" ::: "memory");
      const unsigned og = xb_add(&bar[XB_TOP], 1u);
      const unsigned tg = og / nx;
      if (og + 1u == (tg + 1u) * nx) xb_add(&bar[XB_TOPGEN], 1u);
      else XB_SPIN(xb_ld(&bar[XB_TOPGEN]) == tg, bar);
      __builtin_amdgcn_fence(__ATOMIC_ACQUIRE, "agent");
      xb_add(&bar[XB_XGEN(b.x)], 1u);
      asm volatile("s_waitcnt vmcnt(0)" ::: "memory");
    } else {
      XB_SPIN(xb_ld(&bar[XB_XGEN(b.x)]) == gen, bar);
      __builtin_amdgcn_fence(__ATOMIC_ACQUIRE, "agent");
      asm volatile("s_waitcnt vmcnt(0)" ::: "memory");
    }
  }
  __syncthreads();
}

__device__ __forceinline__ float wave_sum(float v) {
#pragma unroll
  for (int o = 1; o < 64; o <<= 1) v += __shfl_xor(v, o);
  return v;
}
__device__ __forceinline__ void transpose_item(const float* W, int N, bf16_t* WT, int ldt, int koff, LAS float* scr, int item, int lane) {
  const int nblk = N / 32, kb = item / nblk, nb = item % nblk, k0 = 64 * kb, n0 = 32 * nb;
#pragma unroll
  for (int i = 0; i < 8; ++i) { const int kk = 8 * i + (lane >> 3), n4 = (lane & 7) * 4;
    const f32x4 w = *(const f32x4*)(W + (size_t)(k0 + kk) * N + n0 + n4);
    scr[kk * 33 + n4] = w[0]; scr[kk * 33 + n4 + 1] = w[1]; scr[kk * 33 + n4 + 2] = w[2]; scr[kk * 33 + n4 + 3] = w[3]; }
  asm volatile("s_waitcnt lgkmcnt(0)" ::: "memory");
  const int c = lane & 7;
#pragma unroll
  for (int j = 0; j < 4; ++j) { const int n = (lane >> 3) + 8 * j; const LAS float* s = scr + (8 * c) * 33 + n;
    u32x4 o; o.x = cvtpk(s[0 * 33], s[1 * 33]); o.y = cvtpk(s[2 * 33], s[3 * 33]); o.z = cvtpk(s[4 * 33], s[5 * 33]); o.w = cvtpk(s[6 * 33], s[7 * 33]);
    *(u32x4*)(WT + (size_t)(n0 + n) * ldt + koff + k0 + 8 * c) = o; }
  asm volatile("s_waitcnt lgkmcnt(0)" ::: "memory");
}

__device__ __forceinline__ void transpose_item8(const float* W, int N, unsigned char* WT, int ldt, float wscale, LAS float* scr, int item, int lane) {
  const int nblk = N / 32, kb = item / nblk, nb = item % nblk, k0 = 64 * kb, n0 = 32 * nb;
#pragma unroll
  for (int i = 0; i < 8; ++i) { const int kk = 8 * i + (lane >> 3), n4 = (lane & 7) * 4;
    const f32x4 w = *(const f32x4*)(W + (size_t)(k0 + kk) * N + n0 + n4) * wscale;
    scr[kk * 33 + n4] = w[0]; scr[kk * 33 + n4 + 1] = w[1]; scr[kk * 33 + n4 + 2] = w[2]; scr[kk * 33 + n4 + 3] = w[3]; }
  asm volatile("s_waitcnt lgkmcnt(0)" ::: "memory");
  const int c = lane & 7;
#pragma unroll
  for (int j = 0; j < 4; ++j) { const int n = (lane >> 3) + 8 * j; const LAS float* s = scr + (8 * c) * 33 + n;
    u32x2 o; o.x = pk4_fp8(s[0 * 33], s[1 * 33], s[2 * 33], s[3 * 33]); o.y = pk4_fp8(s[4 * 33], s[5 * 33], s[6 * 33], s[7 * 33]);
    *(u32x2*)(WT + (size_t)(n0 + n) * ldt + k0 + 8 * c) = o; }
  asm volatile("s_waitcnt lgkmcnt(0)" ::: "memory");
}
__device__ __forceinline__ void sincos_d(double a, double& s, double& c) {
  const double q = rint(a * 0.63661977236758134308);
  double r = fma(-q, 1.57079632679489655800e+00, a); r = fma(-q, 6.12323399573676603587e-17, r);
  const int qi = ((int)q) & 3; const double r2 = r * r;
  const double sp = r + r * r2 * (-1.0 / 6 + r2 * (1.0 / 120 + r2 * (-1.0 / 5040 + r2 * (1.0 / 362880 + r2 * (-1.0 / 39916800 + r2 * (1.0 / 6227020800.0 + r2 * (-1.0 / 1307674368000.0)))))));
  const double cp = 1.0 + r2 * (-0.5 + r2 * (1.0 / 24 + r2 * (-1.0 / 720 + r2 * (1.0 / 40320 + r2 * (-1.0 / 3628800 + r2 * (1.0 / 479001600 + r2 * (-1.0 / 87178291200.0 + r2 * (1.0 / 20922789888000.0))))))));
  s = (qi == 0) ? sp : (qi == 1) ? cp : (qi == 2) ? -sp : -cp;
  c = (qi == 0) ? cp : (qi == 1) ? -sp : (qi == 2) ? -cp : sp;
}
__device__ __forceinline__ void convert_x(const float* x, bf16_t* xb, int gtid, int gthreads) {
  for (int i = gtid; i < CT * DM / 8; i += gthreads) {
    const f32x4 a = *(const f32x4*)(x + (size_t)i * 8), b = *(const f32x4*)(x + (size_t)i * 8 + 4);
#if USE_FP8_P1
    u32x2 w; w.x = pk4_fp8(a[0], a[1], a[2], a[3]); w.y = pk4_fp8(b[0], b[1], b[2], b[3]);
    *(u32x2*)((unsigned char*)xb + (size_t)i * 8) = w; }
#else
    u32x4 w; w.x = cvtpk(a[0], a[1]); w.y = cvtpk(a[2], a[3]); w.z = cvtpk(b[0], b[1]); w.w = cvtpk(b[2], b[3]);
    *(u32x4*)(xb + (size_t)i * 8) = w; }
#endif
}

__global__ void __launch_bounds__(512, 2) fwd_megakernel(Params p) {
  extern __shared__ __attribute__((aligned(16))) unsigned char smem[];
  cg::grid_group grid = cg::this_grid();
  const int G = gridDim.x, cb = blockIdx.x, NGW = G * 8, gthreads = G * 512;
  volatile LAS unsigned* xst = (volatile LAS unsigned*)((LAS unsigned char*)smem + 131 * 1024);
  if (threadIdx.x == 0) { xst[0] = 0u; xst[1] = 0u; }
  __syncthreads();
  const XcdBarrier xb = xcd_barrier_post((unsigned*)(p.ws + WS_BAR), xst);
#define GSYNC() xcd_barrier(xb)
#define THIN_IDS() const int tid = fresh_tid(), wid = tid >> 6, lane = tid & 63, gw = cb * 8 + wid, gtid = cb * 512 + tid; (void)gw; (void)gtid; (void)lane
  bf16_t* WIN = (bf16_t*)(p.ws + WS_WIN); bf16_t* WAB = (bf16_t*)(p.ws + WS_WAB); bf16_t* WO = (bf16_t*)(p.ws + WS_WO);
  bf16_t* XB = (bf16_t*)(p.ws + WS_XB); bf16_t* T = XB; bf16_t* H = (bf16_t*)(p.ws + WS_H); bf16_t* Y = (bf16_t*)(p.ws + WS_Y);
  unsigned char* Q8 = (unsigned char*)(p.ws + WS_Q8); unsigned char* K8 = (unsigned char*)(p.ws + WS_K8); unsigned char* V8T = (unsigned char*)(p.ws + WS_V8T);
  bf16_t* MRG = (bf16_t*)(p.ws + WS_MRG); float* LSE = (float*)(p.ws + WS_LSE); float* ROPE = (float*)(p.ws + WS_ROPE);

  {
    THIN_IDS();
    LAS float* scr = (LAS float*)((LAS unsigned char*)smem + wid * 8704);
    constexpr int I_IN = (DM / 64) * (INW / 32), I_A = (512 / 64) * (DM / 32), I_B = (DM / 64) * (DM / 32), I_O = I_B, I_L = I_IN + I_A + I_B + I_O;
    for (int it = gw; it < 2 * I_L; it += NGW) {
      const int l = it / I_L; int r = it % I_L;
#if USE_FP8_P1
      if (r < I_IN) { transpose_item8(p.w_in + (size_t)l * DM * INW, INW, (unsigned char*)WIN + (size_t)l * INW * DM, DM, 32.f, scr, r, lane); continue; } r -= I_IN;
#else
      if (r < I_IN) { transpose_item(p.w_in + (size_t)l * DM * INW, INW, WIN + (size_t)l * INW * DM, DM, 0, scr, r, lane); continue; } r -= I_IN;
#endif
      if (r < I_A) { transpose_item(p.w_pa + (size_t)l * 512 * DM, DM, WAB + (size_t)l * DM * YW, YW, 0, scr, r, lane); continue; } r -= I_A;
      if (r < I_B) { transpose_item(p.w_pb + (size_t)l * DM * DM, DM, WAB + (size_t)l * DM * YW, YW, 512, scr, r, lane); continue; } r -= I_B;
      transpose_item(p.w_out + (size_t)l * DM * DM, DM, WO + (size_t)l * DM * DM, DM, 0, scr, r, lane);
    }
    for (int e = cb + G * tid; e < 256 * 32 && tid < (256 * 32 + G - 1) / G; e += gthreads) { const int pos = e >> 5, i = e & 31;
      const float inv = exp2f(-(float)i * (13.287712379549449f / 32.f));
      const float ang = (float)pos * inv; double s, c; sincos_d((double)ang, s, c);
      ROPE[e * 2] = (float)c; ROPE[e * 2 + 1] = (float)s; }
    convert_x(p.x_prompt, XB, gtid, gthreads);
  }
  grid.sync();

#pragma unroll 1
  for (int ch = 0; ch < NCH; ++ch) {
    const int S = (ch < 2) ? 8192 : 16384;
    const float* xin = (ch < 2) ? p.x_prompt + (size_t)ch * CT * DM : p.x_sample;
    float* outc = p.out + (size_t)ch * CT * DM;
#pragma unroll 1
    for (int l = 0; l < DEPTH; ++l) {
#if USE_FP8_P1
      { pg8::SchedStd s; s.nM = CT / 256; s.nN = INW / 256; s.G = G; s.c = cb; s.lda = DM / 2; s.ldb = DM / 2; s.nt = DM / 128; s.A = (const char*)XB; s.B = (const char*)WIN + (size_t)l * INW * DM;
        pg8::EpiIn e; e.H = H; e.bias = p.b_in + (size_t)l * INW; e.ascale = 1.f / 32.f;
        for (int rep = 0; rep < DBG_REP_P1; ++rep) pg8::gemm_phase<pg8::EpiIn, pg8::SchedStd, true>(( LAS unsigned char*)smem, s, e); }
#else
      { pg8::SchedStd s; s.nM = CT / 256; s.nN = INW / 256; s.G = G; s.c = cb; s.lda = DM; s.ldb = DM; s.nt = DM / 64; s.A = (const char*)XB; s.B = (const char*)(WIN + (size_t)l * INW * DM);
        pg8::EpiIn e; e.H = H; e.bias = p.b_in + (size_t)l * INW; e.ascale = 1.f;
        for (int rep = 0; rep < DBG_REP_P1; ++rep) pg8::gemm_phase(( LAS unsigned char*)smem, s, e); }
#endif
      GSYNC();
      {
        { THIN_IDS();
        const float* qg = p.q_gain + l * 128; const float* kg = p.k_gain + l * 128;
        const int l16 = lane & 15;
        for (int idx0 = gw * 4 + (lane >> 4); idx0 < CT * 10; idx0 += NGW * 16) {
          const unsigned char* ptr[4]; u32x2 w[4]; bool ok[4]; int tokk[4], hhk[4];
#pragma unroll
          for (int k = 0; k < 4; ++k) { const int idx = idx0 + k * NGW * 4; ok[k] = idx < CT * 10; const int idc = ok[k] ? idx : idx0;
            tokk[k] = idc / 10; hhk[k] = idc % 10;
            const int boff = (hhk[k] < 8 ? C_BQ * 2 + hhk[k] * 128 : C_BK * 2 + (hhk[k] - 8) * 128) + l16 * 8;
            ptr[k] = (const unsigned char*)H + (size_t)tokk[k] * (INW * 2) + boff; w[k] = *(const u32x2*)ptr[k]; }
#pragma unroll
          for (int k = 0; k < 4; ++k) {
            float v[8]; fp8x4_to_f32(w[k].x, v); fp8x4_to_f32(w[k].y, v + 4);
            float ss = 0.f;
#pragma unroll
            for (int j = 0; j < 8; ++j) ss += v[j] * v[j];
            ss += __shfl_xor(ss, 1); ss += __shfl_xor(ss, 2); ss += __shfl_xor(ss, 4); ss += __shfl_xor(ss, 8);
            const float rms = rsqrtf(ss * (1.f / 128.f) + RMS_EPS);
            const float* gp = (hhk[k] < 8 ? qg : kg) + l16 * 8;
            const int tpos = tokk[k] & (S - 1);
            const int pos = (l16 < 8) ? (tpos >> 6) : (tpos & 63);
            const f32x4* rt = (const f32x4*)(ROPE + ((size_t)pos * 32 + (l16 & 3) * 8) * 2);
            const f32x4 g0 = *(const f32x4*)gp, g1 = *(const f32x4*)(gp + 4);
            const float gg[8] = {g0[0], g0[1], g0[2], g0[3], g1[0], g1[1], g1[2], g1[3]};
            float o[8];
#pragma unroll
            for (int j = 0; j < 8; ++j) v[j] = v[j] * rms * gg[j];
#pragma unroll
            for (int j2 = 0; j2 < 4; ++j2) { const f32x4 cs = rt[j2];
              const float pr0 = __shfl_xor(v[2 * j2], 4), pr1 = __shfl_xor(v[2 * j2 + 1], 4);
              o[2 * j2] = v[2 * j2] * cs[0] + ((l16 & 4) ? pr0 : -pr0) * cs[1];
              o[2 * j2 + 1] = v[2 * j2 + 1] * cs[2] + ((l16 & 4) ? pr1 : -pr1) * cs[3]; }
            u32x4 wo; wo.x = cvtpk(o[0], o[1]); wo.y = cvtpk(o[2], o[3]); wo.z = cvtpk(o[4], o[5]); wo.w = cvtpk(o[6], o[7]);
            if (ok[k]) {
#if USE_FP8_B
#pragma unroll
              for (int j = 0; j < 8; ++j) o[j] *= 0.35709583f;
              u32x2 w8; int t0 = __builtin_amdgcn_cvt_pk_fp8_f32(o[0], o[1], 0, false); w8.x = (unsigned)__builtin_amdgcn_cvt_pk_fp8_f32(o[2], o[3], t0, true);
              int t1 = __builtin_amdgcn_cvt_pk_fp8_f32(o[4], o[5], 0, false); w8.y = (unsigned)__builtin_amdgcn_cvt_pk_fp8_f32(o[6], o[7], t1, true);
              unsigned char* d8 = (hhk[k] < 8) ? Q8 + (size_t)tokk[k] * 1024 + hhk[k] * 128 + l16 * 8 : K8 + ((size_t)(hhk[k] - 8) * CT + tokk[k]) * 128 + l16 * 8;
              *(u32x2*)d8 = w8;
#else
              (void)wo;
#endif
            }
          }
        } }
#if USE_FP8_B
        { THIN_IDS();
          const int kk = lane & 31, khi = (kk >> 2) & 1, slot = khi * 32 + (kk & 3) + 4 * (kk >> 3) + 16 * (lane >> 5);
          for (int it = gw; it < 2 * (CT / 64); it += NGW) {
            const int kvh = it / (CT / 64), tl = it % (CT / 64);
            const unsigned char* vrow = (const unsigned char*)H + (size_t)(tl * 64 + lane) * (INW * 2) + C_BV * 2 + kvh * 128;
            unsigned char* dst = V8T + ((size_t)(kvh * (CT / 64) + tl) * 128) * 64 + slot;
#pragma unroll 4
            for (int d8 = 0; d8 < 16; ++d8) { const u32x2 w = *(const u32x2*)(vrow + d8 * 8);
#pragma unroll
              for (int j = 0; j < 8; ++j) dst[(d8 * 8 + j) * 64] = (unsigned char)(((j < 4 ? w.x : w.y) >> (8 * (j & 3))) & 0xff); }
          } }
#endif
#if DBG_NAIVE_A
        { THIN_IDS();
          for (int idx = gw; idx < CT * 12; idx += NGW) {
            const int tok = idx / 12, gh = idx % 12, g = gh >> 2;
            const int dil = (g == 0) ? 1 : (g == 1) ? 4 : 16, L = S / dil;
            const int seq = tok / S, tp = tok % S, r = tp % dil, u = tp / dil;
            const float slope = exp2f(-8.f * (float)(gh + 1) / 12.f);
            const size_t tok0 = (size_t)seq * S + r; const long rs = (long)dil * INW;
            bf16_t* qrow = H + (size_t)tok * INW + C_AQ + gh * 128;
            const int first = max(u - 64, 0), last = min(u + 64, L - 1);
            float m, l, o0, o1;
            naive_row(qrow, H + tok0 * INW + C_AK + gh * 128, H + tok0 * INW + C_AV + gh * 128, rs, first, last - first + 1, u, slope * (float)dil, lane, m, l, o0, o1);
            *(unsigned*)(qrow + 2 * lane) = cvtpk(o0 / l, o1 / l);
            if (lane == 0) LSE[(size_t)tok * 12 + gh] = m + __logf(l);
          } }
        for (int it = 64 * 12; it < 64 * 12; it += G) {
#else
        for (int rep = 0; rep < DBG_REP_A; ++rep)
        for (int it = cb; it < 64 * 12; it += G) {
#endif
          const int bi = it / 12, gh = it % 12, g = gh >> 2, hs = gh & 3;
          const int dil = (g == 0) ? 1 : (g == 1) ? 4 : 16, L = S / dil, bpc = L / 256;
          const int bps = S / 256, seq = bi / bps, w = bi % bps, r = w / bpc, u0 = (w % bpc) * 256;
          const float slope = exp2f(-8.f * (float)(gh + 1) / 12.f);
          const float sl = slope * (float)dil / at::SCALE;
          const size_t tok0 = (size_t)seq * S + r;
          bf16_t* Qh = H + tok0 * INW + C_AQ + gh * 128;
          const bf16_t* Kh = H + tok0 * INW + C_AK + gh * 128; const bf16_t* Vh = H + tok0 * INW + C_AV + gh * 128;
          const long rs = (long)dil * INW;
          __syncthreads();
          at::attn_body<true>(Qh + (long)u0 * rs, Kh, Vh, rs, 6, u0 - 64, u0, L, sl, Qh + (long)u0 * rs, nullptr,
                              LSE + (tok0 + (size_t)u0 * dil) * 12 + gh, (long)dil * 12, (char*)smem, rep == DBG_REP_A - 1);
        }
      }
      GSYNC();
      {
        const int bps = S / 256;
#if DBG_NAIVE_B
        { THIN_IDS();
          for (int idx = gw; idx < CT * 8; idx += NGW) {
            const int tok = idx >> 3, h = idx & 7, seq = tok / S; const size_t tok0 = (size_t)seq * S;
            float m, l, o0, o1;
            naive_row(H + (size_t)tok * INW + C_BQ + h * 128, H + tok0 * INW + C_BK + (h >> 2) * 128, H + tok0 * INW + C_BV + (h >> 2) * 128, (long)INW, 0, S, 0, 0.f, lane, m, l, o0, o1);
            const unsigned gw_ = *(const unsigned*)(H + (size_t)tok * INW + C_BG + h * 128 + 2 * lane);
            *(unsigned*)(Y + (size_t)tok * YW + 512 + h * 128 + 2 * lane) = cvtpk(o0 / l * bflo(gw_), o1 / l * bfhi(gw_));
          } }
        for (int it = 64 * 8; it < 64 * 8; it += G) {
#else
        for (int rep = 0; rep < DBG_REP_B; ++rep)
        for (int it = cb; it < 64 * 8; it += G) {
#endif
          int qb, h, seq;
          if (G == 256) {
            const int x = cb & 7, idx = (x >> 1) * 64 + (cb >> 3) * 2 + (it >> 8), qblk = idx & 63;
            h = (x & 1) * 4 + (idx >> 6); seq = qblk / bps; qb = qblk % bps;
          } else { qb = it % bps; const int sh = it / bps; h = sh & 7; seq = sh >> 3; }
          const size_t tok0 = (size_t)seq * S, row0 = tok0 + (size_t)qb * 256;
#if DBG_NO_B
          { const int t_ = fresh_tid(); for (int e = t_; e < 256 * 16; e += 512) { u32x4 z = {0u, 0u, 0u, 0u}; *(u32x4*)(Y + (row0 + (e >> 4)) * YW + 512 + h * 128 + (e & 15) * 8) = z; } }
#else
          __syncthreads();
#if USE_FP8_B
          a8::attn_body(Q8 + row0 * 1024 + h * 128, K8 + ((size_t)(h >> 2) * CT + tok0) * 128, V8T + ((size_t)(h >> 2) * (CT / 64) + tok0 / 64) * 8192, S / 64,
                        Y + row0 * YW + 512 + h * 128, (const unsigned char*)H + row0 * (INW * 2) + C_BG * 2 + h * 128, (char*)smem);
#else
          at::attn_body<false>(H + row0 * INW + C_BQ + h * 128, H + tok0 * INW + C_BK + (h >> 2) * 128, H + tok0 * INW + C_BV + (h >> 2) * 128, (long)INW, S / 64,
                               0, 0, 0, 0.f, Y + row0 * YW + 512 + h * 128, H + row0 * INW + C_BG + h * 128, nullptr, 0, (char*)smem);
#endif
#endif
        }
        THIN_IDS();
        const int l16 = lane & 15;
        for (int rep = 0; rep < DBG_REP_C; ++rep)
        for (int idx0 = gw * 4 + (lane >> 4); idx0 < CT * 4; idx0 += NGW * 16) {
          float l0[4], l1[4], l2[4]; u32x4 a[4], b[4], c[4], gt[4]; int tokk[4], hsk[4]; bool ok[4];
#pragma unroll
          for (int k = 0; k < 4; ++k) { const int idx = idx0 + k * NGW * 4; ok[k] = idx < CT * 4; const int idc = ok[k] ? idx : idx0; tokk[k] = idc >> 2; hsk[k] = idc & 3;
            const float* lp = LSE + (size_t)tokk[k] * 12 + hsk[k]; l0[k] = lp[0]; l1[k] = lp[4]; l2[k] = lp[8];
            const bf16_t* hp = H + (size_t)tokk[k] * INW + hsk[k] * 128 + l16 * 8;
            a[k] = *(const u32x4*)(hp); b[k] = *(const u32x4*)(hp + 512); c[k] = *(const u32x4*)(hp + 1024); gt[k] = *(const u32x4*)(hp + C_AG); }
#pragma unroll
          for (int k = 0; k < 4; ++k) {
            const float mx = fmaxf(l0[k], fmaxf(l1[k], l2[k]));
            float e0 = __expf(l0[k] - mx), e1 = __expf(l1[k] - mx), e2 = __expf(l2[k] - mx);
            const float inv = 1.f / (e0 + e1 + e2); e0 *= inv; e1 *= inv; e2 *= inv;
            float o[8];
#define CMB(j, W, HL) o[j] = (e0 * HL(a[k].W) + e1 * HL(b[k].W) + e2 * HL(c[k].W)) * HL(gt[k].W)
            CMB(0, x, bflo); CMB(1, x, bfhi); CMB(2, y, bflo); CMB(3, y, bfhi); CMB(4, z, bflo); CMB(5, z, bfhi); CMB(6, w, bflo); CMB(7, w, bfhi);
#undef CMB
            u32x4 wo; wo.x = cvtpk(o[0], o[1]); wo.y = cvtpk(o[2], o[3]); wo.z = cvtpk(o[4], o[5]); wo.w = cvtpk(o[6], o[7]);
            if (ok[k]) *(u32x4*)(Y + (size_t)tokk[k] * YW + hsk[k] * 128 + l16 * 8) = wo;
          }
        }
      }
      GSYNC();
      { pg8::SchedMerge s; s.nM = CT / 256; s.nN = DM / 256; s.G = G; s.c = cb; s.lda = YW; s.ldb = YW; s.A = (const char*)Y; s.B = (const char*)(WAB + (size_t)l * DM * YW);
        pg8::EpiMerge e; e.H = H; e.T = T; e.MRG = MRG;
        for (int rep = 0; rep < DBG_REP_P4; ++rep) pg8::gemm_phase((LAS unsigned char*)smem, s, e); }
      GSYNC();
#if USE_LN_FUSED
      if (G == 256) {
      { pg8::SchedStd s; s.nM = CT / 256; s.nN = DM / 256; s.G = G; s.c = cb; s.lda = DM; s.ldb = DM; s.nt = DM / 64; s.A = (const char*)MRG; s.B = (const char*)(WO + (size_t)l * DM * DM);
        pg8::EpiLN e; e.X = (l == 0) ? xin : (const float*)outc; e.Yo = outc; e.XB8 = (unsigned char*)XB; e.g = p.ln_g + l * DM; e.b = p.ln_b + l * DM;
        e.slots = (unsigned long long*)(p.ws + WS_LNX); e.cnt = (unsigned*)(p.ws + WS_LNC) + (size_t)(ch * DEPTH + l) * 64 * 64; e.write_xb = (l == 0);
        pg8::gemm_phase((LAS unsigned char*)smem, s, e); }
      if (l == DEPTH - 1 && ch + 1 < NCH) { THIN_IDS(); convert_x((ch + 1 < 2) ? p.x_prompt + (size_t)(ch + 1) * CT * DM : p.x_sample, XB, gtid, gthreads); }
      GSYNC();
      } else
#endif
      {
      { pg8::SchedStd s; s.nM = CT / 256; s.nN = DM / 256; s.G = G; s.c = cb; s.lda = DM; s.ldb = DM; s.nt = DM / 64; s.A = (const char*)MRG; s.B = (const char*)(WO + (size_t)l * DM * DM);
        pg8::EpiOut e; e.X = (l == 0) ? xin : (const float*)outc; e.Z = outc;
        pg8::gemm_phase((LAS unsigned char*)smem, s, e); }
      GSYNC();
      {
        THIN_IDS();
        const float* gmm = p.ln_g + l * DM; const float* bta = p.ln_b + l * DM;
        f32x4 gv[4], bv[4];
#pragma unroll
        for (int j = 0; j < 4; ++j) { gv[j] = *(const f32x4*)(gmm + (j * 64 + lane) * 4); bv[j] = *(const f32x4*)(bta + (j * 64 + lane) * 4); }
        for (int row0 = gw; row0 < CT; row0 += NGW * 4) {
          f32x4 v[4][4];
#pragma unroll
          for (int k = 0; k < 4; ++k) { const int row = min(row0 + k * NGW, CT - 1); const float* zr = outc + (size_t)row * DM;
#pragma unroll
            for (int j = 0; j < 4; ++j) v[k][j] = *(const f32x4*)(zr + (j * 64 + lane) * 4); }
#pragma unroll
          for (int k = 0; k < 4; ++k) { const int row = row0 + k * NGW; float* zr = outc + (size_t)min(row, CT - 1) * DM;
            float s = 0.f;
#pragma unroll
            for (int j = 0; j < 4; ++j) s += (v[k][j][0] + v[k][j][1]) + (v[k][j][2] + v[k][j][3]);
            const float mean = wave_sum(s) * (1.f / DM); float s2 = 0.f;
#pragma unroll
            for (int j = 0; j < 4; ++j) { v[k][j] = v[k][j] - mean; s2 += (v[k][j][0] * v[k][j][0] + v[k][j][1] * v[k][j][1]) + (v[k][j][2] * v[k][j][2] + v[k][j][3] * v[k][j][3]); }
            const float rstd = rsqrtf(wave_sum(s2) * (1.f / DM) + LN_EPS);
            if (row < CT) {
#pragma unroll
              for (int j = 0; j < 4; ++j) { const f32x4 y = v[k][j] * rstd * gv[j] + bv[j]; *(f32x4*)(zr + (j * 64 + lane) * 4) = y;
#if USE_FP8_P1
                if (l == 0) *(unsigned*)((unsigned char*)XB + (size_t)row * DM + (j * 64 + lane) * 4) = pk4_fp8(y[0], y[1], y[2], y[3]); } }
#else
                if (l == 0) { u32x2 w; w.x = cvtpk(y[0], y[1]); w.y = cvtpk(y[2], y[3]); *(u32x2*)(XB + (size_t)row * DM + (j * 64 + lane) * 4) = w; } } }
#endif
          }
        }
        if (l == DEPTH - 1 && ch + 1 < NCH) convert_x((ch + 1 < 2) ? p.x_prompt + (size_t)(ch + 1) * CT * DM : p.x_sample, XB, gtid, gthreads);
      }
      GSYNC();
      }
    }
  }
}

extern "C" void kernel_launch(void* const* d_in, const int* in_sizes, int n_in, void* d_out, int out_size, void* d_ws, size_t ws_size, hipStream_t stream) {
  static int grid_blocks = 0;
  if (grid_blocks == 0) {
    if (n_in != 11 || out_size != NCH * CT * DM || ws_size < WS_END) { fprintf(stderr, "kernel_launch: unexpected shapes n_in %d out %d ws %zu (need %zu)\n", n_in, out_size, ws_size, (size_t)WS_END); grid_blocks = -1; return; }
    int dev = 0, cus = 0, per_cu = 0;
    hipGetDevice(&dev);
    hipDeviceGetAttribute(&cus, hipDeviceAttributeMultiprocessorCount, dev);
    if (hipFuncSetAttribute((const void*)fwd_megakernel, hipFuncAttributeMaxDynamicSharedMemorySize, LDS_BYTES) != hipSuccess) { fprintf(stderr, "kernel_launch: hipFuncSetAttribute failed\n"); grid_blocks = -1; return; }
    hipOccupancyMaxActiveBlocksPerMultiprocessor(&per_cu, (const void*)fwd_megakernel, 512, LDS_BYTES);
    if (per_cu < 1) { fprintf(stderr, "kernel_launch: occupancy query says %d blocks per CU\n", per_cu); per_cu = 1; }
    (void)hipGetLastError();
    grid_blocks = cus;
  }
  if (grid_blocks < 0) return;
  Params p{};
  p.x_prompt = (const float*)d_in[0]; p.x_sample = (const float*)d_in[1]; p.w_in = (const float*)d_in[2]; p.b_in = (const float*)d_in[3];
  p.q_gain = (const float*)d_in[4]; p.k_gain = (const float*)d_in[5]; p.w_pa = (const float*)d_in[6]; p.w_pb = (const float*)d_in[7];
  p.w_out = (const float*)d_in[8]; p.ln_g = (const float*)d_in[9]; p.ln_b = (const float*)d_in[10];
  p.out = (float*)d_out; p.ws = (char*)d_ws;
  if (hipMemsetAsync((char*)d_ws + WS_BAR, 0, WS_ZERO_END - WS_BAR, stream) != hipSuccess) { fprintf(stderr, "kernel_launch: memset of the barrier words failed\n"); return; }
  void* args[] = {&p};
  hipError_t e = hipLaunchCooperativeKernel((const void*)fwd_megakernel, dim3(grid_blocks), dim3(512), args, LDS_BYTES, stream);
  if (e != hipSuccess) fprintf(stderr, "cooperative launch failed: %s (grid %d)\n", hipGetErrorString(e), grid_blocks);
}
```

```cpp
#include <hip/hip_runtime.h>
#include <hip/hip_cooperative_groups.h>
#include <cstdio>
#include <cstdint>
namespace cg = cooperative_groups;

#define LAS __attribute__((address_space(3)))
typedef unsigned short bf16_t;
typedef short bf16x8 __attribute__((ext_vector_type(8)));
typedef short s16x4 __attribute__((ext_vector_type(4)));
typedef float f32x4 __attribute__((ext_vector_type(4)));
typedef float f32x16 __attribute__((ext_vector_type(16)));
typedef unsigned u32x4 __attribute__((ext_vector_type(4)));
typedef unsigned u32x2 __attribute__((ext_vector_type(2)));
typedef int v4i_t __attribute__((ext_vector_type(4)));
typedef int v8i_t __attribute__((ext_vector_type(8)));

constexpr int DM = 1024, INW = 9728, CT = 16384, NCH = 3, DEPTH = 2;
constexpr int C_AQ = 0, C_AK = 1536, C_AV = 3072, C_AG = 4608, C_BQ = 5120, C_BK = 6144, C_BV = 6400, C_BG = 6656, C_GA = 7680, C_GB = 8704;
constexpr int YW = 1536;
constexpr float ALPHA = 1.41421356237309515f;
constexpr float RMS_EPS = 1e-6f, LN_EPS = 1e-5f;
constexpr size_t WS_WIN = 0;
constexpr size_t WS_WAB = WS_WIN + (size_t)2 * INW * DM * 2;
constexpr size_t WS_WO  = WS_WAB + (size_t)2 * DM * YW * 2;
constexpr size_t WS_XB  = WS_WO + (size_t)2 * DM * DM * 2;
constexpr size_t WS_H   = WS_XB + (size_t)CT * DM * 2;
constexpr size_t WS_Y   = WS_H + (size_t)CT * INW * 2;
constexpr size_t WS_MRG = WS_Y + (size_t)CT * YW * 2;
constexpr size_t WS_LSE = WS_MRG + (size_t)CT * DM * 2;
constexpr size_t WS_ROPE = WS_LSE + (size_t)CT * 12 * 4;
constexpr size_t WS_BAR = WS_ROPE + 256 * 32 * 2 * 4;
constexpr size_t WS_LNC = (WS_BAR + 3456 * 4 + 255) / 256 * 256;
constexpr size_t WS_ZERO_END = WS_LNC + (size_t)6 * 64 * 64 * 4;
constexpr size_t WS_LNX = WS_ZERO_END;
constexpr size_t WS_Q8  = (WS_LNX + (size_t)CT * 4 * 8 + 255) / 256 * 256;
constexpr size_t WS_K8  = WS_Q8 + (size_t)CT * 1024;
constexpr size_t WS_V8T = WS_K8 + (size_t)2 * CT * 128;
constexpr size_t WS_END = WS_V8T + (size_t)2 * CT * 128;
constexpr int LDS_BYTES = 132 * 1024;
#ifndef USE_LN_FUSED
#define USE_LN_FUSED 1
#endif
#ifndef USE_FP8_P1
#define USE_FP8_P1 1
#endif
#ifndef USE_FP8_B
#define USE_FP8_B 1
#endif
#ifndef DBG_UNIFORM
#define DBG_UNIFORM 0
#endif
#ifndef DBG_NAIVE_A
#define DBG_NAIVE_A 0
#endif
#ifndef DBG_NAIVE_B
#define DBG_NAIVE_B 0
#endif
#ifndef DBG_REP_A
#define DBG_REP_A 1
#endif
#ifndef DBG_REP_P4
#define DBG_REP_P4 1
#endif
#ifndef DBG_REP_C
#define DBG_REP_C 1
#endif
#ifndef DBG_REP_P1
#define DBG_REP_P1 1
#endif
#ifndef DBG_REP_B
#define DBG_REP_B 1
#endif
#ifndef DBG_NO_B
#define DBG_NO_B 0
#endif

struct Params {
  const float *x_prompt, *x_sample, *w_in, *b_in, *q_gain, *k_gain, *w_pa, *w_pb, *w_out, *ln_g, *ln_b;
  float* out; char* ws;
};

__device__ __forceinline__ int fresh_tid() { int t = threadIdx.x; asm volatile("" : "+v"(t)); return t; }
__device__ __forceinline__ unsigned cvtpk(float lo, float hi) { unsigned r; asm volatile("v_cvt_pk_bf16_f32 %0, %1, %2" : "=v"(r) : "v"(lo), "v"(hi)); return r; }
__device__ __forceinline__ float bflo(unsigned w) { return __uint_as_float(w << 16); }
__device__ __forceinline__ float bfhi(unsigned w) { return __uint_as_float(w & 0xffff0000u); }
__device__ __forceinline__ float bf2f(bf16_t b) { return __uint_as_float(((unsigned)b) << 16); }
__device__ __forceinline__ unsigned pk4_fp8(float a, float b, float c, float d) { const int t = __builtin_amdgcn_cvt_pk_fp8_f32(a, b, 0, false); return (unsigned)__builtin_amdgcn_cvt_pk_fp8_f32(c, d, t, true); }
typedef float f32x2_t __attribute__((ext_vector_type(2)));
__device__ __forceinline__ void fp8x4_to_f32(unsigned w, float* o) { const f32x2_t lo = __builtin_amdgcn_cvt_pk_f32_fp8((int)w, false), hi = __builtin_amdgcn_cvt_pk_f32_fp8((int)w, true); o[0] = lo[0]; o[1] = lo[1]; o[2] = hi[0]; o[3] = hi[1]; }
__device__ __forceinline__ float sigmoidf_(float x) { return __builtin_amdgcn_rcpf(1.f + __builtin_amdgcn_exp2f(-1.4426950408889634f * x)); }

namespace pg8 {
constexpr int BM = 256, BK = 64, HALF = 128, HTB = HALF * BK * 2, STAGE_BYTES = 8 * HTB, NXCD = 8, WGM = 4;
__device__ __forceinline__ int lds_byte(int r, int c) { const int st = (r >> 4) * 2 + (c >> 5), rr = r & 15, cc = c & 31, ob = rr * 64 + cc * 2; return st * 1024 + (ob ^ (((ob >> 9) & 1) << 5)); }
__device__ __forceinline__ void stage_rc(int b, int& R, int& C) { const int st = b / 1024, sb = b % 1024, swz = sb ^ (((sb >> 9) & 1) << 5); R = (st >> 1) * 16 + swz / 64; C = (st & 1) * 32 + (swz % 64) / 2; }
__device__ __forceinline__ int perm32(int rho) { const int n = rho >> 4, i = rho & 15; return 8 * (i >> 2) + 4 * n + (i & 3); }
struct Unit { int pm, pn, kind; };
__device__ __forceinline__ bool tile_of(int L, int nM, int nN, int& pm, int& pn) {
  const int nwg = nM * nN; if (L >= nwg) return false;
  int wgid = L; { const int q = nwg / NXCD, r = nwg % NXCD, xcd = wgid % NXCD, off = wgid / NXCD; wgid = (xcd < r ? xcd * (q + 1) : r * (q + 1) + (xcd - r) * q) + off; }
  const int nig = WGM * nN, gid = wgid / nig, fm = gid * WGM, gsz = (nM - fm) < WGM ? (nM - fm) : WGM;
  pm = fm + ((wgid % nig) % gsz); pn = (wgid % nig) / gsz; return true;
}
struct SchedStd {
  int nM, nN, G, c, lda, ldb, nt; const char *A, *B;
  __device__ __forceinline__ bool next(int i, Unit& u) const { u.kind = 0; return tile_of(i * G + c, nM, nN, u.pm, u.pn); }
  __device__ __forceinline__ void op(const Unit& u, const char*& a, const char*& b, int& n) const { a = A + (size_t)u.pm * BM * lda * 2; b = B + (size_t)u.pn * BM * ldb * 2; n = nt; }
};
struct SchedMerge {
  int nM, nN, G, c, lda, ldb; const char *A, *B;
  __device__ __forceinline__ bool next(int i, Unit& u) const { u.kind = i & 1; return tile_of((i >> 1) * G + c, nM, nN, u.pm, u.pn); }
  __device__ __forceinline__ void op(const Unit& u, const char*& a, const char*& b, int& n) const {
    a = A + (size_t)u.pm * BM * lda * 2 + (u.kind ? 1024 : 0); b = B + (size_t)u.pn * BM * ldb * 2 + (u.kind ? 1024 : 0); n = u.kind ? 16 : 8; }
};

struct EpiIn {
  static __device__ __forceinline__ bool keep_acc(const Unit&) { return false; }
  static constexpr bool AFTER_DRAIN = false;
  static constexpr bool PERM = true;
  bf16_t* H; const float* bias; float ascale;
  __device__ __forceinline__ void operator()(const f32x4 (&acc)[2][2][4][2], const Unit& u, int wr, int wc, int fr, int fq) const {
    const int row0 = u.pm * BM + wr * 64 + fr, col0 = u.pn * BM + wc * 32 + 8 * fq;
    const int act = (u.pn >= 30) ? 2 : (((u.pn >= 18 && u.pn < 20) || (u.pn >= 26)) ? 1 : 0);
    const bool f8 = (u.pn >= 20 && u.pn < 30) || (u.pn >= 34);
    const int fs = (u.pn < 24) ? C_BQ : (u.pn == 24) ? C_BK : (u.pn == 25) ? C_BV : (u.pn < 30) ? C_BG : C_GB;
    f32x4 bv[2][2];
#pragma unroll
    for (int bj = 0; bj < 2; ++bj)
#pragma unroll
      for (int n = 0; n < 2; ++n) bv[bj][n] = *(const f32x4*)(bias + col0 + bj * HALF + 4 * n);
#pragma unroll
    for (int ai = 0; ai < 2; ++ai)
#pragma unroll
      for (int m = 0; m < 4; ++m) { bf16_t* rowp = H + (size_t)(row0 + ai * HALF + m * 16) * INW + col0;
#pragma unroll
        for (int bj = 0; bj < 2; ++bj) { f32x4 v0 = acc[ai][bj][m][0] * ascale + bv[bj][0], v1 = acc[ai][bj][m][1] * ascale + bv[bj][1];
          if (act) {
#pragma unroll
            for (int j = 0; j < 4; ++j) { const float s0 = sigmoidf_(v0[j]), s1 = sigmoidf_(v1[j]); v0[j] = (act == 1) ? v0[j] * s0 : s0; v1[j] = (act == 1) ? v1[j] * s1 : s1; } }
          if (f8) { u32x2 w8; w8.x = pk4_fp8(v0[0], v0[1], v0[2], v0[3]); w8.y = pk4_fp8(v1[0], v1[1], v1[2], v1[3]);
            *(u32x2*)((unsigned char*)H + (size_t)(row0 + ai * HALF + m * 16) * (INW * 2) + fs * 2 + (col0 - fs) + bj * HALF) = w8; }
          else { u32x4 w; w.x = cvtpk(v0[0], v0[1]); w.y = cvtpk(v0[2], v0[3]); w.z = cvtpk(v1[0], v1[1]); w.w = cvtpk(v1[2], v1[3]);
            *(u32x4*)(rowp + bj * HALF) = w; } } }
  }
};
struct EpiMerge {
  static constexpr bool AFTER_DRAIN = false;
  static constexpr bool PERM = true;
  const bf16_t* H; bf16_t* T; bf16_t* MRG;
  static __device__ __forceinline__ bool keep_acc(const Unit& u) { return u.kind == 0; }
  __device__ __forceinline__ void operator()(f32x4 (&acc)[2][2][4][2], const Unit& u, int wr, int wc, int fr, int fq) const {
    const int row0 = u.pm * BM + wr * 64 + fr, col0 = u.pn * BM + wc * 32 + 8 * fq;
#pragma unroll
    for (int ai = 0; ai < 2; ++ai)
#pragma unroll
      for (int m = 0; m < 4; ++m) { const size_t row = (size_t)(row0 + ai * HALF + m * 16);
#pragma unroll
        for (int bj = 0; bj < 2; ++bj) {
          float gb[8];
          { const u32x2 g8 = *(const u32x2*)((const unsigned char*)H + row * (INW * 2) + C_GB * 2 + col0 + bj * HALF); fp8x4_to_f32(g8.x, gb); fp8x4_to_f32(g8.y, gb + 4); }
#pragma unroll
          for (int j = 0; j < 8; ++j) gb[j] = fmaxf(gb[j], 9.765625e-4f);
          if (u.kind == 0) {
            const u32x4 g = *(const u32x4*)(H + row * INW + C_GA + col0 + bj * HALF);
            const float ga[8] = {bflo(g.x), bfhi(g.x), bflo(g.y), bfhi(g.y), bflo(g.z), bfhi(g.z), bflo(g.w), bfhi(g.w)};
#pragma unroll
            for (int j = 0; j < 4; ++j) { acc[ai][bj][m][0][j] *= ga[j] * __builtin_amdgcn_rcpf(gb[j]); acc[ai][bj][m][1][j] *= ga[4 + j] * __builtin_amdgcn_rcpf(gb[4 + j]); }
          } else {
            const f32x4 a0 = acc[ai][bj][m][0], a1 = acc[ai][bj][m][1];
            u32x4 w; w.x = cvtpk(a0[0] * gb[0], a0[1] * gb[1]); w.y = cvtpk(a0[2] * gb[2], a0[3] * gb[3]); w.z = cvtpk(a1[0] * gb[4], a1[1] * gb[5]); w.w = cvtpk(a1[2] * gb[6], a1[3] * gb[7]);
            *(u32x4*)(MRG + row * DM + col0 + bj * HALF) = w; } } }
  }
};
struct EpiOut {
  static __device__ __forceinline__ bool keep_acc(const Unit&) { return false; }
  static constexpr bool AFTER_DRAIN = false;
  static constexpr bool PERM = true;
  const float* X; float* Z;
  __device__ __forceinline__ void operator()(const f32x4 (&acc)[2][2][4][2], const Unit& u, int wr, int wc, int fr, int fq) const {
    const int row0 = u.pm * BM + wr * 64 + fr, col0 = u.pn * BM + wc * 32 + 8 * fq;
#pragma unroll
    for (int ai = 0; ai < 2; ++ai)
#pragma unroll
      for (int m = 0; m < 4; ++m) { const size_t off = (size_t)(row0 + ai * HALF + m * 16) * DM + col0;
#pragma unroll
        for (int bj = 0; bj < 2; ++bj)
#pragma unroll
          for (int n = 0; n < 2; ++n) { const f32x4 xv = *(const f32x4*)(X + off + bj * HALF + n * 4); *(f32x4*)(Z + off + bj * HALF + n * 4) = xv * ALPHA + acc[ai][bj][m][n]; } }
  }
};


struct EpiLN {
  static __device__ __forceinline__ bool keep_acc(const Unit&) { return false; }
  static constexpr bool PERM = true, AFTER_DRAIN = true;
  const float* X; float* Yo; unsigned char* XB8; const float* g; const float* b; unsigned long long* slots; unsigned* cnt; int write_xb;
  __device__ __forceinline__ void fused(f32x4 (&acc)[2][2][4][2], const Unit& u, int wr, int wc, int fr, int fq, LAS unsigned char* lds, int wid, int lane) const {
    typedef float f32x2v __attribute__((ext_vector_type(2)));
    LAS f32x2v* P = (LAS f32x2v*)lds;
    LAS f32x2v* S = (LAS f32x2v*)(lds + 8192);
    const int col0 = u.pn * BM + wc * 32 + 8 * fq;
#pragma unroll
    for (int ai = 0; ai < 2; ++ai)
#pragma unroll
      for (int m = 0; m < 4; ++m) { const int rl = ai * HALF + wr * 64 + m * 16 + fr; const size_t off = (size_t)(u.pm * BM + rl) * DM + col0;
        float s1 = 0.f, s2 = 0.f;
#pragma unroll
        for (int bj = 0; bj < 2; ++bj)
#pragma unroll
          for (int n = 0; n < 2; ++n) { const f32x4 xv = *(const f32x4*)(X + off + bj * HALF + n * 4); const f32x4 z = xv * ALPHA + acc[ai][bj][m][n]; acc[ai][bj][m][n] = z;
            s1 += (z[0] + z[1]) + (z[2] + z[3]); s2 += (z[0] * z[0] + z[1] * z[1]) + (z[2] * z[2] + z[3] * z[3]); }
        s1 += __shfl_xor(s1, 16); s1 += __shfl_xor(s1, 32); s2 += __shfl_xor(s2, 16); s2 += __shfl_xor(s2, 32);
        if (fq == 0) P[rl * 4 + wc] = (f32x2v){s1, s2};
        asm volatile("" ::: "memory"); }
    asm volatile("s_waitcnt lgkmcnt(0)" ::: "memory"); __builtin_amdgcn_s_barrier(); asm volatile("" ::: "memory");
    const int t = wid * 64 + lane;
    if (t < 256) { const f32x2v a = P[t * 4 + 0], b2 = P[t * 4 + 1], c = P[t * 4 + 2], d = P[t * 4 + 3];
      const float m1 = (a.x + b2.x) + (c.x + d.x), m2 = (a.y + b2.y) + (c.y + d.y);
      __hip_atomic_store(slots + ((size_t)(u.pm * BM + t) * 4 + u.pn), ((unsigned long long)__float_as_uint(m2) << 32) | __float_as_uint(m1), __ATOMIC_RELAXED, __HIP_MEMORY_SCOPE_AGENT); }
    asm volatile("s_waitcnt vmcnt(0)" ::: "memory"); __builtin_amdgcn_s_barrier(); asm volatile("" ::: "memory");
    if (t == 0) { __hip_atomic_fetch_add(cnt + 64 * u.pm, 1u, __ATOMIC_RELAXED, __HIP_MEMORY_SCOPE_AGENT);
      unsigned sp = 0; while (__hip_atomic_load(cnt + 64 * u.pm, __ATOMIC_RELAXED, __HIP_MEMORY_SCOPE_AGENT) < 4u) { __builtin_amdgcn_s_sleep(2); if (++sp > (1u << 22)) break; }
      __builtin_amdgcn_fence(__ATOMIC_ACQUIRE, "agent"); asm volatile("s_waitcnt vmcnt(0)" ::: "memory"); }
    __builtin_amdgcn_s_barrier(); asm volatile("" ::: "memory");
    if (t < 256) { const unsigned long long* sl = slots + (size_t)(u.pm * BM + t) * 4; float m1 = 0.f, m2 = 0.f;
#pragma unroll
      for (int q = 0; q < 4; ++q) { const unsigned long long w = __hip_atomic_load(sl + q, __ATOMIC_RELAXED, __HIP_MEMORY_SCOPE_AGENT); m1 += __uint_as_float((unsigned)w); m2 += __uint_as_float((unsigned)(w >> 32)); }
      const float mean = m1 * (1.f / DM), var = fmaxf(m2 * (1.f / DM) - mean * mean, 0.f);
      S[t] = (f32x2v){mean, rsqrtf(var + LN_EPS)}; }
    asm volatile("s_waitcnt lgkmcnt(0)" ::: "memory"); __builtin_amdgcn_s_barrier(); asm volatile("" ::: "memory");
#pragma unroll
    for (int bj = 0; bj < 2; ++bj)
#pragma unroll
      for (int n = 0; n < 2; ++n) { const f32x4 gv = *(const f32x4*)(g + col0 + bj * HALF + n * 4), bv = *(const f32x4*)(b + col0 + bj * HALF + n * 4);
#pragma unroll
        for (int ai = 0; ai < 2; ++ai)
#pragma unroll
          for (int m = 0; m < 4; ++m) { const int rl = ai * HALF + wr * 64 + m * 16 + fr; const f32x2v st = S[rl]; const size_t row = (size_t)(u.pm * BM + rl);
            const f32x4 y = (acc[ai][bj][m][n] - st.x) * st.y * gv + bv;
            *(f32x4*)(Yo + row * DM + col0 + bj * HALF + n * 4) = y;
            if (write_xb) *(unsigned*)(XB8 + row * DM + col0 + bj * HALF + n * 4) = pk4_fp8(y[0], y[1], y[2], y[3]); } }
  }
};

template <class Epi, class Sched, bool FP8 = false>
__device__ __forceinline__ void gemm_phase(LAS unsigned char* lds, const Sched& S, const Epi& E) {
  const int tid = fresh_tid(), wid = __builtin_amdgcn_readfirstlane(tid >> 6), lane = tid & 63, wr = wid >> 2, wc = wid & 3, fr = lane & 15, fq = lane >> 4;
  const int lda = S.lda, ldb = S.ldb;
  unsigned voffA[2], voffB[2];
#pragma unroll
  for (int i = 0; i < 2; ++i) { int R, C; stage_rc(tid * 16 + i * 8192, R, C); const int Rb = Epi::PERM ? ((R & ~31) + perm32(R & 31)) : R;
    voffA[i] = (unsigned)(R * lda + C) * 2u; voffB[i] = (unsigned)(Rb * ldb + C) * 2u; }
  const size_t kstep = (size_t)(BK * 2);
  const size_t hstepA = (size_t)HALF * lda * 2, hstepB = (size_t)HALF * ldb * 2;
  const unsigned ldsw = (unsigned)wid * 1024u;
  const int aoff = lds_byte(wr * 64 + fr, fq * 8), boff = lds_byte(wc * 32 + fr, fq * 8);
#define PG8_SA(b, h) (((b) * 2 + (h)) * HTB)
#define PG8_SB(b, h) ((4 + (b) * 2 + (h)) * HTB)
#define PG8_STAGE(bufoff, gbase, voff) do { _Pragma("unroll") for (int _i = 0; _i < 2; ++_i) \
    __builtin_amdgcn_global_load_lds((const unsigned*)((const char*)(gbase) + (voff)[_i]), (LAS unsigned*)(lds + (bufoff) + ldsw + _i * 8192), 16, 0, 0); } while (0)
#define PG8_LDA(dst, b, h) do { if constexpr (FP8) { _Pragma("unroll") for (int m = 0; m < 4; ++m) dst##8[m] = __builtin_shufflevector(*(const LAS v4i_t*)(lds + PG8_SA(b, h) + aoff + m * 2048), *(const LAS v4i_t*)(lds + PG8_SA(b, h) + aoff + m * 2048 + 1024), 0, 1, 2, 3, 4, 5, 6, 7); } \
    else { _Pragma("unroll") for (int m = 0; m < 4; ++m) _Pragma("unroll") for (int k = 0; k < 2; ++k) dst[m][k] = *(const LAS bf16x8*)(lds + PG8_SA(b, h) + aoff + m * 2048 + k * 1024); } } while (0)
#define PG8_LDB(dst, b, h) do { if constexpr (FP8) { _Pragma("unroll") for (int n = 0; n < 2; ++n) dst##8[n] = __builtin_shufflevector(*(const LAS v4i_t*)(lds + PG8_SB(b, h) + boff + n * 2048), *(const LAS v4i_t*)(lds + PG8_SB(b, h) + boff + n * 2048 + 1024), 0, 1, 2, 3, 4, 5, 6, 7); } \
    else { _Pragma("unroll") for (int n = 0; n < 2; ++n) _Pragma("unroll") for (int k = 0; k < 2; ++k) dst[n][k] = *(const LAS bf16x8*)(lds + PG8_SB(b, h) + boff + n * 2048 + k * 1024); } } while (0)
#define PG8_CAT(x, y) __builtin_shufflevector(__builtin_bit_cast(v4i_t, x), __builtin_bit_cast(v4i_t, y), 0, 1, 2, 3, 4, 5, 6, 7)
#define PG8_MMA(ai, bj, At, Bt) do { __builtin_amdgcn_s_setprio(1); \
    if constexpr (FP8) { _Pragma("unroll") for (int m = 0; m < 4; ++m) _Pragma("unroll") for (int n = 0; n < 2; ++n) \
      asm volatile("v_mfma_f32_16x16x128_f8f6f4 %0, %1, %2, %0" : "+v"(acc[ai][bj][m][n]) : "v"(Bt##8[n]), "v"(At##8[m])); } \
    else { _Pragma("unroll") for (int m = 0; m < 4; ++m) _Pragma("unroll") for (int n = 0; n < 2; ++n) _Pragma("unroll") for (int k = 0; k < 2; ++k) \
      acc[ai][bj][m][n] = __builtin_amdgcn_mfma_f32_16x16x32_bf16(Bt[n][k], At[m][k], acc[ai][bj][m][n], 0, 0, 0); } \
    __builtin_amdgcn_s_setprio(0); } while (0)
#define PG8_WAIT_V(n) asm volatile("s_waitcnt vmcnt(" #n ")" ::: "memory")
#define PG8_WAIT_L(n) asm volatile("s_waitcnt lgkmcnt(" #n ")" ::: "memory")
#define PG8_BAR __builtin_amdgcn_s_barrier()
#define PG8_SCHED __builtin_amdgcn_sched_barrier(0)
  Unit cur, nxt; int ui = 0;
  if (!S.next(0, cur)) return;
  f32x4 acc[2][2][4][2];
#pragma unroll
  for (int a = 0; a < 2; ++a)
#pragma unroll
    for (int b = 0; b < 2; ++b)
#pragma unroll
      for (int m = 0; m < 4; ++m)
#pragma unroll
        for (int n = 0; n < 2; ++n) acc[a][b][m][n] = (f32x4){0.f, 0.f, 0.f, 0.f};
  bf16x8 At[4][2], B0[2][2], B1[2][2]; v8i_t At8[4], B08[2], B18[2]; (void)At; (void)B0; (void)B1; (void)At8; (void)B08; (void)B18;
  const char *cA, *cB; int nt; S.op(cur, cA, cB, nt);
  PG8_STAGE(PG8_SB(0, 0), cB, voffB); PG8_STAGE(PG8_SA(0, 0), cA, voffA); PG8_STAGE(PG8_SB(0, 1), cB + hstepB, voffB); PG8_STAGE(PG8_SA(0, 1), cA + hstepA, voffA);
  if (wr == 1) PG8_BAR;
  PG8_WAIT_V(4); PG8_BAR;
  PG8_STAGE(PG8_SB(1, 0), cB + kstep, voffB); PG8_STAGE(PG8_SA(1, 0), cA + kstep, voffA); PG8_STAGE(PG8_SB(1, 1), cB + hstepB + kstep, voffB);
  PG8_WAIT_V(6); PG8_BAR;
  for (;;) {
    const bool has_next = S.next(ui + 1, nxt);
    const char *nA = cA, *nB = cB; int nnt = nt;
    if (has_next) S.op(nxt, nA, nB, nnt);
    for (int t = 0; t < nt; t += 2) {
      const bool last = (t == nt - 2);
      const char* a1 = cA + (size_t)(t + 1) * kstep;
      const char* a2 = last ? nA : cA + (size_t)(t + 2) * kstep; const char* b2 = last ? nB : cB + (size_t)(t + 2) * kstep;
      const char* a3 = a2 + kstep; const char* b3 = b2 + kstep;
      PG8_LDB(B0, 0, 0); PG8_SCHED; PG8_LDA(At, 0, 0); PG8_STAGE(PG8_SA(1, 1), a1 + hstepA, voffA);
      PG8_WAIT_L(8); PG8_BAR; PG8_WAIT_L(0); PG8_MMA(0, 0, At, B0); PG8_BAR; PG8_SCHED;
      PG8_LDB(B1, 0, 1); PG8_STAGE(PG8_SB(0, 0), b2, voffB);
      PG8_BAR; PG8_WAIT_L(0); PG8_MMA(0, 1, At, B1); PG8_BAR;
      PG8_LDA(At, 0, 1); PG8_STAGE(PG8_SA(0, 0), a2, voffA);
      PG8_BAR; PG8_WAIT_L(0); PG8_MMA(1, 0, At, B0); PG8_BAR; PG8_SCHED;
      PG8_STAGE(PG8_SB(0, 1), b2 + hstepB, voffB);
      PG8_WAIT_V(6); PG8_BAR; PG8_MMA(1, 1, At, B1); PG8_BAR;
      PG8_LDB(B0, 1, 0); PG8_SCHED; PG8_LDA(At, 1, 0); PG8_STAGE(PG8_SA(0, 1), a2 + hstepA, voffA);
      PG8_WAIT_L(8); PG8_BAR; PG8_WAIT_L(0); PG8_MMA(0, 0, At, B0); PG8_BAR; PG8_SCHED;
      PG8_LDB(B1, 1, 1); PG8_STAGE(PG8_SB(1, 0), b3, voffB);
      PG8_BAR; PG8_WAIT_L(0); PG8_MMA(0, 1, At, B1); PG8_BAR;
      PG8_LDA(At, 1, 1); PG8_STAGE(PG8_SA(1, 0), a3, voffA);
      PG8_BAR; PG8_WAIT_L(0); PG8_MMA(1, 0, At, B0); PG8_BAR; PG8_SCHED;
      PG8_STAGE(PG8_SB(1, 1), b3 + hstepB, voffB);
      PG8_WAIT_V(6); PG8_BAR; PG8_MMA(1, 1, At, B1); PG8_BAR;
    }
    if constexpr (FP8) asm volatile("s_nop 15\n\ts_nop 15\n\ts_nop 15" ::: "memory");
    if constexpr (!Epi::AFTER_DRAIN) { Unit ue = cur; int fr_ = fr, fq_ = fq;
      asm volatile("" : "+s"(ue.pm), "+s"(ue.pn), "+s"(ue.kind), "+v"(fr_), "+v"(fq_));
      E(acc, ue, wr, wc, fr_, fq_); }
    if (!has_next) break;
    if (!Epi::keep_acc(cur)) {
#pragma unroll
    for (int a = 0; a < 2; ++a)
#pragma unroll
      for (int b = 0; b < 2; ++b)
#pragma unroll
        for (int m = 0; m < 4; ++m)
#pragma unroll
          for (int n = 0; n < 2; ++n) acc[a][b][m][n] = (f32x4){0.f, 0.f, 0.f, 0.f};
    }
    cur = nxt; cA = nA; cB = nB; nt = nnt; ++ui;
  }
  PG8_WAIT_V(0);
  if (wr == 0) PG8_BAR;
  PG8_BAR;
  if constexpr (Epi::AFTER_DRAIN) { Unit ue = cur; int fr_ = fr, fq_ = fq;
    asm volatile("" : "+s"(ue.pm), "+s"(ue.pn), "+v"(fr_), "+v"(fq_));
    E.fused(acc, ue, wr, wc, fr_, fq_, lds, wid, lane); }
#undef PG8_SA
#undef PG8_SB
#undef PG8_STAGE
#undef PG8_LDA
#undef PG8_LDB
#undef PG8_MMA
#undef PG8_CAT
#undef PG8_WAIT_V
#undef PG8_WAIT_L
#undef PG8_BAR
#undef PG8_SCHED
}
}


__device__ __forceinline__ void store_tile_rows(const f32x16* o, const float* rli, char* wl, int r32, int hi, int lane, bf16_t* Orow0, long ostride, const unsigned char* Grow0, long gstride) {
#pragma unroll
  for (int r = 0; r < 16; ++r) { const int row = (r & 3) + 8 * (r >> 2) + 4 * hi;
#pragma unroll
    for (int d0 = 0; d0 < 4; ++d0) *(bf16_t*)(wl + row * 256 + (d0 * 32 + r32) * 2) = (bf16_t)(cvtpk(o[d0][r] * rli[r], 0.f) & 0xffffu);
    asm volatile("" ::: "memory"); }
  asm volatile("s_waitcnt lgkmcnt(0)" ::: "memory");
#pragma unroll 1
  for (int it = 0; it < 8; ++it) { const int chunk = it * 64 + lane, row = chunk >> 4, cc = chunk & 15;
    u32x4 v = *(const u32x4*)(wl + chunk * 16);
    if (Grow0) { const u32x2 g8 = *(const u32x2*)(Grow0 + (long)row * gstride + cc * 8); float gf[8]; fp8x4_to_f32(g8.x, gf); fp8x4_to_f32(g8.y, gf + 4);
      v.x = cvtpk(bflo(v.x) * gf[0], bfhi(v.x) * gf[1]); v.y = cvtpk(bflo(v.y) * gf[2], bfhi(v.y) * gf[3]);
      v.z = cvtpk(bflo(v.z) * gf[4], bfhi(v.z) * gf[5]); v.w = cvtpk(bflo(v.w) * gf[6], bfhi(v.w) * gf[7]); }
    *(u32x4*)(Orow0 + (long)row * ostride + cc * 8) = v; }
  asm volatile("s_waitcnt lgkmcnt(0)" ::: "memory");
}
constexpr int EPI_LDS_OFF = 66 * 1024;

namespace at {
constexpr int D = 128, NW = 8, QBLK = 32, KVBLK = 64;
constexpr float SCALE = 0.088388347648318440f;
constexpr float THR = 8.f;
constexpr size_t SHM_V = KVBLK * D * 2, SHM_K = KVBLK * D * 2, SHM_ATTN = 2 * SHM_V + 2 * SHM_K + NW * 64 * 4;
#define KSWZ(row, colB) ((row) * 256 + ((colB) ^ (((row) & 7) << 4)))
#define SBAR() __builtin_amdgcn_sched_barrier(0)
__device__ __forceinline__ int crow(int r, int hi) { return (r & 3) + 8 * (r >> 2) + 4 * hi; }

template <bool BAND>
__device__ __forceinline__ void partialSM(f32x16& p0, f32x16& p1, float& m_reg, float& mn, float& alpha, int kb, int uq, int L, float sl, int hi) {
  constexpr float C = SCALE * 1.4426950408889634f;
#if DBG_UNIFORM
  if constexpr (!BAND) { p0 = p0 * 0.f; p1 = p1 * 0.f; }
#endif
  if constexpr (BAND) {
#pragma unroll
    for (int r = 0; r < 16; ++r) {
      const int k0i = kb + crow(r, hi), k1i = k0i + 32;
      const float a0 = fabsf((float)(k0i - uq)), a1 = fabsf((float)(k1i - uq));
      const bool ok0 = (a0 <= 64.f) && ((unsigned)k0i < (unsigned)L), ok1 = (a1 <= 64.f) && ((unsigned)k1i < (unsigned)L);
      p0[r] = ok0 ? fmaf(-a0, sl, p0[r]) : -1e30f; p1[r] = ok1 ? fmaf(-a1, sl, p1[r]) : -1e30f;
    }
  }
  float pmax = p0[0];
#pragma unroll
  for (int r = 1; r < 16; ++r) pmax = fmaxf(pmax, p0[r]);
#pragma unroll
  for (int r = 0; r < 16; ++r) pmax = fmaxf(pmax, p1[r]);
  { auto rr = __builtin_amdgcn_permlane32_swap(__float_as_uint(pmax), __float_as_uint(pmax), false, false);
    pmax = fmaxf(__uint_as_float(rr[0]), __uint_as_float(rr[1])); }
  if (__builtin_expect(__all(pmax - m_reg <= THR / SCALE), 1)) { mn = m_reg; alpha = 1.f; }
  else { mn = fmaxf(m_reg, pmax); alpha = __builtin_amdgcn_exp2f((m_reg - mn) * C); m_reg = mn; }
  const float mnC = -mn * C;
#pragma unroll
  for (int r = 0; r < 16; ++r) p0[r] = fmaf(p0[r], C, mnC);
#pragma unroll
  for (int r = 0; r < 16; ++r) p1[r] = fmaf(p1[r], C, mnC);
#pragma unroll
  for (int r = 0; r < 16; ++r) p0[r] = __builtin_amdgcn_exp2f(p0[r]);
}
__device__ __forceinline__ void finishSM(f32x16& p0, f32x16& p1, float alpha, float& l_reg, bf16x8& pa0, bf16x8& pa1, bf16x8& pa2, bf16x8& pa3) {
#pragma unroll
  for (int r = 0; r < 16; ++r) p1[r] = __builtin_amdgcn_exp2f(p1[r]);
  float ps = 0;
#pragma unroll
  for (int r = 0; r < 16; ++r) ps += p0[r];
#pragma unroll
  for (int r = 0; r < 16; ++r) ps += p1[r];
  { auto rr = __builtin_amdgcn_permlane32_swap(__float_as_uint(ps), __float_as_uint(ps), false, false);
    ps = __uint_as_float(rr[0]) + __uint_as_float(rr[1]); }
  l_reg = l_reg * alpha + ps;
#define PK4(P, BASE, OUT) do { unsigned a0 = cvtpk(P[BASE + 0], P[BASE + 1]), a1 = cvtpk(P[BASE + 2], P[BASE + 3]);   \
    unsigned b0 = cvtpk(P[BASE + 4], P[BASE + 5]), b1 = cvtpk(P[BASE + 6], P[BASE + 7]);                              \
    auto r0 = __builtin_amdgcn_permlane32_swap(a0, b0, false, false); auto r1 = __builtin_amdgcn_permlane32_swap(a1, b1, false, false); \
    u32x4 w = {r0[0], r1[0], r0[1], r1[1]}; OUT = *reinterpret_cast<bf16x8*>(&w); } while (0)
  PK4(p0, 0, pa0); PK4(p0, 8, pa1); PK4(p1, 0, pa2); PK4(p1, 8, pa3);
#undef PK4
}
__device__ __forceinline__ void qkt(f32x16& p0, f32x16& p1, const char* Ks, const bf16x8* qr, int r32, int hi) {
  p0 = f32x16{}; p1 = f32x16{};
#pragma unroll
  for (int d0 = 0; d0 < 8; ++d0) { const int cb = (d0 * 16 + hi * 8) * 2;
    bf16x8 b0 = *reinterpret_cast<const bf16x8*>(Ks + KSWZ(r32, cb));
    bf16x8 b1 = *reinterpret_cast<const bf16x8*>(Ks + KSWZ(32 + r32, cb));
    p0 = __builtin_amdgcn_mfma_f32_32x32x16_bf16(b0, qr[d0], p0, 0, 0, 0);
    p1 = __builtin_amdgcn_mfma_f32_32x32x16_bf16(b1, qr[d0], p1, 0, 0, 0); }
}
__device__ __forceinline__ int v_st(int k, int c) { const int kk = (k & ~0xC) | ((k & 4) << 1) | ((k & 8) >> 1); return ((kk >> 3) * 4 + (c >> 5)) * 512 + ((kk & 7) * 32 + (c & 31)) * 2; }
__device__ __forceinline__ int v_rd_base(int lane) { return ((lane & 3) << 3) | (((lane >> 2) & 3) << 6) | (((lane >> 4) & 1) << 5) | (((lane >> 5) & 1) << 8); }
constexpr int v_rd_off(int d0, int ks, int half) { return d0 * 512 + ks * 4096 + half * 2048; }
template <int OFF> __device__ __forceinline__ s16x4 tr_read(int vb) {
  s16x4 r; asm volatile("ds_read_b64_tr_b16 %0, %1 offset:%2" : "=&v"(r) : "v"(vb), "i"(OFF) : "memory"); return r;
}
template <int D0> __device__ __forceinline__ void pv_one(f32x16& od, int vb, bf16x8 pa0, bf16x8 pa1, bf16x8 pa2, bf16x8 pa3) {
  const s16x4 l0 = tr_read<v_rd_off(D0, 0, 0)>(vb), h0 = tr_read<v_rd_off(D0, 0, 1)>(vb), l1 = tr_read<v_rd_off(D0, 1, 0)>(vb), h1 = tr_read<v_rd_off(D0, 1, 1)>(vb);
  const s16x4 l2 = tr_read<v_rd_off(D0, 2, 0)>(vb), h2 = tr_read<v_rd_off(D0, 2, 1)>(vb), l3 = tr_read<v_rd_off(D0, 3, 0)>(vb), h3 = tr_read<v_rd_off(D0, 3, 1)>(vb);
  asm volatile("s_waitcnt lgkmcnt(0)" ::: "memory"); SBAR();
#define PK(L, H) (bf16x8){L[0], L[1], L[2], L[3], H[0], H[1], H[2], H[3]}
  od = __builtin_amdgcn_mfma_f32_32x32x16_bf16(pa0, PK(l0, h0), od, 0, 0, 0);
  od = __builtin_amdgcn_mfma_f32_32x32x16_bf16(pa1, PK(l1, h1), od, 0, 0, 0);
  od = __builtin_amdgcn_mfma_f32_32x32x16_bf16(pa2, PK(l2, h2), od, 0, 0, 0);
  od = __builtin_amdgcn_mfma_f32_32x32x16_bf16(pa3, PK(l3, h3), od, 0, 0, 0);
#undef PK
}
__device__ __forceinline__ void pv_d0(f32x16* o, int vb, bf16x8 pa0, bf16x8 pa1, bf16x8 pa2, bf16x8 pa3) {
  pv_one<0>(o[0], vb, pa0, pa1, pa2, pa3); pv_one<1>(o[1], vb, pa0, pa1, pa2, pa3); pv_one<2>(o[2], vb, pa0, pa1, pa2, pa3); pv_one<3>(o[3], vb, pa0, pa1, pa2, pa3);
}

template <bool BAND>
__device__ __forceinline__ void attn_body(const bf16_t* Qb, const bf16_t* Kh, const bf16_t* Vh, long rs, int NT,
                                          int ubase, int u0, int L, float sl,
                                          bf16_t* Ob, const bf16_t* Gb, float* Lp, long lse_stride, char* lds, bool do_store = true) {
  const int tid = fresh_tid(), wid = tid >> 6, lane = tid & 63, r32 = lane & 31, hi = lane >> 5;
  if (__builtin_amdgcn_readfirstlane(wid) >= 4) __builtin_amdgcn_s_setprio(1);
  char* V_lds = lds; char* K_lds = lds + 2 * SHM_V;
  float* wsl = (float*)(lds + 2 * SHM_V + 2 * SHM_K) + wid * 64; float* li_l = wsl; float* al_l = wsl + 32;
  float m_reg = BAND ? -1e5f : -1e30f, l_reg = 0; f32x16 o[4] = {}; bf16x8 qr[8];
  const int uq = u0 + wid * QBLK + r32;
  const bf16_t* Qw = Qb + (long)(wid * QBLK + r32) * rs + hi * 8;
#pragma unroll
  for (int d0 = 0; d0 < 8; ++d0) qr[d0] = *reinterpret_cast<const bf16x8*>(Qw + d0 * 16);
  const int sr = tid >> 4, sc = (tid & 15) * 8, vst0 = v_st(sr, sc), vst1 = v_st(32 + sr, sc);
  const int vb0 = (int)(uintptr_t)V_lds + v_rd_base(lane);
  struct { bf16x8 vs0, vs1, ks0, ks1; } sr_[2];
#define KROW(k) (BAND ? (long)min(max(ubase + (k), 0), L - 1) * rs : (long)(k) * rs)
#define SLOAD(i, k0) do { const long ra_ = KROW((k0) + sr) + sc, rb_ = KROW((k0) + 32 + sr) + sc; \
    sr_[i].vs0 = *reinterpret_cast<const bf16x8*>(Vh + ra_); sr_[i].vs1 = *reinterpret_cast<const bf16x8*>(Vh + rb_); \
    sr_[i].ks0 = *reinterpret_cast<const bf16x8*>(Kh + ra_); sr_[i].ks1 = *reinterpret_cast<const bf16x8*>(Kh + rb_); } while (0)
#define SWRITE(b, i) do { *(bf16x8*)(V_lds + (b) * SHM_V + vst0) = sr_[i].vs0;          \
    *(bf16x8*)(V_lds + (b) * SHM_V + vst1) = sr_[i].vs1; const int kc = sc * 2;               \
    *(bf16x8*)(K_lds + (b) * SHM_K + KSWZ(sr, kc)) = sr_[i].ks0;                       \
    *(bf16x8*)(K_lds + (b) * SHM_K + KSWZ(32 + sr, kc)) = sr_[i].ks1; } while (0)
#define SWAIT() asm volatile("s_waitcnt vmcnt(4)" ::: "memory")
#define RESC(a) do { if (__any((a) < 1.f)) { if (hi == 0) al_l[r32] = (a); asm volatile("s_waitcnt lgkmcnt(0)" ::: "memory"); \
    _Pragma("unroll") for (int d = 0; d < 4; ++d) _Pragma("unroll") for (int r = 0; r < 16; ++r) o[d][r] *= al_l[crow(r, hi)]; } } while (0)
  f32x16 pA0, pA1, pB0, pB1; float mnA, mnB, alA, alB; bf16x8 pa0, pa1, pa2, pa3;
  constexpr int SE = 0, SO = 1;
  SLOAD(SE, 0); SLOAD(SO, KVBLK); SWAIT(); SWRITE(0, SE); __syncthreads();
  qkt(pA0, pA1, K_lds, qr, r32, hi); partialSM<BAND>(pA0, pA1, m_reg, mnA, alA, ubase, uq, L, sl, hi);
  if (2 < NT) SLOAD(SE, 2 * KVBLK);
  SWAIT(); SWRITE(1, SO); __syncthreads();
  for (int j = 1; j + 1 < NT; j += 2) {
    SBAR(); qkt(pB0, pB1, K_lds + SHM_K, qr, r32, hi);
    finishSM(pA0, pA1, alA, l_reg, pa0, pa1, pa2, pa3); SBAR();
    SLOAD(SO, (j + 2) * KVBLK); SBAR();
    pv_d0(o, vb0, pa0, pa1, pa2, pa3); partialSM<BAND>(pB0, pB1, m_reg, mnB, alB, ubase + j * KVBLK, uq, L, sl, hi);
    __syncthreads(); SWAIT(); SWRITE(0, SE);
    RESC(alB); __syncthreads();
    SBAR(); qkt(pA0, pA1, K_lds, qr, r32, hi);
    finishSM(pB0, pB1, alB, l_reg, pa0, pa1, pa2, pa3); SBAR();
    if (j + 3 < NT) SLOAD(SE, (j + 3) * KVBLK); SBAR();
    pv_d0(o, vb0 + (int)SHM_V, pa0, pa1, pa2, pa3); partialSM<BAND>(pA0, pA1, m_reg, mnA, alA, ubase + (j + 1) * KVBLK, uq, L, sl, hi);
    __syncthreads(); SWAIT(); SWRITE(1, SO);
    RESC(alA); __syncthreads();
  }
  SBAR(); qkt(pB0, pB1, K_lds + SHM_K, qr, r32, hi);
  finishSM(pA0, pA1, alA, l_reg, pa0, pa1, pa2, pa3); SBAR();
  pv_d0(o, vb0, pa0, pa1, pa2, pa3); partialSM<BAND>(pB0, pB1, m_reg, mnB, alB, ubase + (NT - 1) * KVBLK, uq, L, sl, hi);
  __syncthreads(); RESC(alB);
  finishSM(pB0, pB1, alB, l_reg, pa0, pa1, pa2, pa3); SBAR();
  pv_d0(o, vb0 + (int)SHM_V, pa0, pa1, pa2, pa3);
  __builtin_amdgcn_s_setprio(0);
  if (hi == 0) li_l[r32] = l_reg; asm volatile("s_waitcnt lgkmcnt(0)" ::: "memory");
  float rli[16];
#pragma unroll
  for (int r = 0; r < 16; ++r) rli[r] = __builtin_amdgcn_rcpf(li_l[crow(r, hi)]);
  if (!do_store) return;
  if constexpr (BAND) {
    if (hi == 0) Lp[(long)(wid * QBLK + r32) * lse_stride] = m_reg * SCALE + __logf(l_reg);
    store_tile_rows(o, rli, lds + EPI_LDS_OFF + wid * 8192, r32, hi, lane, Ob + (long)(wid * QBLK) * rs, rs, nullptr, 0);
  } else {
    bf16_t* Ow = Ob + (long)(wid * QBLK) * YW; const bf16_t* Gw = Gb + (long)(wid * QBLK) * INW;
#pragma unroll
    for (int r = 0; r < 16; ++r) { const long orow = crow(r, hi);
#pragma unroll
      for (int d0 = 0; d0 < 4; ++d0) { const float g = bf2f(Gw[orow * INW + d0 * 32 + r32]);
        Ow[orow * YW + d0 * 32 + r32] = (bf16_t)(cvtpk(o[d0][r] * rli[r] * g, 0.f) & 0xffffu); } }
  }
#undef KROW
#undef SLOAD
#undef SWRITE
#undef SWAIT
#undef RESC
}
}


namespace a8 {
typedef int v8i __attribute__((ext_vector_type(8)));
typedef int v4i __attribute__((ext_vector_type(4)));
constexpr float PSHIFT = 5.f, CAP = 8.75f;
constexpr int TILE_B = 8192;
#define A8_MFMA(a, b, c) __builtin_amdgcn_mfma_scale_f32_32x32x64_f8f6f4((a), (b), (c), 0, 0, 0, 0, 0, 0)
__device__ __forceinline__ v8i cat8(v4i a, v4i b) { return (v8i){a[0], a[1], a[2], a[3], b[0], b[1], b[2], b[3]}; }
__device__ __forceinline__ void partialSM(f32x16& p0, f32x16& p1, float& pm, f32x16& negM, float& alpha) {
  float dmax = p0[0];
#pragma unroll
  for (int r = 1; r < 16; ++r) dmax = fmaxf(dmax, p0[r]);
#pragma unroll
  for (int r = 0; r < 16; ++r) dmax = fmaxf(dmax, p1[r]);
  { auto rr = __builtin_amdgcn_permlane32_swap(__float_as_uint(dmax), __float_as_uint(dmax), false, false);
    dmax = fmaxf(__uint_as_float(rr[0]), __uint_as_float(rr[1])); }
  if (__builtin_expect(__all(dmax <= CAP), 1)) { alpha = 1.f; }
  else { const float delta = fmaxf(dmax - PSHIFT, 0.f); alpha = __builtin_amdgcn_exp2f(-delta); pm += delta;
#pragma unroll
    for (int r = 0; r < 16; ++r) { p0[r] -= delta; p1[r] -= delta; }
    const float nm = -pm;
#pragma unroll
    for (int r = 0; r < 16; ++r) negM[r] = nm; }
#pragma unroll
  for (int r = 0; r < 16; ++r) p0[r] = __builtin_amdgcn_exp2f(p0[r]);
}
__device__ __forceinline__ void finishSM(f32x16& p0, f32x16& p1, v8i& pa) {
#pragma unroll
  for (int r = 0; r < 16; ++r) p1[r] = __builtin_amdgcn_exp2f(p1[r]);
#pragma unroll
  for (int v = 0; v < 4; ++v) { int w = __builtin_amdgcn_cvt_pk_fp8_f32(p0[4 * v], p0[4 * v + 1], 0, false); pa[v] = __builtin_amdgcn_cvt_pk_fp8_f32(p0[4 * v + 2], p0[4 * v + 3], w, true); }
#pragma unroll
  for (int v = 0; v < 4; ++v) { int w = __builtin_amdgcn_cvt_pk_fp8_f32(p1[4 * v], p1[4 * v + 1], 0, false); pa[4 + v] = __builtin_amdgcn_cvt_pk_fp8_f32(p1[4 * v + 2], p1[4 * v + 3], w, true); }
}
__device__ __forceinline__ void qkt(f32x16& p0, f32x16& p1, const f32x16& negM, const char* Ks, v8i q0, v8i q1, int kb, int ko00, int ko01, int ko10, int ko11) {
  const v4i a00 = *(const v4i*)(Ks + kb + ko00), a01 = *(const v4i*)(Ks + kb + ko01), a10 = *(const v4i*)(Ks + kb + ko10), a11 = *(const v4i*)(Ks + kb + ko11);
  const v4i b00 = *(const v4i*)(Ks + 4096 + kb + ko00), b01 = *(const v4i*)(Ks + 4096 + kb + ko01), b10 = *(const v4i*)(Ks + 4096 + kb + ko10), b11 = *(const v4i*)(Ks + 4096 + kb + ko11);
  p0 = A8_MFMA(cat8(a00, a01), q0, negM); p1 = A8_MFMA(cat8(b00, b01), q0, negM);
  p0 = A8_MFMA(cat8(a10, a11), q1, p0); p1 = A8_MFMA(cat8(b10, b11), q1, p1);
}
__device__ __forceinline__ void pv(f32x16* o, const char* Vs, v8i pa, const char* onesp, int vb, int vo0, int vo1) {
  const v8i ones = cat8(*(const v4i*)(onesp), *(const v4i*)(onesp + 16));
  const v4i x0 = *(const v4i*)(Vs + vb + vo0), y0 = *(const v4i*)(Vs + vb + vo1), x1 = *(const v4i*)(Vs + 2048 + vb + vo0), y1 = *(const v4i*)(Vs + 2048 + vb + vo1);
  const v4i x2 = *(const v4i*)(Vs + 4096 + vb + vo0), y2 = *(const v4i*)(Vs + 4096 + vb + vo1), x3 = *(const v4i*)(Vs + 6144 + vb + vo0), y3 = *(const v4i*)(Vs + 6144 + vb + vo1);
  o[4] = A8_MFMA(pa, ones, o[4]);
  o[0] = A8_MFMA(pa, cat8(x0, y0), o[0]); o[1] = A8_MFMA(pa, cat8(x1, y1), o[1]); o[2] = A8_MFMA(pa, cat8(x2, y2), o[2]); o[3] = A8_MFMA(pa, cat8(x3, y3), o[3]);
}
__device__ __forceinline__ void attn_body(const unsigned char* Q8, const unsigned char* K8, const unsigned char* V8T, int NT, bf16_t* Ob, const unsigned char* Gb, char* lds) {
  using at::crow;
  const int tid = fresh_tid(), wid = tid >> 6, lane = tid & 63, r32 = lane & 31, hi = lane >> 5;
  if (__builtin_amdgcn_readfirstlane(wid) >= 4) __builtin_amdgcn_s_setprio(1);
  char* V_lds = lds; char* K_lds = lds + 2 * TILE_B;
  float* al_l = (float*)(lds + 4 * TILE_B) + wid * 32;
  float pm = 8.f - PSHIFT; f32x16 o[5] = {}; f32x16 negM;
#pragma unroll
  for (int r = 0; r < 16; ++r) negM[r] = PSHIFT - 8.f;
  { int t_; asm volatile("v_mov_b32 %0, 0x38383838" : "=v"(t_)); *(int*)(lds + 4 * TILE_B + 1024 + tid * 4) = t_; }
  const char* ones = lds + 4 * TILE_B + 1024 + lane * 32;
  v8i q0, q1;
  { const unsigned char* Qw = Q8 + (long)(wid * 32 + r32) * 1024 + hi * 32;
    q0 = cat8(*(const v4i*)(Qw), *(const v4i*)(Qw + 16)); q1 = cat8(*(const v4i*)(Qw + 64), *(const v4i*)(Qw + 80)); }
  const int kb = r32 * 128, ksw = (r32 >> 1) & 7;
  const int ko00 = ((2 * hi) ^ ksw) << 4, ko01 = ((2 * hi + 1) ^ ksw) << 4, ko10 = ((4 + 2 * hi) ^ ksw) << 4, ko11 = ((5 + 2 * hi) ^ ksw) << 4;
  const int vb = r32 * 64, vsw = (r32 >> 2) & 3, vo0 = ((2 * hi) ^ vsw) << 4, vo1 = ((2 * hi + 1) ^ vsw) << 4;
  const int krow = tid >> 3, kst = krow * 128 + (((tid & 7) ^ ((krow >> 1) & 7)) << 4);
  const int vd = tid >> 2, vst = vd * 64 + (((tid & 3) ^ ((vd >> 2) & 3)) << 4);
  const unsigned char* Kg = K8 + tid * 16; const unsigned char* Vg = V8T + tid * 16;
  struct { v4i k, v; } sr_[2];
#define SLOAD(i, t) do { sr_[i].k = *(const v4i*)(Kg + (long)(t) * TILE_B); sr_[i].v = *(const v4i*)(Vg + (long)(t) * TILE_B); } while (0)
#define SWRITE(b, i) do { *(v4i*)(K_lds + (b) * TILE_B + kst) = sr_[i].k; *(v4i*)(V_lds + (b) * TILE_B + vst) = sr_[i].v; } while (0)
#define SWAIT() asm volatile("s_waitcnt vmcnt(2)" ::: "memory")
#define RESC(a) do { if (__any((a) < 1.f)) { if (hi == 0) al_l[r32] = (a); asm volatile("s_waitcnt lgkmcnt(0)" ::: "memory"); \
    _Pragma("unroll") for (int d = 0; d < 5; ++d) _Pragma("unroll") for (int r = 0; r < 16; ++r) o[d][r] *= al_l[crow(r, hi)]; } } while (0)
  f32x16 pA0, pA1, pB0, pB1; float alA, alB; v8i pa;
  constexpr int SE = 0, SO = 1;
  SLOAD(SE, 0); SLOAD(SO, 1); SWAIT(); SWRITE(0, SE); __syncthreads();
  qkt(pA0, pA1, negM, K_lds, q0, q1, kb, ko00, ko01, ko10, ko11); partialSM(pA0, pA1, pm, negM, alA);
  if (2 < NT) SLOAD(SE, 2);
  SWAIT(); SWRITE(1, SO); __syncthreads();
  for (int j = 1; j + 1 < NT; j += 2) {
    SBAR(); qkt(pB0, pB1, negM, K_lds + TILE_B, q0, q1, kb, ko00, ko01, ko10, ko11);
    finishSM(pA0, pA1, pa); SBAR();
    SLOAD(SO, j + 2); SBAR();
    pv(o, V_lds, pa, ones, vb, vo0, vo1); partialSM(pB0, pB1, pm, negM, alB);
    __syncthreads(); SWAIT(); SWRITE(0, SE);
    RESC(alB); __syncthreads();
    SBAR(); qkt(pA0, pA1, negM, K_lds, q0, q1, kb, ko00, ko01, ko10, ko11);
    finishSM(pB0, pB1, pa); SBAR();
    if (j + 3 < NT) SLOAD(SE, j + 3); SBAR();
    pv(o, V_lds + TILE_B, pa, ones, vb, vo0, vo1); partialSM(pA0, pA1, pm, negM, alA);
    __syncthreads(); SWAIT(); SWRITE(1, SO);
    RESC(alA); __syncthreads();
  }
  SBAR(); qkt(pB0, pB1, negM, K_lds + TILE_B, q0, q1, kb, ko00, ko01, ko10, ko11);
  finishSM(pA0, pA1, pa); SBAR();
  pv(o, V_lds, pa, ones, vb, vo0, vo1); partialSM(pB0, pB1, pm, negM, alB);
  __syncthreads(); RESC(alB);
  finishSM(pB0, pB1, pa); SBAR();
  pv(o, V_lds + TILE_B, pa, ones, vb, vo0, vo1);
  __builtin_amdgcn_s_setprio(0);
  float rli[16];
#pragma unroll
  for (int r = 0; r < 16; ++r) rli[r] = __builtin_amdgcn_rcpf(o[4][r]);
  store_tile_rows(o, rli, lds + EPI_LDS_OFF + wid * 8192, r32, hi, lane, Ob + (long)(wid * 32) * YW, YW, Gb + (long)(wid * 32) * (INW * 2), INW * 2);
#undef SLOAD
#undef SWRITE
#undef SWAIT
#undef RESC
}
}

#if DBG_NAIVE_A || DBG_NAIVE_B
__device__ __forceinline__ void naive_row(const bf16_t* qrow, const bf16_t* Kb, const bf16_t* Vb, long rs, int first, int count, int uc, float sl, int lane, float& m, float& l, float& o0, float& o1) {
  const unsigned qw = *(const unsigned*)(qrow + 2 * lane); const float q0 = bflo(qw), q1 = bfhi(qw);
  m = -1e30f; l = 0.f; o0 = 0.f; o1 = 0.f;
  for (int i = first; i < first + count; ++i) {
    const unsigned kw = *(const unsigned*)(Kb + (long)i * rs + 2 * lane), vw = *(const unsigned*)(Vb + (long)i * rs + 2 * lane);
    float s = q0 * bflo(kw) + q1 * bfhi(kw);
#pragma unroll
    for (int off = 1; off < 64; off <<= 1) s += __shfl_xor(s, off);
    s = s * 0.088388347648318440f - sl * fabsf((float)(i - uc));
    const float mn = fmaxf(m, s), a = __expf(m - mn), p = __expf(s - mn);
    l = l * a + p; o0 = o0 * a + p * bflo(vw); o1 = o1 * a + p * bfhi(vw); m = mn;
  }
}
#endif

#define XB_TMO      128
#define XB_XCNT(j)  (256  + 64 * (j))
#define XB_XSUB(j)  (1280 + 64 * (j))
#define XB_XGEN(j)  (2304 + 64 * (j))
#define XB_TOP      3328
#define XB_TOPGEN   3392
#define XCD_BAR_WORDS 3456
#define XB_SPIN_CAP (1u << 20)
__device__ __forceinline__ unsigned xb_ld(unsigned* p)              { return __hip_atomic_load(p, __ATOMIC_RELAXED, __HIP_MEMORY_SCOPE_AGENT); }
__device__ __forceinline__ unsigned xb_add(unsigned* p, unsigned v) { return __hip_atomic_fetch_add(p, v, __ATOMIC_RELAXED, __HIP_MEMORY_SCOPE_AGENT); }
__device__ __forceinline__ unsigned xb_xcc_id() { return (unsigned)__builtin_amdgcn_s_getreg((3 << 11) | 20) & 0xFu; }
#define XB_SPIN(cond, bar) do { unsigned _sp = 0; while (cond) { __builtin_amdgcn_s_sleep(1); \
    if ((++_sp & 255u) == 0u) { if (xb_ld(&(bar)[XB_TMO])) break; if (_sp > XB_SPIN_CAP) { atomicAdd(&(bar)[XB_TMO], 1u); break; } } } } while (0)
struct XcdBarrier { unsigned* bar; unsigned x; volatile LAS unsigned* st; };
__device__ __forceinline__ XcdBarrier xcd_barrier_post(unsigned* bar, volatile LAS unsigned* st) {
  XcdBarrier b; b.bar = bar; b.x = xb_xcc_id(); b.st = st;
  if (threadIdx.x == 0) (void)xb_add(&bar[XB_XCNT(b.x)], 1u);
  return b;
}
__device__ __forceinline__ void xcd_barrier_complete(unsigned* bar, unsigned x, unsigned& nloc, unsigned& nx) {
  const unsigned G = gridDim.x * gridDim.y * gridDim.z;
  unsigned sum, cnt, mine, sp = 0u;
  for (;;) {
    sum = 0u; cnt = 0u; mine = 0u;
#pragma unroll
    for (unsigned j = 0; j < 16; ++j) { const unsigned c = xb_ld(&bar[XB_XCNT(j)]); sum += c; cnt += (c > 0u) ? 1u : 0u; mine = (j == x) ? c : mine; }
    if (sum == G) break;
    __builtin_amdgcn_s_sleep(1);
    if ((++sp & 255u) == 0u) { if (xb_ld(&bar[XB_TMO])) break; if (sp > XB_SPIN_CAP) { atomicAdd(&bar[XB_TMO], 1u); break; } }
  }
  nloc = mine > 0u ? mine : 1u; nx = cnt > 0u ? cnt : 1u;
}
__device__ __forceinline__ void xcd_barrier(const XcdBarrier& b) {
  asm volatile("s_waitcnt vmcnt(0)" ::: "memory");
  __syncthreads();
  if (threadIdx.x == 0) {
    unsigned* bar = b.bar;
    __builtin_amdgcn_s_waitcnt(0);
    unsigned nloc = b.st[0], nx = b.st[1];
    if (nloc == 0u) { xcd_barrier_complete(bar, b.x, nloc, nx); b.st[0] = nloc; b.st[1] = nx; }
    const unsigned old = xb_add(&bar[XB_XSUB(b.x)], 1u);
    const unsigned gen = old / nloc;
    if (old + 1u == (gen + 1u) * nloc) {
      __builtin_amdgcn_fence(__ATOMIC_RELEASE, "agent");
      asm volatile("s_waitcnt vmcnt(0)" ::: "memory");
      const unsigned og = xb_add(&bar[XB_TOP], 1u);
      const unsigned tg = og / nx;
      if (og + 1u == (tg + 1u) * nx) xb_add(&bar[XB_TOPGEN], 1u);
      else XB_SPIN(xb_ld(&bar[XB_TOPGEN]) == tg, bar);
      __builtin_amdgcn_fence(__ATOMIC_ACQUIRE, "agent");
      xb_add(&bar[XB_XGEN(b.x)], 1u);
      asm volatile("s_waitcnt vmcnt(0)" ::: "memory");
    } else {
      XB_SPIN(xb_ld(&bar[XB_XGEN(b.x)]) == gen, bar);
      __builtin_amdgcn_fence(__ATOMIC_ACQUIRE, "agent");
      asm volatile("s_waitcnt vmcnt(0)" ::: "memory");
    }
  }
  __syncthreads();
}

__device__ __forceinline__ float wave_sum(float v) {
#pragma unroll
  for (int o = 1; o < 64; o <<= 1) v += __shfl_xor(v, o);
  return v;
}
__device__ __forceinline__ void transpose_item(const float* W, int N, bf16_t* WT, int ldt, int koff, LAS float* scr, int item, int lane) {
  const int nblk = N / 32, kb = item / nblk, nb = item % nblk, k0 = 64 * kb, n0 = 32 * nb;
#pragma unroll
  for (int i = 0; i < 8; ++i) { const int kk = 8 * i + (lane >> 3), n4 = (lane & 7) * 4;
    const f32x4 w = *(const f32x4*)(W + (size_t)(k0 + kk) * N + n0 + n4);
    scr[kk * 33 + n4] = w[0]; scr[kk * 33 + n4 + 1] = w[1]; scr[kk * 33 + n4 + 2] = w[2]; scr[kk * 33 + n4 + 3] = w[3]; }
  asm volatile("s_waitcnt lgkmcnt(0)" ::: "memory");
  const int c = lane & 7;
#pragma unroll
  for (int j = 0; j < 4; ++j) { const int n = (lane >> 3) + 8 * j; const LAS float* s = scr + (8 * c) * 33 + n;
    u32x4 o; o.x = cvtpk(s[0 * 33], s[1 * 33]); o.y = cvtpk(s[2 * 33], s[3 * 33]); o.z = cvtpk(s[4 * 33], s[5 * 33]); o.w = cvtpk(s[6 * 33], s[7 * 33]);
    *(u32x4*)(WT + (size_t)(n0 + n) * ldt + koff + k0 + 8 * c) = o; }
  asm volatile("s_waitcnt lgkmcnt(0)" ::: "memory");
}

__device__ __forceinline__ void transpose_item8(const float* W, int N, unsigned char* WT, int ldt, float wscale, LAS float* scr, int item, int lane) {
  const int nblk = N / 32, kb = item / nblk, nb = item % nblk, k0 = 64 * kb, n0 = 32 * nb;
#pragma unroll
  for (int i = 0; i < 8; ++i) { const int kk = 8 * i + (lane >> 3), n4 = (lane & 7) * 4;
    const f32x4 w = *(const f32x4*)(W + (size_t)(k0 + kk) * N + n0 + n4) * wscale;
    scr[kk * 33 + n4] = w[0]; scr[kk * 33 + n4 + 1] = w[1]; scr[kk * 33 + n4 + 2] = w[2]; scr[kk * 33 + n4 + 3] = w[3]; }
  asm volatile("s_waitcnt lgkmcnt(0)" ::: "memory");
  const int c = lane & 7;
#pragma unroll
  for (int j = 0; j < 4; ++j) { const int n = (lane >> 3) + 8 * j; const LAS float* s = scr + (8 * c) * 33 + n;
    u32x2 o; o.x = pk4_fp8(s[0 * 33], s[1 * 33], s[2 * 33], s[3 * 33]); o.y = pk4_fp8(s[4 * 33], s[5 * 33], s[6 * 33], s[7 * 33]);
    *(u32x2*)(WT + (size_t)(n0 + n) * ldt + k0 + 8 * c) = o; }
  asm volatile("s_waitcnt lgkmcnt(0)" ::: "memory");
}
__device__ __forceinline__ void sincos_d(double a, double& s, double& c) {
  const double q = rint(a * 0.63661977236758134308);
  double r = fma(-q, 1.57079632679489655800e+00, a); r = fma(-q, 6.12323399573676603587e-17, r);
  const int qi = ((int)q) & 3; const double r2 = r * r;
  const double sp = r + r * r2 * (-1.0 / 6 + r2 * (1.0 / 120 + r2 * (-1.0 / 5040 + r2 * (1.0 / 362880 + r2 * (-1.0 / 39916800 + r2 * (1.0 / 6227020800.0 + r2 * (-1.0 / 1307674368000.0)))))));
  const double cp = 1.0 + r2 * (-0.5 + r2 * (1.0 / 24 + r2 * (-1.0 / 720 + r2 * (1.0 / 40320 + r2 * (-1.0 / 3628800 + r2 * (1.0 / 479001600 + r2 * (-1.0 / 87178291200.0 + r2 * (1.0 / 20922789888000.0))))))));
  s = (qi == 0) ? sp : (qi == 1) ? cp : (qi == 2) ? -sp : -cp;
  c = (qi == 0) ? cp : (qi == 1) ? -sp : (qi == 2) ? -cp : sp;
}
__device__ __forceinline__ void convert_x(const float* x, bf16_t* xb, int gtid, int gthreads) {
  for (int i = gtid; i < CT * DM / 8; i += gthreads) {
    const f32x4 a = *(const f32x4*)(x + (size_t)i * 8), b = *(const f32x4*)(x + (size_t)i * 8 + 4);
#if USE_FP8_P1
    u32x2 w; w.x = pk4_fp8(a[0], a[1], a[2], a[3]); w.y = pk4_fp8(b[0], b[1], b[2], b[3]);
    *(u32x2*)((unsigned char*)xb + (size_t)i * 8) = w; }
#else
    u32x4 w; w.x = cvtpk(a[0], a[1]); w.y = cvtpk(a[2], a[3]); w.z = cvtpk(b[0], b[1]); w.w = cvtpk(b[2], b[3]);
    *(u32x4*)(xb + (size_t)i * 8) = w; }
#endif
}

__global__ void __launch_bounds__(512, 2) fwd_megakernel(Params p) {
  extern __shared__ __attribute__((aligned(16))) unsigned char smem[];
  cg::grid_group grid = cg::this_grid();
  const int G = gridDim.x, cb = blockIdx.x, NGW = G * 8, gthreads = G * 512;
  volatile LAS unsigned* xst = (volatile LAS unsigned*)((LAS unsigned char*)smem + 131 * 1024);
  if (threadIdx.x == 0) { xst[0] = 0u; xst[1] = 0u; }
  __syncthreads();
  const XcdBarrier xb = xcd_barrier_post((unsigned*)(p.ws + WS_BAR), xst);
#define GSYNC() xcd_barrier(xb)
#define THIN_IDS() const int tid = fresh_tid(), wid = tid >> 6, lane = tid & 63, gw = cb * 8 + wid, gtid = cb * 512 + tid; (void)gw; (void)gtid; (void)lane
  bf16_t* WIN = (bf16_t*)(p.ws + WS_WIN); bf16_t* WAB = (bf16_t*)(p.ws + WS_WAB); bf16_t* WO = (bf16_t*)(p.ws + WS_WO);
  bf16_t* XB = (bf16_t*)(p.ws + WS_XB); bf16_t* T = XB; bf16_t* H = (bf16_t*)(p.ws + WS_H); bf16_t* Y = (bf16_t*)(p.ws + WS_Y);
  unsigned char* Q8 = (unsigned char*)(p.ws + WS_Q8); unsigned char* K8 = (unsigned char*)(p.ws + WS_K8); unsigned char* V8T = (unsigned char*)(p.ws + WS_V8T);
  bf16_t* MRG = (bf16_t*)(p.ws + WS_MRG); float* LSE = (float*)(p.ws + WS_LSE); float* ROPE = (float*)(p.ws + WS_ROPE);

  {
    THIN_IDS();
    LAS float* scr = (LAS float*)((LAS unsigned char*)smem + wid * 8704);
    constexpr int I_IN = (DM / 64) * (INW / 32), I_A = (512 / 64) * (DM / 32), I_B = (DM / 64) * (DM / 32), I_O = I_B, I_L = I_IN + I_A + I_B + I_O;
    for (int it = gw; it < 2 * I_L; it += NGW) {
      const int l = it / I_L; int r = it % I_L;
#if USE_FP8_P1
      if (r < I_IN) { transpose_item8(p.w_in + (size_t)l * DM * INW, INW, (unsigned char*)WIN + (size_t)l * INW * DM, DM, 32.f, scr, r, lane); continue; } r -= I_IN;
#else
      if (r < I_IN) { transpose_item(p.w_in + (size_t)l * DM * INW, INW, WIN + (size_t)l * INW * DM, DM, 0, scr, r, lane); continue; } r -= I_IN;
#endif
      if (r < I_A) { transpose_item(p.w_pa + (size_t)l * 512 * DM, DM, WAB + (size_t)l * DM * YW, YW, 0, scr, r, lane); continue; } r -= I_A;
      if (r < I_B) { transpose_item(p.w_pb + (size_t)l * DM * DM, DM, WAB + (size_t)l * DM * YW, YW, 512, scr, r, lane); continue; } r -= I_B;
      transpose_item(p.w_out + (size_t)l * DM * DM, DM, WO + (size_t)l * DM * DM, DM, 0, scr, r, lane);
    }
    for (int e = cb + G * tid; e < 256 * 32 && tid < (256 * 32 + G - 1) / G; e += gthreads) { const int pos = e >> 5, i = e & 31;
      const float inv = exp2f(-(float)i * (13.287712379549449f / 32.f));
      const float ang = (float)pos * inv; double s, c; sincos_d((double)ang, s, c);
      ROPE[e * 2] = (float)c; ROPE[e * 2 + 1] = (float)s; }
    convert_x(p.x_prompt, XB, gtid, gthreads);
  }
  grid.sync();

#pragma unroll 1
  for (int ch = 0; ch < NCH; ++ch) {
    const int S = (ch < 2) ? 8192 : 16384;
    const float* xin = (ch < 2) ? p.x_prompt + (size_t)ch * CT * DM : p.x_sample;
    float* outc = p.out + (size_t)ch * CT * DM;
#pragma unroll 1
    for (int l = 0; l < DEPTH; ++l) {
#if USE_FP8_P1
      { pg8::SchedStd s; s.nM = CT / 256; s.nN = INW / 256; s.G = G; s.c = cb; s.lda = DM / 2; s.ldb = DM / 2; s.nt = DM / 128; s.A = (const char*)XB; s.B = (const char*)WIN + (size_t)l * INW * DM;
        pg8::EpiIn e; e.H = H; e.bias = p.b_in + (size_t)l * INW; e.ascale = 1.f / 32.f;
        for (int rep = 0; rep < DBG_REP_P1; ++rep) pg8::gemm_phase<pg8::EpiIn, pg8::SchedStd, true>(( LAS unsigned char*)smem, s, e); }
#else
      { pg8::SchedStd s; s.nM = CT / 256; s.nN = INW / 256; s.G = G; s.c = cb; s.lda = DM; s.ldb = DM; s.nt = DM / 64; s.A = (const char*)XB; s.B = (const char*)(WIN + (size_t)l * INW * DM);
        pg8::EpiIn e; e.H = H; e.bias = p.b_in + (size_t)l * INW; e.ascale = 1.f;
        for (int rep = 0; rep < DBG_REP_P1; ++rep) pg8::gemm_phase(( LAS unsigned char*)smem, s, e); }
#endif
      GSYNC();
      {
        { THIN_IDS();
        const float* qg = p.q_gain + l * 128; const float* kg = p.k_gain + l * 128;
        const int l16 = lane & 15;
        for (int idx0 = gw * 4 + (lane >> 4); idx0 < CT * 10; idx0 += NGW * 16) {
          const unsigned char* ptr[4]; u32x2 w[4]; bool ok[4]; int tokk[4], hhk[4];
#pragma unroll
          for (int k = 0; k < 4; ++k) { const int idx = idx0 + k * NGW * 4; ok[k] = idx < CT * 10; const int idc = ok[k] ? idx : idx0;
            tokk[k] = idc / 10; hhk[k] = idc % 10;
            const int boff = (hhk[k] < 8 ? C_BQ * 2 + hhk[k] * 128 : C_BK * 2 + (hhk[k] - 8) * 128) + l16 * 8;
            ptr[k] = (const unsigned char*)H + (size_t)tokk[k] * (INW * 2) + boff; w[k] = *(const u32x2*)ptr[k]; }
#pragma unroll
          for (int k = 0; k < 4; ++k) {
            float v[8]; fp8x4_to_f32(w[k].x, v); fp8x4_to_f32(w[k].y, v + 4);
            float ss = 0.f;
#pragma unroll
            for (int j = 0; j < 8; ++j) ss += v[j] * v[j];
            ss += __shfl_xor(ss, 1); ss += __shfl_xor(ss, 2); ss += __shfl_xor(ss, 4); ss += __shfl_xor(ss, 8);
            const float rms = rsqrtf(ss * (1.f / 128.f) + RMS_EPS);
            const float* gp = (hhk[k] < 8 ? qg : kg) + l16 * 8;
            const int tpos = tokk[k] & (S - 1);
            const int pos = (l16 < 8) ? (tpos >> 6) : (tpos & 63);
            const f32x4* rt = (const f32x4*)(ROPE + ((size_t)pos * 32 + (l16 & 3) * 8) * 2);
            const f32x4 g0 = *(const f32x4*)gp, g1 = *(const f32x4*)(gp + 4);
            const float gg[8] = {g0[0], g0[1], g0[2], g0[3], g1[0], g1[1], g1[2], g1[3]};
            float o[8];
#pragma unroll
            for (int j = 0; j < 8; ++j) v[j] = v[j] * rms * gg[j];
#pragma unroll
            for (int j2 = 0; j2 < 4; ++j2) { const f32x4 cs = rt[j2];
              const float pr0 = __shfl_xor(v[2 * j2], 4), pr1 = __shfl_xor(v[2 * j2 + 1], 4);
              o[2 * j2] = v[2 * j2] * cs[0] + ((l16 & 4) ? pr0 : -pr0) * cs[1];
              o[2 * j2 + 1] = v[2 * j2 + 1] * cs[2] + ((l16 & 4) ? pr1 : -pr1) * cs[3]; }
            u32x4 wo; wo.x = cvtpk(o[0], o[1]); wo.y = cvtpk(o[2], o[3]); wo.z = cvtpk(o[4], o[5]); wo.w = cvtpk(o[6], o[7]);
            if (ok[k]) {
#if USE_FP8_B
#pragma unroll
              for (int j = 0; j < 8; ++j) o[j] *= 0.35709583f;
              u32x2 w8; int t0 = __builtin_amdgcn_cvt_pk_fp8_f32(o[0], o[1], 0, false); w8.x = (unsigned)__builtin_amdgcn_cvt_pk_fp8_f32(o[2], o[3], t0, true);
              int t1 = __builtin_amdgcn_cvt_pk_fp8_f32(o[4], o[5], 0, false); w8.y = (unsigned)__builtin_amdgcn_cvt_pk_fp8_f32(o[6], o[7], t1, true);
              unsigned char* d8 = (hhk[k] < 8) ? Q8 + (size_t)tokk[k] * 1024 + hhk[k] * 128 + l16 * 8 : K8 + ((size_t)(hhk[k] - 8) * CT + tokk[k]) * 128 + l16 * 8;
              *(u32x2*)d8 = w8;
#else
              (void)wo;
#endif
            }
          }
        } }
#if USE_FP8_B
        { THIN_IDS();
          const int kk = lane & 31, khi = (kk >> 2) & 1, slot = khi * 32 + (kk & 3) + 4 * (kk >> 3) + 16 * (lane >> 5);
          for (int it = gw; it < 2 * (CT / 64); it += NGW) {
            const int kvh = it / (CT / 64), tl = it % (CT / 64);
            const unsigned char* vrow = (const unsigned char*)H + (size_t)(tl * 64 + lane) * (INW * 2) + C_BV * 2 + kvh * 128;
            unsigned char* dst = V8T + ((size_t)(kvh * (CT / 64) + tl) * 128) * 64 + slot;
#pragma unroll 4
            for (int d8 = 0; d8 < 16; ++d8) { const u32x2 w = *(const u32x2*)(vrow + d8 * 8);
#pragma unroll
              for (int j = 0; j < 8; ++j) dst[(d8 * 8 + j) * 64] = (unsigned char)(((j < 4 ? w.x : w.y) >> (8 * (j & 3))) & 0xff); }
          } }
#endif
#if DBG_NAIVE_A
        { THIN_IDS();
          for (int idx = gw; idx < CT * 12; idx += NGW) {
            const int tok = idx / 12, gh = idx % 12, g = gh >> 2;
            const int dil = (g == 0) ? 1 : (g == 1) ? 4 : 16, L = S / dil;
            const int seq = tok / S, tp = tok % S, r = tp % dil, u = tp / dil;
            const float slope = exp2f(-8.f * (float)(gh + 1) / 12.f);
            const size_t tok0 = (size_t)seq * S + r; const long rs = (long)dil * INW;
            bf16_t* qrow = H + (size_t)tok * INW + C_AQ + gh * 128;
            const int first = max(u - 64, 0), last = min(u + 64, L - 1);
            float m, l, o0, o1;
            naive_row(qrow, H + tok0 * INW + C_AK + gh * 128, H + tok0 * INW + C_AV + gh * 128, rs, first, last - first + 1, u, slope * (float)dil, lane, m, l, o0, o1);
            *(unsigned*)(qrow + 2 * lane) = cvtpk(o0 / l, o1 / l);
            if (lane == 0) LSE[(size_t)tok * 12 + gh] = m + __logf(l);
          } }
        for (int it = 64 * 12; it < 64 * 12; it += G) {
#else
        for (int rep = 0; rep < DBG_REP_A; ++rep)
        for (int it = cb; it < 64 * 12; it += G) {
#endif
          const int bi = it / 12, gh = it % 12, g = gh >> 2, hs = gh & 3;
          const int dil = (g == 0) ? 1 : (g == 1) ? 4 : 16, L = S / dil, bpc = L / 256;
          const int bps = S / 256, seq = bi / bps, w = bi % bps, r = w / bpc, u0 = (w % bpc) * 256;
          const float slope = exp2f(-8.f * (float)(gh + 1) / 12.f);
          const float sl = slope * (float)dil / at::SCALE;
          const size_t tok0 = (size_t)seq * S + r;
          bf16_t* Qh = H + tok0 * INW + C_AQ + gh * 128;
          const bf16_t* Kh = H + tok0 * INW + C_AK + gh * 128; const bf16_t* Vh = H + tok0 * INW + C_AV + gh * 128;
          const long rs = (long)dil * INW;
          __syncthreads();
          at::attn_body<true>(Qh + (long)u0 * rs, Kh, Vh, rs, 6, u0 - 64, u0, L, sl, Qh + (long)u0 * rs, nullptr,
                              LSE + (tok0 + (size_t)u0 * dil) * 12 + gh, (long)dil * 12, (char*)smem, rep == DBG_REP_A - 1);
        }
      }
      GSYNC();
      {
        const int bps = S / 256;
#if DBG_NAIVE_B
        { THIN_IDS();
          for (int idx = gw; idx < CT * 8; idx += NGW) {
            const int tok = idx >> 3, h = idx & 7, seq = tok / S; const size_t tok0 = (size_t)seq * S;
            float m, l, o0, o1;
            naive_row(H + (size_t)tok * INW + C_BQ + h * 128, H + tok0 * INW + C_BK + (h >> 2) * 128, H + tok0 * INW + C_BV + (h >> 2) * 128, (long)INW, 0, S, 0, 0.f, lane, m, l, o0, o1);
            const unsigned gw_ = *(const unsigned*)(H + (size_t)tok * INW + C_BG + h * 128 + 2 * lane);
            *(unsigned*)(Y + (size_t)tok * YW + 512 + h * 128 + 2 * lane) = cvtpk(o0 / l * bflo(gw_), o1 / l * bfhi(gw_));
          } }
        for (int it = 64 * 8; it < 64 * 8; it += G) {
#else
        for (int rep = 0; rep < DBG_REP_B; ++rep)
        for (int it = cb; it < 64 * 8; it += G) {
#endif
          int qb, h, seq;
          if (G == 256) {
            const int x = cb & 7, idx = (x >> 1) * 64 + (cb >> 3) * 2 + (it >> 8), qblk = idx & 63;
            h = (x & 1) * 4 + (idx >> 6); seq = qblk / bps; qb = qblk % bps;
          } else { qb = it % bps; const int sh = it / bps; h = sh & 7; seq = sh >> 3; }
          const size_t tok0 = (size_t)seq * S, row0 = tok0 + (size_t)qb * 256;
#if DBG_NO_B
          { const int t_ = fresh_tid(); for (int e = t_; e < 256 * 16; e += 512) { u32x4 z = {0u, 0u, 0u, 0u}; *(u32x4*)(Y + (row0 + (e >> 4)) * YW + 512 + h * 128 + (e & 15) * 8) = z; } }
#else
          __syncthreads();
#if USE_FP8_B
          a8::attn_body(Q8 + row0 * 1024 + h * 128, K8 + ((size_t)(h >> 2) * CT + tok0) * 128, V8T + ((size_t)(h >> 2) * (CT / 64) + tok0 / 64) * 8192, S / 64,
                        Y + row0 * YW + 512 + h * 128, (const unsigned char*)H + row0 * (INW * 2) + C_BG * 2 + h * 128, (char*)smem);
#else
          at::attn_body<false>(H + row0 * INW + C_BQ + h * 128, H + tok0 * INW + C_BK + (h >> 2) * 128, H + tok0 * INW + C_BV + (h >> 2) * 128, (long)INW, S / 64,
                               0, 0, 0, 0.f, Y + row0 * YW + 512 + h * 128, H + row0 * INW + C_BG + h * 128, nullptr, 0, (char*)smem);
#endif
#endif
        }
        THIN_IDS();
        const int l16 = lane & 15;
        for (int rep = 0; rep < DBG_REP_C; ++rep)
        for (int idx0 = gw * 4 + (lane >> 4); idx0 < CT * 4; idx0 += NGW * 16) {
          float l0[4], l1[4], l2[4]; u32x4 a[4], b[4], c[4], gt[4]; int tokk[4], hsk[4]; bool ok[4];
#pragma unroll
          for (int k = 0; k < 4; ++k) { const int idx = idx0 + k * NGW * 4; ok[k] = idx < CT * 4; const int idc = ok[k] ? idx : idx0; tokk[k] = idc >> 2; hsk[k] = idc & 3;
            const float* lp = LSE + (size_t)tokk[k] * 12 + hsk[k]; l0[k] = lp[0]; l1[k] = lp[4]; l2[k] = lp[8];
            const bf16_t* hp = H + (size_t)tokk[k] * INW + hsk[k] * 128 + l16 * 8;
            a[k] = *(const u32x4*)(hp); b[k] = *(const u32x4*)(hp + 512); c[k] = *(const u32x4*)(hp + 1024); gt[k] = *(const u32x4*)(hp + C_AG); }
#pragma unroll
          for (int k = 0; k < 4; ++k) {
            const float mx = fmaxf(l0[k], fmaxf(l1[k], l2[k]));
            float e0 = __expf(l0[k] - mx), e1 = __expf(l1[k] - mx), e2 = __expf(l2[k] - mx);
            const float inv = 1.f / (e0 + e1 + e2); e0 *= inv; e1 *= inv; e2 *= inv;
            float o[8];
#define CMB(j, W, HL) o[j] = (e0 * HL(a[k].W) + e1 * HL(b[k].W) + e2 * HL(c[k].W)) * HL(gt[k].W)
            CMB(0, x, bflo); CMB(1, x, bfhi); CMB(2, y, bflo); CMB(3, y, bfhi); CMB(4, z, bflo); CMB(5, z, bfhi); CMB(6, w, bflo); CMB(7, w, bfhi);
#undef CMB
            u32x4 wo; wo.x = cvtpk(o[0], o[1]); wo.y = cvtpk(o[2], o[3]); wo.z = cvtpk(o[4], o[5]); wo.w = cvtpk(o[6], o[7]);
            if (ok[k]) *(u32x4*)(Y + (size_t)tokk[k] * YW + hsk[k] * 128 + l16 * 8) = wo;
          }
        }
      }
      GSYNC();
      { pg8::SchedMerge s; s.nM = CT / 256; s.nN = DM / 256; s.G = G; s.c = cb; s.lda = YW; s.ldb = YW; s.A = (const char*)Y; s.B = (const char*)(WAB + (size_t)l * DM * YW);
        pg8::EpiMerge e; e.H = H; e.T = T; e.MRG = MRG;
        for (int rep = 0; rep < DBG_REP_P4; ++rep) pg8::gemm_phase((LAS unsigned char*)smem, s, e); }
      GSYNC();
#if USE_LN_FUSED
      if (G == 256) {
      { pg8::SchedStd s; s.nM = CT / 256; s.nN = DM / 256; s.G = G; s.c = cb; s.lda = DM; s.ldb = DM; s.nt = DM / 64; s.A = (const char*)MRG; s.B = (const char*)(WO + (size_t)l * DM * DM);
        pg8::EpiLN e; e.X = (l == 0) ? xin : (const float*)outc; e.Yo = outc; e.XB8 = (unsigned char*)XB; e.g = p.ln_g + l * DM; e.b = p.ln_b + l * DM;
        e.slots = (unsigned long long*)(p.ws + WS_LNX); e.cnt = (unsigned*)(p.ws + WS_LNC) + (size_t)(ch * DEPTH + l) * 64 * 64; e.write_xb = (l == 0);
        pg8::gemm_phase((LAS unsigned char*)smem, s, e); }
      if (l == DEPTH - 1 && ch + 1 < NCH) { THIN_IDS(); convert_x((ch + 1 < 2) ? p.x_prompt + (size_t)(ch + 1) * CT * DM : p.x_sample, XB, gtid, gthreads); }
      GSYNC();
      } else
#endif
      {
      { pg8::SchedStd s; s.nM = CT / 256; s.nN = DM / 256; s.G = G; s.c = cb; s.lda = DM; s.ldb = DM; s.nt = DM / 64; s.A = (const char*)MRG; s.B = (const char*)(WO + (size_t)l * DM * DM);
        pg8::EpiOut e; e.X = (l == 0) ? xin : (const float*)outc; e.Z = outc;
        pg8::gemm_phase((LAS unsigned char*)smem, s, e); }
      GSYNC();
      {
        THIN_IDS();
        const float* gmm = p.ln_g + l * DM; const float* bta = p.ln_b + l * DM;
        f32x4 gv[4], bv[4];
#pragma unroll
        for (int j = 0; j < 4; ++j) { gv[j] = *(const f32x4*)(gmm + (j * 64 + lane) * 4); bv[j] = *(const f32x4*)(bta + (j * 64 + lane) * 4); }
        for (int row0 = gw; row0 < CT; row0 += NGW * 4) {
          f32x4 v[4][4];
#pragma unroll
          for (int k = 0; k < 4; ++k) { const int row = min(row0 + k * NGW, CT - 1); const float* zr = outc + (size_t)row * DM;
#pragma unroll
            for (int j = 0; j < 4; ++j) v[k][j] = *(const f32x4*)(zr + (j * 64 + lane) * 4); }
#pragma unroll
          for (int k = 0; k < 4; ++k) { const int row = row0 + k * NGW; float* zr = outc + (size_t)min(row, CT - 1) * DM;
            float s = 0.f;
#pragma unroll
            for (int j = 0; j < 4; ++j) s += (v[k][j][0] + v[k][j][1]) + (v[k][j][2] + v[k][j][3]);
            const float mean = wave_sum(s) * (1.f / DM); float s2 = 0.f;
#pragma unroll
            for (int j = 0; j < 4; ++j) { v[k][j] = v[k][j] - mean; s2 += (v[k][j][0] * v[k][j][0] + v[k][j][1] * v[k][j][1]) + (v[k][j][2] * v[k][j][2] + v[k][j][3] * v[k][j][3]); }
            const float rstd = rsqrtf(wave_sum(s2) * (1.f / DM) + LN_EPS);
            if (row < CT) {
#pragma unroll
              for (int j = 0; j < 4; ++j) { const f32x4 y = v[k][j] * rstd * gv[j] + bv[j]; *(f32x4*)(zr + (j * 64 + lane) * 4) = y;
#if USE_FP8_P1
                if (l == 0) *(unsigned*)((unsigned char*)XB + (size_t)row * DM + (j * 64 + lane) * 4) = pk4_fp8(y[0], y[1], y[2], y[3]); } }
#else
                if (l == 0) { u32x2 w; w.x = cvtpk(y[0], y[1]); w.y = cvtpk(y[2], y[3]); *(u32x2*)(XB + (size_t)row * DM + (j * 64 + lane) * 4) = w; } } }
#endif
          }
        }
        if (l == DEPTH - 1 && ch + 1 < NCH) convert_x((ch + 1 < 2) ? p.x_prompt + (size_t)(ch + 1) * CT * DM : p.x_sample, XB, gtid, gthreads);
      }
      GSYNC();
      }
    }
  }
}

extern "C" void kernel_launch(void* const* d_in, const int* in_sizes, int n_in, void* d_out, int out_size, void* d_ws, size_t ws_size, hipStream_t stream) {
  static int grid_blocks = 0;
  if (grid_blocks == 0) {
    if (n_in != 11 || out_size != NCH * CT * DM || ws_size < WS_END) { fprintf(stderr, "kernel_launch: unexpected shapes n_in %d out %d ws %zu (need %zu)\n", n_in, out_size, ws_size, (size_t)WS_END); grid_blocks = -1; return; }
    int dev = 0, cus = 0, per_cu = 0;
    hipGetDevice(&dev);
    hipDeviceGetAttribute(&cus, hipDeviceAttributeMultiprocessorCount, dev);
    if (hipFuncSetAttribute((const void*)fwd_megakernel, hipFuncAttributeMaxDynamicSharedMemorySize, LDS_BYTES) != hipSuccess) { fprintf(stderr, "kernel_launch: hipFuncSetAttribute failed\n"); grid_blocks = -1; return; }
    hipOccupancyMaxActiveBlocksPerMultiprocessor(&per_cu, (const void*)fwd_megakernel, 512, LDS_BYTES);
    if (per_cu < 1) { fprintf(stderr, "kernel_launch: occupancy query says %d blocks per CU\n", per_cu); per_cu = 1; }
    (void)hipGetLastError();
    grid_blocks = cus;
  }
  if (grid_blocks < 0) return;
  Params p{};
  p.x_prompt = (const float*)d_in[0]; p.x_sample = (const float*)d_in[1]; p.w_in = (const float*)d_in[2]; p.b_in = (const float*)d_in[3];
  p.q_gain = (const float*)d_in[4]; p.k_gain = (const float*)d_in[5]; p.w_pa = (const float*)d_in[6]; p.w_pb = (const float*)d_in[7];
  p.w_out = (const float*)d_in[8]; p.ln_g = (const float*)d_in[9]; p.ln_b = (const float*)d_in[10];
  p.out = (float*)d_out; p.ws = (char*)d_ws;
  if (hipMemsetAsync((char*)d_ws + WS_BAR, 0, WS_ZERO_END - WS_BAR, stream) != hipSuccess) { fprintf(stderr, "kernel_launch: memset of the barrier words failed\n"); return; }
  void* args[] = {&p};
  hipError_t e = hipLaunchCooperativeKernel((const void*)fwd_megakernel, dim3(grid_blocks), dim3(512), args, LDS_BYTES, stream);
  if (e != hipSuccess) fprintf(stderr, "cooperative launch failed: %s (grid %d)\n", hipGetErrorString(e), grid_blocks);
}
```
